# Optimizing an MI355X kernel written in HIP

```python
import math
import jax, jax.numpy as jnp
from jax import lax
import numpy as np

D_MODEL = 4096
BATCH = 4
SEQ = 4096
DEPTH = 1

EPS = 1e-6
N_META = 16
GRID_W = 64
D_MIX = D_MODEL
HEAD_DIM = 128
D_ATTN = D_MIX // 2
N_Q = D_ATTN // HEAD_DIM
N_KV = 4
Q_PER_KV = N_Q // N_KV
D_KV = N_KV * HEAD_DIM
Q_BLOCK = 128
ATTN_SCALE = 1.0 / math.sqrt(HEAD_DIM)
ROPE_THETA = 10000.0
ROPE_PAIRS = HEAD_DIM // 4
D_RNN = D_MIX - D_ATTN
LRU_BLOCKS = 16
LRU_BW = D_RNN // LRU_BLOCKS
LRU_C = 8.0
CONV_W = 4
CONV_PAD_L = 2
OFF_K = D_ATTN
OFF_V = OFF_K + D_KV
OFF_X = OFF_V + D_KV
OFF_Y = OFF_X + D_RNN
IN_COLS = OFF_Y + D_RNN
PEER_HEADS = 8
N_KEYS = 128
N_EXPERTS = N_KEYS * N_KEYS
PEER_DQ = 256
DQ_HALF = PEER_DQ // 2
PEER_TOPK = 16
PEER_E = PEER_HEADS * PEER_TOPK
PEER_CHUNK = 64

kernel_name = "hymba_attn_rglru_peer_encoder_layer"


def rmsnorm(x, g):
    xf = x.astype(jnp.float32)
    y = xf * lax.rsqrt(jnp.mean(xf * xf, axis=-1, keepdims=True) + EPS)
    return (y * g.astype(jnp.float32)).astype(x.dtype)


def axial_rope_tables(n_tok):
    rows = n_tok // GRID_W
    row = jnp.repeat(jnp.arange(rows, dtype=jnp.float32), GRID_W)
    col = (jnp.arange(rows * GRID_W) % GRID_W).astype(jnp.float32)
    inv = ROPE_THETA ** (-jnp.arange(ROPE_PAIRS, dtype=jnp.float32) / ROPE_PAIRS)
    ar = row[:, None] * inv[None, :]
    ac = col[:, None] * inv[None, :]
    ang = jnp.concatenate([ar, ar, ac, ac], axis=-1)
    ang = jnp.concatenate([jnp.zeros((N_META, HEAD_DIM), jnp.float32), ang], axis=0)
    return jnp.cos(ang), jnp.sin(ang)


def apply_rope(t, cos, sin):
    p = ROPE_PAIRS
    rot = jnp.concatenate([-t[..., p:2 * p], t[..., :p], -t[..., 3 * p:], t[..., 2 * p:3 * p]], axis=-1)
    c = cos[None, :, None, :]
    s = sin[None, :, None, :]
    return (t.astype(jnp.float32) * c + rot.astype(jnp.float32) * s).astype(t.dtype)


def attention_group(q, k, v):
    B, L = q.shape[0], q.shape[1]
    q = q.reshape(B, L, N_KV, Q_PER_KV, HEAD_DIM)

    def attend(qb):
        s = jnp.einsum('bqkgd,bskd->bkgqs', qb, k).astype(jnp.float32) * ATTN_SCALE
        p = jax.nn.softmax(s, axis=-1).astype(v.dtype)
        return jnp.einsum('bkgqs,bskd->bqkgd', p, v)

    o_meta = attend(q[:, :N_META])
    n_real = L - N_META
    n_blk = n_real // Q_BLOCK
    qr = q[:, N_META:].reshape(B, n_blk, Q_BLOCK, N_KV, Q_PER_KV, HEAD_DIM).transpose(1, 0, 2, 3, 4, 5)
    o_real = lax.map(attend, qr).transpose(1, 0, 2, 3, 4, 5).reshape(B, n_real, N_KV, Q_PER_KV, HEAD_DIM)
    o = jnp.concatenate([o_meta, o_real], axis=1)
    return o.reshape(B, L, D_ATTN)


def short_conv(x, w, b):
    y = lax.conv_general_dilated(
        x, w[:, None, :].astype(x.dtype), window_strides=(1,),
        padding=[(CONV_PAD_L, CONV_W - 1 - CONV_PAD_L)],
        dimension_numbers=('NWC', 'WIO', 'NWC'), feature_group_count=x.shape[-1])
    return y + b.astype(x.dtype)


def _lin_combine(left, right):
    a_l, b_l = left
    a_r, b_r = right
    return a_l * a_r, a_r * b_l + b_r


def rg_lru_scan(xc, w_r, b_r, w_i, b_i, lam, reverse):
    B, L = xc.shape[0], xc.shape[1]
    xb = xc.reshape(B, L, LRU_BLOCKS, LRU_BW)
    gate_r = jnp.einsum('blnc,ncd->blnd', xb, w_r).reshape(B, L, D_RNN) + b_r
    gate_i = jnp.einsum('blnc,ncd->blnd', xb, w_i).reshape(B, L, D_RNN) + b_i
    r = jax.nn.sigmoid(gate_r.astype(jnp.float32))
    i = jax.nn.sigmoid(gate_i.astype(jnp.float32))
    log_a = -LRU_C * r * jax.nn.softplus(-lam.astype(jnp.float32))
    a = jnp.exp(log_a)
    b = jnp.sqrt(-jnp.expm1(2.0 * log_a)) * (i * xc.astype(jnp.float32))
    _, h = lax.associative_scan(_lin_combine, (a, b), axis=1, reverse=reverse)
    return h


def peer_ffn(xn, wq, subkeys, u, v):
    B, L, D = xn.shape
    T = B * L
    t = xn.reshape(T, D)
    q = (t @ wq).reshape(T, PEER_HEADS, 2, DQ_HALF)
    s = jnp.einsum('thpc,hpnc->thpn', q, subkeys).astype(jnp.float32)
    s1, i1 = lax.top_k(s[:, :, 0], PEER_TOPK)
    s2, i2 = lax.top_k(s[:, :, 1], PEER_TOPK)
    cand_s = (s1[..., :, None] + s2[..., None, :]).reshape(T, PEER_HEADS, PEER_TOPK * PEER_TOPK)
    cand_i = (i1[..., :, None] * N_KEYS + i2[..., None, :]).reshape(T, PEER_HEADS, PEER_TOPK * PEER_TOPK)
    best_s, pos = lax.top_k(cand_s, PEER_TOPK)
    idx = jnp.take_along_axis(cand_i, pos, axis=-1).reshape(T, PEER_E)
    gate = jax.nn.softmax(best_s, axis=-1).reshape(T, PEER_E)

    pad = (-T) % PEER_CHUNK
    t_p = jnp.pad(t, ((0, pad), (0, 0)))
    idx_p = jnp.pad(idx, ((0, pad), (0, 0)))
    gate_p = jnp.pad(gate, ((0, pad), (0, 0)))
    n_c = (T + pad) // PEER_CHUNK

    def chunk(args):
        tc, ic, gc = args
        uc = u[ic]
        act = jax.nn.gelu(jnp.einsum('ced,cd->ce', uc, tc))
        w = (gc * act.astype(jnp.float32)).astype(tc.dtype)
        vc = v[ic]
        return jnp.einsum('ce,ced->cd', w, vc)

    out = lax.map(chunk, (t_p.reshape(n_c, PEER_CHUNK, D),
                          idx_p.reshape(n_c, PEER_CHUNK, PEER_E),
                          gate_p.reshape(n_c, PEER_CHUNK, PEER_E)))
    return out.reshape(T + pad, D)[:T].reshape(B, L, D)


def setup_inputs(seed: int = 0) -> dict:
    key = jax.random.key(seed)
    ks = jax.random.split(key, 24)
    f32 = jnp.float32

    def nrm(k, shape, scale):
        return jax.random.normal(k, shape, f32) * scale

    def gain(k, shape):
        return 1.0 + 0.05 * jax.random.normal(k, shape, f32)

    u01 = jax.random.uniform(ks[12], (DEPTH, 2, D_RNN), f32, minval=0.9, maxval=0.999)
    sig = u01 ** (1.0 / LRU_C)
    lru_lambda = jnp.log(sig) - jnp.log1p(-sig)

    return {
        "x": nrm(ks[0], (BATCH, SEQ, D_MODEL), 1.0),
        "meta_tokens": nrm(ks[1], (N_META, D_MODEL), 1.0),
        "norm1_g": gain(ks[2], (DEPTH, D_MODEL)),
        "w_in": nrm(ks[3], (DEPTH, D_MODEL, IN_COLS), D_MODEL ** -0.5),
        "q_norm_g": gain(ks[4], (DEPTH, HEAD_DIM)),
        "k_norm_g": gain(ks[5], (DEPTH, HEAD_DIM)),
        "conv_w": nrm(ks[6], (DEPTH, CONV_W, D_RNN), CONV_W ** -0.5),
        "conv_b": nrm(ks[7], (DEPTH, D_RNN), 0.01),
        "w_rg": nrm(ks[8], (DEPTH, 2, LRU_BLOCKS, LRU_BW, LRU_BW), LRU_BW ** -0.5),
        "b_rg": nrm(ks[9], (DEPTH, 2, D_RNN), 0.01),
        "w_ig": nrm(ks[10], (DEPTH, 2, LRU_BLOCKS, LRU_BW, LRU_BW), LRU_BW ** -0.5),
        "b_ig": nrm(ks[11], (DEPTH, 2, D_RNN), 0.01),
        "lru_lambda": lru_lambda,
        "attn_out_g": gain(ks[13], (DEPTH, D_ATTN)),
        "lru_out_g": gain(ks[14], (DEPTH, D_RNN)),
        "w_out": nrm(ks[15], (DEPTH, D_MIX, D_MODEL), D_MIX ** -0.5),
        "norm2_g": gain(ks[16], (DEPTH, D_MODEL)),
        "peer_wq": nrm(ks[17], (DEPTH, D_MODEL, PEER_HEADS * PEER_DQ), D_MODEL ** -0.5),
        "peer_subkeys": nrm(ks[18], (DEPTH, PEER_HEADS, 2, N_KEYS, DQ_HALF), DQ_HALF ** -0.5),
        "peer_u": nrm(ks[19], (DEPTH, N_EXPERTS, D_MODEL), D_MODEL ** -0.5),
        "peer_v": nrm(ks[20], (DEPTH, N_EXPERTS, D_MODEL), PEER_E ** -0.5),
    }


def reference(x, meta_tokens, norm1_g, w_in, q_norm_g, k_norm_g, conv_w, conv_b,
              w_rg, b_rg, w_ig, b_ig, lru_lambda, attn_out_g, lru_out_g, w_out,
              norm2_g, peer_wq, peer_subkeys, peer_u, peer_v):
    B, S, D = x.shape
    meta = jnp.broadcast_to(meta_tokens[None].astype(x.dtype), (B, N_META, D))
    h = jnp.concatenate([meta, x], axis=1)
    L = N_META + S
    cos, sin = axial_rope_tables(S)

    for l in range(DEPTH):
        xn = rmsnorm(h, norm1_g[l])
        z = xn @ w_in[l]
        q = z[..., :OFF_K].reshape(B, L, N_Q, HEAD_DIM)
        k = z[..., OFF_K:OFF_V].reshape(B, L, N_KV, HEAD_DIM)
        v = z[..., OFF_V:OFF_X].reshape(B, L, N_KV, HEAD_DIM)
        xr = z[..., OFF_X:OFF_Y]
        yr = z[..., OFF_Y:]

        q = apply_rope(rmsnorm(q, q_norm_g[l]), cos, sin)
        k = apply_rope(rmsnorm(k, k_norm_g[l]), cos, sin)
        attn = attention_group(q, k, v)

        xc = short_conv(xr, conv_w[l], conv_b[l])
        h_fwd = rg_lru_scan(xc, w_rg[l, 0], b_rg[l, 0], w_ig[l, 0], b_ig[l, 0], lru_lambda[l, 0], False)
        h_bwd = rg_lru_scan(xc, w_rg[l, 1], b_rg[l, 1], w_ig[l, 1], b_ig[l, 1], lru_lambda[l, 1], True)
        lru = ((h_fwd + h_bwd) * jax.nn.gelu(yr.astype(jnp.float32))).astype(h.dtype)

        merged = jnp.concatenate([rmsnorm(attn, attn_out_g[l]), rmsnorm(lru, lru_out_g[l])], axis=-1)
        h = h + merged @ w_out[l]

        h = h + peer_ffn(rmsnorm(h, norm2_g[l]), peer_wq[l], peer_subkeys[l], peer_u[l], peer_v[l])

    return h[:, N_META:]
```

```cpp
#include <hip/hip_runtime.h>
#include <hip/hip_cooperative_groups.h>
#include <cstdio>
#include <cstdint>
namespace cg = cooperative_groups;

#ifndef N_LAUNCH_MODE
#define N_LAUNCH_MODE 1
#endif

#define GAS __attribute__((address_space(1)))
#define LAS __attribute__((address_space(3)))
typedef unsigned short bf16_t;
typedef short bf16x8 __attribute__((ext_vector_type(8)));
typedef short s16x4 __attribute__((ext_vector_type(4)));
typedef float f32x2 __attribute__((ext_vector_type(2)));
typedef float f32x4 __attribute__((ext_vector_type(4)));
typedef float f32x16 __attribute__((ext_vector_type(16)));
typedef unsigned u32x2 __attribute__((ext_vector_type(2)));
typedef unsigned u32x4 __attribute__((ext_vector_type(4)));
typedef __bf16 bf16x2 __attribute__((ext_vector_type(2)));

constexpr int DM = 4096, NB = 4, SEQ = 4096, NMETA = 16, LTOT = SEQ + NMETA;
constexpr int MR = NB * SEQ;
constexpr int INC = 7168, OFF_K = 2048, OFF_V = 2560, OFF_X = 3072, OFF_Y = 5120;
constexpr int HD = 128, NQ = 16, NKV = 4, DATT = 2048, DRNN = 2048;
constexpr int KPAD = 4224;
constexpr int NT_REAL = 64;
constexpr int PH = 8, NKEYS = 128, PDQ = 256, PTOPK = 16, PE = 128, NEXP = 16384;
constexpr float EPS = 1e-6f;

constexpr size_t MiB = 1u << 20;
constexpr size_t WS_CTL = 0;
constexpr size_t WS_ROPE = 1 * MiB;
constexpr size_t WS_RSTD2 = 1 * MiB + 65536;
constexpr size_t WS_SU = 1 * MiB + 131072;
constexpr size_t WS_SV = 1 * MiB + 196608;
constexpr size_t WS_SKB = 2 * MiB;
constexpr size_t WS_ZM = 2 * MiB + 524288;
constexpr size_t WS_WG = 3 * MiB;
constexpr size_t WS_WT1 = 5 * MiB;
constexpr size_t WS_WT2 = 61 * MiB;
constexpr size_t WS_WT3 = 93 * MiB;
constexpr size_t WS_XN = 109 * MiB;
constexpr size_t WS_KP = 238 * MiB;
constexpr size_t WS_VP = 255 * MiB;
constexpr size_t WS_MRG = 272 * MiB;
constexpr size_t WS_SSQ2 = 400 * MiB;
constexpr size_t WS_IDX = 404 * MiB;
constexpr size_t WS_GATE = 412 * MiB;
constexpr size_t WS_QP = 420 * MiB;
constexpr size_t WS_Z = 484 * MiB;
constexpr size_t WS_HF = 708 * MiB;
constexpr size_t WS_HB = 772 * MiB;
constexpr size_t WS_UB = 484 * MiB;
constexpr size_t WS_VB = 516 * MiB;
constexpr size_t WS_SUT = 336 * MiB;
constexpr size_t WS_GS = 344 * MiB;
constexpr size_t WS_PACT = 272 * MiB;
constexpr size_t WS_END = 836 * MiB;

constexpr int LDS_BYTES = 147456; constexpr int LDS_MISC = 147456 - 256;
constexpr int NWAVES = 8;
constexpr int NPHASE = 10;

__device__ __forceinline__ unsigned f2bf(float f) { unsigned u = __builtin_bit_cast(unsigned, f); return (u + 0x7fffu + ((u >> 16) & 1u)) >> 16; }
__device__ __forceinline__ unsigned pk2(float lo, float hi) { return f2bf(lo) | (f2bf(hi) << 16); }
__device__ __forceinline__ float bflo(unsigned w) { return __builtin_bit_cast(float, w << 16); }
__device__ __forceinline__ float bfhi(unsigned w) { return __builtin_bit_cast(float, w & 0xffff0000u); }
__device__ __forceinline__ float bf2f(bf16_t b) { return __builtin_bit_cast(float, ((unsigned)b) << 16); }
__device__ __forceinline__ unsigned cvt_pk_bf16(float lo, float hi) { unsigned r; asm volatile("v_cvt_pk_bf16_f32 %0, %1, %2" : "=v"(r) : "v"(lo), "v"(hi)); return r; }
__device__ __forceinline__ float wave_sum(float v) {
#pragma unroll
    for (int o = 1; o < 64; o <<= 1) v += __shfl_xor(v, o);
    return v;
}
__device__ __forceinline__ float gelu_tanh(float x) {
    const float y = 0.7978845608028654f * (x + 0.044715f * x * x * x);
    const float e = __expf(2.f * y);
    const float th = 1.f - 2.f / (1.f + e);
    return 0.5f * x * (1.f + th);
}
__device__ __forceinline__ float sigmoidf_(float x) { return 1.f / (1.f + __expf(-x)); }
__device__ __forceinline__ float dot2bf(unsigned w, unsigned x, float acc) { return __builtin_amdgcn_fdot2_f32_bf16(__builtin_bit_cast(bf16x2, w), __builtin_bit_cast(bf16x2, x), acc, false); }
__device__ __forceinline__ float ub0(unsigned x) { float r; asm("v_cvt_f32_ubyte0 %0, %1" : "=v"(r) : "v"(x)); return r; }
__device__ __forceinline__ float ub1(unsigned x) { float r; asm("v_cvt_f32_ubyte1 %0, %1" : "=v"(r) : "v"(x)); return r; }
__device__ __forceinline__ float ub2(unsigned x) { float r; asm("v_cvt_f32_ubyte2 %0, %1" : "=v"(r) : "v"(x)); return r; }
__device__ __forceinline__ float ub3(unsigned x) { float r; asm("v_cvt_f32_ubyte3 %0, %1" : "=v"(r) : "v"(x)); return r; }
__device__ __forceinline__ float wave_max(float v) {
#pragma unroll
    for (int o = 1; o < 64; o <<= 1) v = fmaxf(v, __shfl_xor(v, o));
    return v;
}
__device__ __forceinline__ unsigned pack_i8x4(float a, float b, float c, float d, int bias) {
    const int ia = (int)__builtin_rintf(a) + bias, ib = (int)__builtin_rintf(b) + bias, ic = (int)__builtin_rintf(c) + bias, id = (int)__builtin_rintf(d) + bias;
    return (unsigned)(ia & 0xff) | ((unsigned)(ib & 0xff) << 8) | ((unsigned)(ic & 0xff) << 16) | ((unsigned)id << 24);
}
#define LDS_WAIT() asm volatile("s_waitcnt lgkmcnt(0)" ::: "memory")

namespace pg8 {
constexpr int BM = 256, BK = 64, HALF = 128, HTB = HALF * BK * 2, STAGE_BYTES = 8 * HTB, NXCD = 8, WGM = 8;
__host__ __device__ __forceinline__ int lds_byte(int r, int c) { const int st = (r >> 4) * 2 + (c >> 5), rr = r & 15, cc = c & 31, ob = rr * 64 + cc * 2; return st * 1024 + (ob ^ (((ob >> 9) & 1) << 5)); }
__host__ __device__ __forceinline__ void stage_rc(int b, int& R, int& C) { const int st = b / 1024, sb = b % 1024, swz = sb ^ (((sb >> 9) & 1) << 5); R = (st >> 1) * 16 + swz / 64; C = (st & 1) * 32 + (swz % 64) / 2; }
__host__ __device__ __forceinline__ int perm32(int rho) { const int n = rho >> 4, i = rho & 15; return 8 * (i >> 2) + 4 * n + (i & 3); }
struct Unit { int pm, pn; };
struct Gemm { const bf16_t* A; const bf16_t* Bt; int M, N, K; };
struct StaticOrder {
    int nM, nN, nwg, G, c;
    __host__ __device__ void init(int M, int N, int G_, int c_) { nM = M / BM; nN = N / BM; nwg = nM * nN; G = G_; c = c_; }
    __host__ __device__ bool next(int i, Unit& u) const {
        const long L = (long)i * G + c; if (L >= nwg) return false;
        int wgid = (int)L; { const int q = nwg / NXCD, r = nwg % NXCD, xcd = wgid % NXCD, off = wgid / NXCD; wgid = (xcd < r ? xcd * (q + 1) : r * (q + 1) + (xcd - r) * q) + off; }
        const int nig = WGM * nN, gid = wgid / nig, fm = gid * WGM, gsz = (nM - fm) < WGM ? (nM - fm) : WGM;
        u.pm = fm + ((wgid % nig) % gsz); u.pn = (wgid % nig) / gsz; return true;
    }
};
struct EpiBf16 {
    bf16_t* O; int ldc;
    __device__ __forceinline__ void operator()(const f32x4 (&acc)[2][2][4][2], const Unit& u, int wr, int wc, int fr, int fq) const {
        const int row0 = u.pm * BM + wr * 64 + fr; const int col0 = u.pn * BM + wc * 32 + 8 * fq;
#pragma unroll
        for (int ai = 0; ai < 2; ++ai)
#pragma unroll
            for (int m = 0; m < 4; ++m) { bf16_t* rowp = O + (size_t)(row0 + ai * HALF + m * 16) * ldc + col0;
#pragma unroll
                for (int bj = 0; bj < 2; ++bj) { const f32x4 v0 = acc[ai][bj][m][0], v1 = acc[ai][bj][m][1];
                    u32x4 w; w.x = cvt_pk_bf16(v0[0], v0[1]); w.y = cvt_pk_bf16(v0[2], v0[3]); w.z = cvt_pk_bf16(v1[0], v1[1]); w.w = cvt_pk_bf16(v1[2], v1[3]);
                    *(u32x4*)(rowp + bj * HALF) = w; } }
    }
};
struct EpiResid {
    const float* X; float* OUT; bf16_t* HB; float* SSQ; int ldc;
    __device__ __forceinline__ void operator()(const f32x4 (&acc)[2][2][4][2], const Unit& u, int wr, int wc, int fr, int fq) const {
        const int row0 = u.pm * BM + wr * 64 + fr; const int col0 = u.pn * BM + wc * 32 + 8 * fq;
#pragma unroll
        for (int ai = 0; ai < 2; ++ai)
#pragma unroll
            for (int m = 0; m < 4; ++m) { const int row = row0 + ai * HALF + m * 16; const size_t off = (size_t)row * ldc + col0; float ss = 0.f;
#pragma unroll
                for (int bj = 0; bj < 2; ++bj) {
                    const f32x4 x0 = *(const f32x4*)(X + off + bj * HALF), x1 = *(const f32x4*)(X + off + bj * HALF + 4);
                    const f32x4 v0 = acc[ai][bj][m][0] + x0, v1 = acc[ai][bj][m][1] + x1;
                    u32x4 w; w.x = cvt_pk_bf16(v0[0], v0[1]); w.y = cvt_pk_bf16(v0[2], v0[3]); w.z = cvt_pk_bf16(v1[0], v1[1]); w.w = cvt_pk_bf16(v1[2], v1[3]);
                    *(u32x4*)(HB + off + bj * HALF) = w;
                    ss += (v0[0] * v0[0] + v0[1] * v0[1]) + (v0[2] * v0[2] + v0[3] * v0[3]) + (v1[0] * v1[0] + v1[1] * v1[1]) + (v1[2] * v1[2] + v1[3] * v1[3]); }
                ss += __shfl_xor(ss, 16); ss += __shfl_xor(ss, 32);
                if (fq == 0) SSQ[(size_t)row * 64 + u.pn * 4 + wc] = ss; }
    }
};

template <class Epi>
__device__ __forceinline__ void gemm_phase(LAS unsigned char* lds, const Gemm g, const StaticOrder& S, const Epi& E) {
    const int tid = threadIdx.x, wid = __builtin_amdgcn_readfirstlane(tid >> 6), lane = tid & 63, wr = wid >> 2, wc = wid & 3, fr = lane & 15, fq = lane >> 4;
    const int K = g.K, nt = K / BK;
    unsigned voffA[2], voffB[2];
#pragma unroll
    for (int i = 0; i < 2; ++i) { int R, C; stage_rc(tid * 16 + i * 8192, R, C); const int Rb = (R & ~31) + perm32(R & 31);
        voffA[i] = (unsigned)(R * K + C) * 2u; voffB[i] = (unsigned)(Rb * K + C) * 2u; }
    const size_t kstep = (size_t)(BK * 2);
    const size_t hstep = (size_t)HALF * K * 2;
    const size_t tstep = 2 * hstep;
    const unsigned ldsw = (unsigned)wid * 1024u;
    const int aoff = lds_byte(wr * 64 + fr, fq * 8), boff = lds_byte(wc * 32 + fr, fq * 8);
#define PG8_SA(b, h) (((b) * 2 + (h)) * HTB)
#define PG8_SB(b, h) ((4 + (b) * 2 + (h)) * HTB)
#define PG8_STAGE(bufoff, gbase, voff) do { _Pragma("unroll") for (int _i = 0; _i < 2; ++_i) \
        __builtin_amdgcn_global_load_lds((const unsigned*)((const char*)(gbase) + (voff)[_i]), (LAS unsigned*)(lds + (bufoff) + ldsw + _i * 8192), 16, 0, 0); } while (0)
#define PG8_LDA(dst, b, h) do { _Pragma("unroll") for (int m = 0; m < 4; ++m) _Pragma("unroll") for (int k = 0; k < 2; ++k) dst[m][k] = *(const LAS bf16x8*)(lds + PG8_SA(b, h) + aoff + m * 2048 + k * 1024); } while (0)
#define PG8_LDB(dst, b, h) do { _Pragma("unroll") for (int n = 0; n < 2; ++n) _Pragma("unroll") for (int k = 0; k < 2; ++k) dst[n][k] = *(const LAS bf16x8*)(lds + PG8_SB(b, h) + boff + n * 2048 + k * 1024); } while (0)
#define PG8_MMA(ai, bj, At, Bt) do { __builtin_amdgcn_s_setprio(1); _Pragma("unroll") for (int m = 0; m < 4; ++m) _Pragma("unroll") for (int n = 0; n < 2; ++n) _Pragma("unroll") for (int k = 0; k < 2; ++k) \
        acc[ai][bj][m][n] = __builtin_amdgcn_mfma_f32_16x16x32_bf16(Bt[n][k], At[m][k], acc[ai][bj][m][n], 0, 0, 0); __builtin_amdgcn_s_setprio(0); } while (0)
#define PG8_WAIT_V(n) asm volatile("s_waitcnt vmcnt(" #n ")" ::: "memory")
#define PG8_WAIT_L(n) asm volatile("s_waitcnt lgkmcnt(" #n ")" ::: "memory")
#define PG8_BAR __builtin_amdgcn_s_barrier()
#define PG8_SCHED __builtin_amdgcn_sched_barrier(0)
    Unit cur, nxt; int ui = 0;
    if (!S.next(0, cur)) return;
    f32x4 acc[2][2][4][2];
#pragma unroll
    for (int a = 0; a < 2; ++a)
#pragma unroll
        for (int b = 0; b < 2; ++b)
#pragma unroll
            for (int m = 0; m < 4; ++m)
#pragma unroll
                for (int n = 0; n < 2; ++n) acc[a][b][m][n] = (f32x4){0.f, 0.f, 0.f, 0.f};
    bf16x8 At[4][2], B0[2][2], B1[2][2];
    const char* cA = (const char*)g.A + (size_t)cur.pm * tstep; const char* cB = (const char*)g.Bt + (size_t)cur.pn * tstep;
    PG8_STAGE(PG8_SB(0, 0), cB, voffB); PG8_STAGE(PG8_SB(0, 1), cB + hstep, voffB); PG8_STAGE(PG8_SA(0, 0), cA, voffA); PG8_STAGE(PG8_SA(0, 1), cA + hstep, voffA);
    if (wr == 1) PG8_BAR;
    PG8_WAIT_V(2); PG8_BAR;
    PG8_STAGE(PG8_SB(1, 0), cB + kstep, voffB); PG8_STAGE(PG8_SA(1, 0), cA + kstep, voffA); PG8_STAGE(PG8_SB(1, 1), cB + hstep + kstep, voffB);
    PG8_WAIT_V(6); PG8_BAR;
    for (;;) {
        const bool has_next = S.next(ui + 1, nxt);
        const char* nA = has_next ? (const char*)g.A + (size_t)nxt.pm * tstep : cA; const char* nB = has_next ? (const char*)g.Bt + (size_t)nxt.pn * tstep : cB;
        for (int t = 0; t < nt; t += 2) {
            const bool last = (t == nt - 2);
            const char* a1 = cA + (size_t)(t + 1) * kstep;
            const char* a2 = last ? nA : cA + (size_t)(t + 2) * kstep; const char* b2 = last ? nB : cB + (size_t)(t + 2) * kstep;
            const char* a3 = a2 + kstep; const char* b3 = b2 + kstep;
            PG8_LDB(B0, 0, 0); PG8_LDB(B1, 0, 1); PG8_SCHED; PG8_LDA(At, 0, 0); PG8_STAGE(PG8_SA(1, 1), a1 + hstep, voffA);
            PG8_WAIT_V(8); PG8_WAIT_L(0); PG8_BAR; PG8_MMA(0, 0, At, B0); PG8_MMA(0, 1, At, B1); PG8_BAR; PG8_SCHED;
            PG8_LDA(At, 0, 1); PG8_STAGE(PG8_SB(0, 0), b2, voffB); PG8_STAGE(PG8_SB(0, 1), b2 + hstep, voffB); PG8_STAGE(PG8_SA(0, 0), a2, voffA);
            PG8_WAIT_V(8); PG8_WAIT_L(0); PG8_BAR; PG8_MMA(1, 0, At, B0); PG8_MMA(1, 1, At, B1); PG8_BAR; PG8_SCHED;
            PG8_LDB(B0, 1, 0); PG8_LDB(B1, 1, 1); PG8_SCHED; PG8_LDA(At, 1, 0); PG8_STAGE(PG8_SA(0, 1), a2 + hstep, voffA);
            PG8_WAIT_V(8); PG8_WAIT_L(0); PG8_BAR; PG8_MMA(0, 0, At, B0); PG8_MMA(0, 1, At, B1); PG8_BAR; PG8_SCHED;
            PG8_LDA(At, 1, 1); PG8_STAGE(PG8_SB(1, 0), b3, voffB); PG8_STAGE(PG8_SB(1, 1), b3 + hstep, voffB); PG8_STAGE(PG8_SA(1, 0), a3, voffA);
            PG8_WAIT_V(8); PG8_WAIT_L(0); PG8_BAR; PG8_MMA(1, 0, At, B0); PG8_MMA(1, 1, At, B1); PG8_BAR; PG8_SCHED;
        }
        if (wr == 0) PG8_BAR;
        E(acc, cur, wr, wc, fr, fq);
        if (!has_next) break;
#pragma unroll
        for (int a = 0; a < 2; ++a)
#pragma unroll
            for (int b = 0; b < 2; ++b)
#pragma unroll
                for (int m = 0; m < 4; ++m)
#pragma unroll
                    for (int n = 0; n < 2; ++n) acc[a][b][m][n] = (f32x4){0.f, 0.f, 0.f, 0.f};
        cur = nxt; cA = nA; cB = nB; ++ui;
        if (wr == 1) PG8_BAR;
    }
    PG8_WAIT_V(0);
    PG8_BAR;
#undef PG8_SA
#undef PG8_SB
#undef PG8_STAGE
#undef PG8_LDA
#undef PG8_LDB
#undef PG8_MMA
#undef PG8_WAIT_V
#undef PG8_WAIT_L
#undef PG8_BAR
#undef PG8_SCHED
}
}

namespace att {
constexpr int D = 128, NW = 8, QBLK = 32, KVBLK = 64;
constexpr float SCALE = 0.088388347648318440f;
constexpr float THR = 8.f;
constexpr int LDQ = INC, LDK = HD, LDO = DM;
constexpr size_t SHM_V = KVBLK * D * 2, SHM_K = KVBLK * D * 2, SHM_ATTN = 2 * SHM_V + 2 * SHM_K + NW * 64 * 4;
#define KSWZ(row, colB) ((row) * 256 + ((colB) ^ (((row) & 7) << 4)))
#define SBAR() __builtin_amdgcn_sched_barrier(0)
__device__ __forceinline__ int crow(int r, int hi) { return (r & 3) + 8 * (r >> 2) + 4 * hi; }
__device__ __forceinline__ unsigned cvtpk(float lo, float hi) { unsigned r; asm volatile("v_cvt_pk_bf16_f32 %0, %1, %2" : "=v"(r) : "v"(lo), "v"(hi)); return r; }
template <int NV> __device__ __forceinline__ void partialSM(f32x16& p0, f32x16& p1, float& m_reg, float& mn, float& alpha) {
    constexpr float C = SCALE * 1.4426950408889634f;
    float pmax = p0[0];
#pragma unroll
    for (int r = 1; r < 16; ++r) pmax = fmaxf(pmax, p0[r]);
#pragma unroll
    for (int r = 0; r < 16; ++r) pmax = fmaxf(pmax, p1[r]);
    { auto rr = __builtin_amdgcn_permlane32_swap(__float_as_uint(pmax), __float_as_uint(pmax), false, false);
      pmax = fmaxf(__uint_as_float(rr[0]), __uint_as_float(rr[1])); }
    if (__builtin_expect(__all(pmax - m_reg <= THR / SCALE), 1)) { mn = m_reg; alpha = 1.f; }
    else { mn = fmaxf(m_reg, pmax); alpha = __builtin_amdgcn_exp2f((m_reg - mn) * C); m_reg = mn; }
    float mnC = -mn * C;
#pragma unroll
    for (int r = 0; r < 16; ++r) p0[r] = fmaf(p0[r], C, mnC);
#pragma unroll
    for (int r = 0; r < 16; ++r) p1[r] = fmaf(p1[r], C, mnC);
#pragma unroll
    for (int r = 0; r < 16; ++r) p0[r] = __builtin_amdgcn_exp2f(p0[r]);
}
__device__ __forceinline__ void finishSM(f32x16& p0, f32x16& p1, float alpha, float& l_reg, bf16x8& pa0, bf16x8& pa1, bf16x8& pa2, bf16x8& pa3) {
#pragma unroll
    for (int r = 0; r < 16; ++r) p1[r] = __builtin_amdgcn_exp2f(p1[r]);
    float ps = 0;
#pragma unroll
    for (int r = 0; r < 16; ++r) ps += p0[r];
#pragma unroll
    for (int r = 0; r < 16; ++r) ps += p1[r];
    { auto rr = __builtin_amdgcn_permlane32_swap(__float_as_uint(ps), __float_as_uint(ps), false, false);
      ps = __uint_as_float(rr[0]) + __uint_as_float(rr[1]); }
    l_reg = l_reg * alpha + ps;
#define PK4(P, BASE, OUT) do { unsigned a0 = cvtpk(P[BASE + 0], P[BASE + 1]), a1 = cvtpk(P[BASE + 2], P[BASE + 3]);   \
    unsigned b0 = cvtpk(P[BASE + 4], P[BASE + 5]), b1 = cvtpk(P[BASE + 6], P[BASE + 7]);                              \
    auto r0 = __builtin_amdgcn_permlane32_swap(a0, b0, false, false); auto r1 = __builtin_amdgcn_permlane32_swap(a1, b1, false, false); \
    u32x4 w = {r0[0], r1[0], r0[1], r1[1]}; OUT = *reinterpret_cast<bf16x8*>(&w); } while (0)
    PK4(p0, 0, pa0); PK4(p0, 8, pa1); PK4(p1, 0, pa2); PK4(p1, 8, pa3);
#undef PK4
}
__device__ __forceinline__ void qkt(f32x16& p0, f32x16& p1, const bf16_t* Ks, const bf16x8* qr, int r32, int hi) {
    p0 = f32x16{}; p1 = f32x16{};
#pragma unroll
    for (int d0 = 0; d0 < 8; ++d0) { int cb = (d0 * 16 + hi * 8) * 2;
        bf16x8 b0 = *reinterpret_cast<const bf16x8*>((const char*)Ks + KSWZ(r32, cb));
        bf16x8 b1 = *reinterpret_cast<const bf16x8*>((const char*)Ks + KSWZ(32 + r32, cb));
        p0 = __builtin_amdgcn_mfma_f32_32x32x16_bf16(b0, qr[d0], p0, 0, 0, 0);
        p1 = __builtin_amdgcn_mfma_f32_32x32x16_bf16(b1, qr[d0], p1, 0, 0, 0); }
}
__device__ __forceinline__ int v_st(int k, int c) { const int kk = (k & ~0xC) | ((k & 4) << 1) | ((k & 8) >> 1); return ((kk >> 3) * 4 + (c >> 5)) * 512 + ((kk & 7) * 32 + (c & 31)) * 2; }
__device__ __forceinline__ int v_rd_base(int lane) { return ((lane & 3) << 3) | (((lane >> 2) & 3) << 6) | (((lane >> 4) & 1) << 5) | (((lane >> 5) & 1) << 8); }
constexpr int v_rd_off(int d0, int ks, int half) { return d0 * 512 + ks * 4096 + half * 2048; }
template <int OFF> __device__ __forceinline__ s16x4 tr_read(int vb) {
    s16x4 r; asm volatile("ds_read_b64_tr_b16 %0, %1 offset:%2" : "=&v"(r) : "v"(vb), "i"(OFF) : "memory"); return r;
}
template <int D0> __device__ __forceinline__ void pv_one(f32x16& od, int vb, bf16x8 pa0, bf16x8 pa1, bf16x8 pa2, bf16x8 pa3) {
    const s16x4 l0 = tr_read<v_rd_off(D0, 0, 0)>(vb), h0 = tr_read<v_rd_off(D0, 0, 1)>(vb), l1 = tr_read<v_rd_off(D0, 1, 0)>(vb), h1 = tr_read<v_rd_off(D0, 1, 1)>(vb);
    const s16x4 l2 = tr_read<v_rd_off(D0, 2, 0)>(vb), h2 = tr_read<v_rd_off(D0, 2, 1)>(vb), l3 = tr_read<v_rd_off(D0, 3, 0)>(vb), h3 = tr_read<v_rd_off(D0, 3, 1)>(vb);
    asm volatile("s_waitcnt lgkmcnt(0)" ::: "memory"); SBAR();
#define PK(L, H) (bf16x8){L[0], L[1], L[2], L[3], H[0], H[1], H[2], H[3]}
    od = __builtin_amdgcn_mfma_f32_32x32x16_bf16(pa0, PK(l0, h0), od, 0, 0, 0);
    od = __builtin_amdgcn_mfma_f32_32x32x16_bf16(pa1, PK(l1, h1), od, 0, 0, 0);
    od = __builtin_amdgcn_mfma_f32_32x32x16_bf16(pa2, PK(l2, h2), od, 0, 0, 0);
    od = __builtin_amdgcn_mfma_f32_32x32x16_bf16(pa3, PK(l3, h3), od, 0, 0, 0);
#undef PK
}
__device__ __forceinline__ void pv_d0(f32x16* o, int vb, bf16x8 pa0, bf16x8 pa1, bf16x8 pa2, bf16x8 pa3) {
    pv_one<0>(o[0], vb, pa0, pa1, pa2, pa3); pv_one<1>(o[1], vb, pa0, pa1, pa2, pa3); pv_one<2>(o[2], vb, pa0, pa1, pa2, pa3); pv_one<3>(o[3], vb, pa0, pa1, pa2, pa3);
}

__device__ __forceinline__ void attn_unit(const bf16_t* __restrict__ Qb, const bf16_t* __restrict__ Kh, const bf16_t* __restrict__ Vh, bf16_t* __restrict__ Ob, char* lds,
                                          const int s0, const float* __restrict__ gq, const f32x2* __restrict__ RT) {
    const int tid = threadIdx.x, wid = tid >> 6, lane = tid & 63, r32 = lane & 31, hi = lane >> 5;
    bf16_t* V_lds = (bf16_t*)lds; bf16_t* K_lds = (bf16_t*)(lds + 2 * SHM_V);
    float* ws = (float*)(lds + 2 * SHM_V + 2 * SHM_K) + wid * 64; float* li_l = ws; float* al_l = ws + 32;
    float m_reg = -1e30f, l_reg = 0; bf16x8 qr[8];
    const bf16_t* Qw = Qb + (long)(wid * QBLK + r32) * LDQ + hi * 8;
#pragma unroll
    for (int d0 = 0; d0 < 8; ++d0) qr[d0] = *reinterpret_cast<const bf16x8*>(Qw + d0 * 16);
    { float ss = 0.f;
#pragma unroll
      for (int d0 = 0; d0 < 8; ++d0)
#pragma unroll
          for (int j = 0; j < 8; ++j) { const float x = bf2f((bf16_t)qr[d0][j]); ss += x * x; }
      ss += __shfl_xor(ss, 32);
      const float rstd = 1.f / sqrtf(ss * (1.f / HD) + EPS);
      const int sq = s0 + wid * QBLK + r32, prow = sq >> 6, pcol = sq & 63;
#pragma unroll
      for (int pr = 0; pr < 4; ++pr) { const int da = (pr & 1) + 4 * (pr >> 1), db = da + 2; const int pos = (pr < 2) ? prow : pcol;
          const f32x4* cs4 = (const f32x4*)(RT + pos * 32 + (da & 1) * 16 + hi * 8);
          const f32x4* ga4 = (const f32x4*)(gq + da * 16 + hi * 8); const f32x4* gb4 = (const f32x4*)(gq + db * 16 + hi * 8);
          unsigned wa[4], wb[4];
#pragma unroll
          for (int jj = 0; jj < 4; ++jj) { const f32x4 cs = cs4[jj]; const f32x4 ga = ga4[jj >> 1], gb = gb4[jj >> 1];
              const int j = 2 * jj; const float g0a = (jj & 1) ? ga.z : ga.x, g1a = (jj & 1) ? ga.w : ga.y, g0b = (jj & 1) ? gb.z : gb.x, g1b = (jj & 1) ? gb.w : gb.y;
              const float xa0 = bf2f((bf16_t)qr[da][j]) * rstd * g0a, xa1 = bf2f((bf16_t)qr[da][j + 1]) * rstd * g1a;
              const float xb0 = bf2f((bf16_t)qr[db][j]) * rstd * g0b, xb1 = bf2f((bf16_t)qr[db][j + 1]) * rstd * g1b;
              wa[jj] = cvtpk(xa0 * cs.x - xb0 * cs.y, xa1 * cs.z - xb1 * cs.w);
              wb[jj] = cvtpk(xb0 * cs.x + xa0 * cs.y, xb1 * cs.z + xa1 * cs.w); }
          const u32x4 va = {wa[0], wa[1], wa[2], wa[3]}, vb = {wb[0], wb[1], wb[2], wb[3]};
          qr[da] = *reinterpret_cast<const bf16x8*>(&va); qr[db] = *reinterpret_cast<const bf16x8*>(&vb); } }
    f32x16 o[4] = {};
    const int sr = tid >> 4, sc = (tid & 15) * 8, vst0 = v_st(sr, sc), vst1 = v_st(32 + sr, sc);
    const int vb0 = (int)(uintptr_t)V_lds + v_rd_base(lane);
    struct { bf16x8 vs0, vs1, ks0, ks1; } sr_[2];
    const unsigned toff = (unsigned)(sr * LDK + sc) * 2u;
#define SLOAD(i, k0) do { const char* _kb = (const char*)Kh + (size_t)(k0) * (LDK * 2); const char* _vb = (const char*)Vh + (size_t)(k0) * (LDK * 2); \
    sr_[i].vs0 = *reinterpret_cast<const bf16x8*>(_vb + toff); sr_[i].vs1 = *reinterpret_cast<const bf16x8*>(_vb + 32 * LDK * 2 + toff); \
    sr_[i].ks0 = *reinterpret_cast<const bf16x8*>(_kb + toff); sr_[i].ks1 = *reinterpret_cast<const bf16x8*>(_kb + 32 * LDK * 2 + toff); } while (0)
#define SWRITE(b, i) do { *(bf16x8*)((char*)V_lds + (b) * SHM_V + vst0) = sr_[i].vs0;          \
    *(bf16x8*)((char*)V_lds + (b) * SHM_V + vst1) = sr_[i].vs1; int kc = sc * 2;               \
    *(bf16x8*)((char*)K_lds + (b) * SHM_K + KSWZ(sr, kc)) = sr_[i].ks0;                       \
    *(bf16x8*)((char*)K_lds + (b) * SHM_K + KSWZ(32 + sr, kc)) = sr_[i].ks1; } while (0)
#define SWAIT() asm volatile("s_waitcnt vmcnt(4)" ::: "memory")
#define RESC(a) do { if (__any((a) < 1.f)) { if (hi == 0) al_l[r32] = (a); asm volatile("s_waitcnt lgkmcnt(0)" ::: "memory"); \
    _Pragma("unroll") for (int d = 0; d < 4; ++d) _Pragma("unroll") for (int r = 0; r < 16; ++r) o[d][r] *= al_l[crow(r, hi)]; } } while (0)
    f32x16 pA0, pA1, pB0, pB1; float mnA, mnB, alA, alB; bf16x8 pa0, pa1, pa2, pa3; constexpr int NT = KPAD / KVBLK; static_assert(NT == NT_REAL + 2, "tile count");
    constexpr int SE = 0, SO = 1;
    SLOAD(SE, 0); asm volatile("s_waitcnt vmcnt(0)" ::: "memory"); SWRITE(0, SE); __syncthreads();
    qkt(pA0, pA1, K_lds, qr, r32, hi); partialSM<64>(pA0, pA1, m_reg, mnA, alA);
    SLOAD(SO, KVBLK); SLOAD(SE, 2 * KVBLK);
    SWAIT(); SWRITE(1, SO); __syncthreads();
    for (int j = 1; j + 1 < NT; j += 2) {
        SBAR(); qkt(pB0, pB1, (bf16_t*)((char*)K_lds + SHM_K), qr, r32, hi);
        finishSM(pA0, pA1, alA, l_reg, pa0, pa1, pa2, pa3); SBAR();
        SLOAD(SO, (j + 2) * KVBLK); SBAR();
        pv_d0(o, vb0, pa0, pa1, pa2, pa3); partialSM<64>(pB0, pB1, m_reg, mnB, alB);
        __syncthreads(); SWAIT(); SWRITE(0, SE);
        RESC(alB); __syncthreads();
        SBAR(); qkt(pA0, pA1, K_lds, qr, r32, hi);
        finishSM(pB0, pB1, alB, l_reg, pa0, pa1, pa2, pa3); SBAR();
        if (j + 3 < NT) SLOAD(SE, (j + 3) * KVBLK); SBAR();
        pv_d0(o, vb0 + (int)SHM_V, pa0, pa1, pa2, pa3); partialSM<64>(pA0, pA1, m_reg, mnA, alA);
        __syncthreads(); SWAIT(); SWRITE(1, SO);
        RESC(alA); __syncthreads();
    }
    SBAR(); qkt(pB0, pB1, (bf16_t*)((char*)K_lds + SHM_K), qr, r32, hi);
    finishSM(pA0, pA1, alA, l_reg, pa0, pa1, pa2, pa3); SBAR();
    pv_d0(o, vb0, pa0, pa1, pa2, pa3); partialSM<64>(pB0, pB1, m_reg, mnB, alB);
    __syncthreads(); RESC(alB);
    finishSM(pB0, pB1, alB, l_reg, pa0, pa1, pa2, pa3); SBAR();
    pv_d0(o, vb0 + (int)SHM_V, pa0, pa1, pa2, pa3);
    l_reg -= (float)(KPAD - LTOT) * __builtin_amdgcn_exp2f(-m_reg * (SCALE * 1.4426950408889634f));
    if (hi == 0) li_l[r32] = l_reg; asm volatile("s_waitcnt lgkmcnt(0)" ::: "memory");
    float rli[16];
#pragma unroll
    for (int r = 0; r < 16; ++r) rli[r] = __builtin_amdgcn_rcpf(li_l[crow(r, hi)]);
    bf16_t* Ow = Ob + (long)(wid * QBLK) * LDO;
    const int odd = lane & 1;
#pragma unroll
    for (int r = 0; r < 16; r += 2) {
#pragma unroll
        for (int d0 = 0; d0 < 4; ++d0) {
            const float a = o[d0][r] * rli[r], b = o[d0][r + 1] * rli[r + 1];
            const float send = odd ? a : b; const float recv = __shfl_xor(send, 1);
            const unsigned w = odd ? cvtpk(recv, b) : cvtpk(a, recv);
            const int orow = crow(odd ? r + 1 : r, hi);
            *(unsigned*)(Ow + (long)orow * LDO + d0 * 32 + (r32 & ~1)) = w;
        }
    }
    __syncthreads();
#undef SLOAD
#undef SWRITE
#undef SWAIT
#undef RESC
}
}

#define XB_TMO      128
#define XB_XCNT(j)  (256  + 64 * (j))
#define XB_XSUB(j)  (1280 + 64 * (j))
#define XB_XGEN(j)  (2304 + 64 * (j))
#define XB_TOP      3328
#define XB_TOPGEN   3392
#define XCD_BAR_WORDS 3456
#define XB_SPIN_CAP (1u << 22)
__device__ __forceinline__ unsigned xb_ld(unsigned* p)              { return __hip_atomic_load(p, __ATOMIC_RELAXED, __HIP_MEMORY_SCOPE_AGENT); }
__device__ __forceinline__ unsigned xb_add(unsigned* p, unsigned v) { return __hip_atomic_fetch_add(p, v, __ATOMIC_RELAXED, __HIP_MEMORY_SCOPE_AGENT); }
__device__ __forceinline__ unsigned xb_xcc_id() { return (unsigned)__builtin_amdgcn_s_getreg((3 << 11) | 20) & 0xFu; }
#define XB_SPIN(cond, bar) do { unsigned _sp = 0; while (cond) { __builtin_amdgcn_s_sleep(1); \
    if ((++_sp & 255u) == 0u) { if (xb_ld(&(bar)[XB_TMO])) break; if (_sp > XB_SPIN_CAP) { atomicAdd(&(bar)[XB_TMO], 1u); break; } } } } while (0)
struct XcdBarrier { unsigned* bar; unsigned x; volatile LAS unsigned* st; };
__device__ __forceinline__ XcdBarrier xcd_barrier_post(unsigned* bar, volatile LAS unsigned* st) {
    XcdBarrier b; b.bar = bar; b.x = xb_xcc_id(); b.st = st;
    if (threadIdx.x == 0) (void)xb_add(&bar[XB_XCNT(b.x)], 1u);
    return b;
}
__device__ __forceinline__ void xcd_barrier_complete(unsigned* bar, unsigned x, unsigned& nloc, unsigned& nx) {
    const unsigned G = gridDim.x * gridDim.y * gridDim.z;
    unsigned sum, cnt, mine, sp = 0u;
    for (;;) {
        sum = 0u; cnt = 0u; mine = 0u;
#pragma unroll
        for (unsigned j = 0; j < 16; ++j) { const unsigned c = xb_ld(&bar[XB_XCNT(j)]); sum += c; cnt += (c > 0u) ? 1u : 0u; mine = (j == x) ? c : mine; }
        if (sum == G) break;
        __builtin_amdgcn_s_sleep(1);
        if ((++sp & 255u) == 0u) { if (xb_ld(&bar[XB_TMO])) break; if (sp > XB_SPIN_CAP) { atomicAdd(&bar[XB_TMO], 1u); break; } }
    }
    nloc = mine > 0u ? mine : 1u; nx = cnt > 0u ? cnt : 1u;
}
__device__ __forceinline__ void xcd_barrier(const XcdBarrier& b) {
    asm volatile("s_waitcnt vmcnt(0)" ::: "memory");
    __syncthreads();
    if (threadIdx.x == 0) {
        unsigned* bar = b.bar;
        __builtin_amdgcn_s_waitcnt(0);
        unsigned nloc = b.st[0], nx = b.st[1];
        if (nloc == 0u) { xcd_barrier_complete(bar, b.x, nloc, nx); b.st[0] = nloc; b.st[1] = nx; }
        const unsigned old = xb_add(&bar[XB_XSUB(b.x)], 1u);
        const unsigned gen = old / nloc;
        if (old + 1u == (gen + 1u) * nloc) {
            __builtin_amdgcn_fence(__ATOMIC_RELEASE, "agent");
            asm volatile("s_waitcnt vmcnt(0)" ::: "memory");
            const unsigned og = xb_add(&bar[XB_TOP], 1u);
            const unsigned tg = og / nx;
            if (og + 1u == (tg + 1u) * nx) xb_add(&bar[XB_TOPGEN], 1u);
            else XB_SPIN(xb_ld(&bar[XB_TOPGEN]) == tg, bar);
            __builtin_amdgcn_fence(__ATOMIC_ACQUIRE, "agent");
            xb_add(&bar[XB_XGEN(b.x)], 1u);
            asm volatile("s_waitcnt vmcnt(0)" ::: "memory");
        } else {
            XB_SPIN(xb_ld(&bar[XB_XGEN(b.x)]) == gen, bar);
            __builtin_amdgcn_fence(__ATOMIC_ACQUIRE, "agent");
            asm volatile("s_waitcnt vmcnt(0)" ::: "memory");
        }
    }
    __syncthreads();
}

struct Args { const float* in[21]; float* out; unsigned char* ws; int ph_lo, ph_hi; };
struct Frame {
    LAS unsigned char* lds; char* ldsg;
    int tid, lane, wave, vcu, G;
    float* out; unsigned char* ws;
};
#define IN_X 0
#define IN_META 1
#define IN_G1 2
#define IN_WIN 3
#define IN_QG 4
#define IN_KG 5
#define IN_CW 6
#define IN_CB 7
#define IN_WRG 8
#define IN_BRG 9
#define IN_WIG 10
#define IN_BIG 11
#define IN_LAM 12
#define IN_GA 13
#define IN_GL 14
#define IN_WOUT 15
#define IN_G2 16
#define IN_WQ 17
#define IN_SK 18
#define IN_U 19
#define IN_V 20

__device__ __forceinline__ void p0_transpose_item(const float* W, int K, int N, bf16_t* WT, const float* gk, LAS float* scr, int item, int lane) {
    const int nblk = N / 64, kb = item / nblk, nb = item % nblk, k0 = 64 * kb, n0 = 64 * nb;
    const int kq = lane >> 4, nq = lane & 15;
#pragma unroll 8
    for (int i = 0; i < 16; ++i) { const int kk = 4 * i + kq; f32x4 v = *(const f32x4*)(W + (size_t)(k0 + kk) * N + n0 + 4 * nq); if (gk) { const float g = gk[k0 + kk]; v.x *= g; v.y *= g; v.z *= g; v.w *= g; }
        LAS float* d = scr + kk * 65 + 4 * nq; d[0] = v.x; d[1] = v.y; d[2] = v.z; d[3] = v.w; }
    LDS_WAIT(); asm volatile("" ::: "memory");
    const int c = lane & 7;
#pragma unroll
    for (int j = 0; j < 8; ++j) { const int n = (lane >> 3) + 8 * j; const LAS float* sp = scr + (8 * c) * 65 + n;
        u32x4 o; o.x = pk2(sp[0 * 65], sp[1 * 65]); o.y = pk2(sp[2 * 65], sp[3 * 65]); o.z = pk2(sp[4 * 65], sp[5 * 65]); o.w = pk2(sp[6 * 65], sp[7 * 65]);
        *(u32x4*)(WT + (size_t)(n0 + n) * K + k0 + 8 * c) = o; }
    LDS_WAIT(); asm volatile("" ::: "memory");
}
__device__ __forceinline__ void p0_prologue(Frame& F, const Args& A) {
    LAS float* scr = (LAS float*)(F.lds + F.wave * 16640);
    const int gw = F.vcu * NWAVES + F.wave, NGW = F.G * NWAVES, lane = F.lane;
    bf16_t* WT1 = (bf16_t*)(F.ws + WS_WT1); bf16_t* WT2 = (bf16_t*)(F.ws + WS_WT2); bf16_t* WT3 = (bf16_t*)(F.ws + WS_WT3); bf16_t* WG = (bf16_t*)(F.ws + WS_WG);
    constexpr int I_1 = (DM / 64) * (INC / 64), I_2 = (DM / 64) * (DM / 64), I_3 = (DM / 64) * (2048 / 64), I_G = 64 * 4;
    constexpr int NITEMS = I_1 + I_2 + I_3 + I_G;
    for (int it = gw; it < NITEMS; it += NGW) {
        int r = it;
        if (r < I_1) { p0_transpose_item(A.in[IN_WIN], DM, INC, WT1, A.in[IN_G1], scr, r, lane); continue; } r -= I_1;
        if (r < I_2) { const int kb = r / (DM / 64); const float* gk = (kb < 32) ? A.in[IN_GA] : (A.in[IN_GL] - DATT); p0_transpose_item(A.in[IN_WOUT], DM, DM, WT2, gk, scr, r, lane); continue; } r -= I_2;
        if (r < I_3) { p0_transpose_item(A.in[IN_WQ], DM, 2048, WT3, A.in[IN_G2], scr, r, lane); continue; } r -= I_3;
        { const int mat = r >> 2, sub = r & 3; const int dirn = mat >> 1, gate = mat & 1;
          const float* W = (gate ? A.in[IN_WIG] : A.in[IN_WRG]) + (size_t)dirn * 128 * 128;
          p0_transpose_item(W, 128, 128, WG + (size_t)mat * 128 * 128, nullptr, scr, sub, lane); }
    }
    bf16_t* XN = (bf16_t*)(F.ws + WS_XN);
    for (int m = gw; m < MR + NMETA; m += NGW) {
        const float* xrow = (m < MR) ? A.in[IN_X] + (size_t)m * DM : A.in[IN_META] + (size_t)(m - MR) * DM;
        const f32x4* xr = (const f32x4*)xrow + lane;
        f32x4 v[16]; float s = 0.f;
#pragma unroll
        for (int j = 0; j < 16; ++j) { v[j] = xr[64 * j]; s += (v[j].x * v[j].x + v[j].y * v[j].y) + (v[j].z * v[j].z + v[j].w * v[j].w); }
        const float rstd = 1.f / sqrtf(wave_sum(s) * (1.f / DM) + EPS);
        u32x2* o8 = (u32x2*)(XN + (size_t)m * DM) + lane;
#pragma unroll
        for (int j = 0; j < 16; ++j) { u32x2 w; w.x = pk2(v[j].x * rstd, v[j].y * rstd); w.y = pk2(v[j].z * rstd, v[j].w * rstd); o8[64 * j] = w; }
    }
    { const float* sk = A.in[IN_SK]; bf16_t* SKB = (bf16_t*)(F.ws + WS_SKB);
      for (int i = gw * 64 + lane; i < PH * 2 * NKEYS * 128 / 4; i += NGW * 64) { const f32x4 v = ((const f32x4*)sk)[i]; u32x2 w; w.x = pk2(v.x, v.y); w.y = pk2(v.z, v.w); ((u32x2*)SKB)[i] = w; }
      f32x2* RT = (f32x2*)(F.ws + WS_ROPE);
      for (int i = gw * 64 + lane; i < 64 * 32; i += NGW * 64) { const int p = i >> 5, j = i & 31;
          const float inv = exp2f(-(float)j * (13.287712379549449f / 32.f)); const float ang = (float)p * inv;
          float rev = ang * 0.15915494309189535f; rev -= floorf(rev);
          f32x2 cs; cs.x = __builtin_amdgcn_cosf(rev); cs.y = __builtin_amdgcn_sinf(rev); RT[i] = cs; } }
}

__device__ __forceinline__ void p1_meta_gemm(Frame& F, const Args& A) {
    const bf16_t* XNm = (const bf16_t*)(F.ws + WS_XN) + (size_t)MR * DM; const bf16_t* WT1 = (const bf16_t*)(F.ws + WS_WT1); bf16_t* ZM = (bf16_t*)(F.ws + WS_ZM);
    LAS float* red = (LAS float*)F.lds;
    const int lane = F.lane, c16 = lane & 15, q = lane >> 4;
    for (int item = F.vcu; item < (OFF_Y - OFF_K) / 16; item += F.G) {
        const int n0 = OFF_K + 16 * item;
        f32x4 acc = {0.f, 0.f, 0.f, 0.f};
        const bf16_t* ap = XNm + (size_t)c16 * DM + F.wave * 512 + 8 * q; const bf16_t* bp = WT1 + (size_t)(n0 + c16) * DM + F.wave * 512 + 8 * q;
#pragma unroll
        for (int ks = 0; ks < 16; ++ks) { const bf16x8 a = *(const bf16x8*)(ap + 32 * ks), b = *(const bf16x8*)(bp + 32 * ks); acc = __builtin_amdgcn_mfma_f32_16x16x32_bf16(a, b, acc, 0, 0, 0); }
#pragma unroll
        for (int r = 0; r < 4; ++r) red[F.wave * 256 + (4 * q + r) * 16 + c16] = acc[r];
        __syncthreads();
        if (F.tid < 256) { float s = 0.f;
#pragma unroll
            for (int w = 0; w < 8; ++w) s += red[w * 256 + F.tid];
            ZM[(size_t)(F.tid >> 4) * INC + n0 + (F.tid & 15)] = (bf16_t)f2bf(s); }
        __syncthreads();
    }
}

template <int dir> __device__ __forceinline__ void scan_unit(Frame& F, const Args& A, int u) {
    const int half = (u >> 1) & 1, n = (u >> 2) & 15, b = u >> 6;
    const int tid = F.tid, lane = F.lane, wave = F.wave;
    const bf16_t* Z = (const bf16_t*)(F.ws + WS_Z); const bf16_t* ZM = (const bf16_t*)(F.ws + WS_ZM);
    bf16_t* HO = (bf16_t*)(F.ws + (dir ? WS_HB : WS_HF));
    LAS unsigned char* XR = F.lds;
    LAS unsigned char* XC = F.lds + 18432;
    LAS float* AS = (LAS float*)(F.lds + 35840);
    LAS float* BS = (LAS float*)(F.lds + 52224);
    LAS float* HS = (LAS float*)(F.lds + 68608);
    LAS float* SM = (LAS float*)(F.lds + 84992);
    LAS float* CR = (LAS float*)(F.lds + 89088);
    const int mt = wave & 3, dh = wave >> 2, r16 = lane & 15, q4 = lane >> 4;
    bf16x8 bw[4][4];
#pragma unroll
    for (int nt = 0; nt < 4; ++nt) { const int gate = nt >> 1, dcol = 64 * half + 32 * dh + 16 * (nt & 1) + r16;
        const bf16_t* wp = (const bf16_t*)(F.ws + WS_WG) + ((size_t)((dir * 16 + n) * 2 + gate) * 128 + dcol) * 128 + 8 * q4;
#pragma unroll
        for (int ks = 0; ks < 4; ++ks) bw[nt][ks] = *(const bf16x8*)(wp + 32 * ks); }
    float br[2], bi[2], sp8[2];
#pragma unroll
    for (int db = 0; db < 2; ++db) { const int che = 128 * n + 64 * half + 32 * dh + 16 * db + r16;
        br[db] = A.in[IN_BRG][dir * DRNN + che]; bi[db] = A.in[IN_BIG][dir * DRNN + che]; sp8[db] = 8.f * log1pf(__expf(-A.in[IN_LAM][dir * DRNN + che])); }
    const int cp = tid & 63, tg = tid >> 6;
    float cw[2][4], cb[2];
#pragma unroll
    for (int c = 0; c < 2; ++c) { const int ch = 128 * n + 2 * cp + c;
#pragma unroll
        for (int j = 0; j < 4; ++j) cw[c][j] = A.in[IN_CW][j * DRNN + ch];
        cb[c] = A.in[IN_CB][ch]; }
    const int ntile = dir ? 64 : 65;
    const int lr = tid >> 4, lc = tid & 15;
    u32x4 pf[3];
#define TILE_P0(it) (dir ? (NMETA + 64 * (63 - (it))) : ((it) == 0 ? -48 : NMETA + 64 * ((it) - 1)))
#define XR_PREFETCH(it) do { const int _p0 = TILE_P0(it); _Pragma("unroll") for (int _j = 0; _j < 3; ++_j) { const int _r = lr + 32 * _j; const int _p = _p0 - 2 + _r; u32x4 _v = {0u, 0u, 0u, 0u}; \
        if (_r < 67 && _p >= 0 && _p < LTOT) { const bf16_t* _row = (_p < NMETA) ? (ZM + (size_t)_p * INC) : (Z + (size_t)(b * SEQ + _p - NMETA) * INC); _v = *(const u32x4*)(_row + OFF_X + 128 * n + 8 * lc); } pf[_j] = _v; } } while (0)
    XR_PREFETCH(0);
    if (tid < 128) CR[tid] = 0.f;
    for (int it = 0; it < ntile; ++it) {
        const int p0 = TILE_P0(it);
#pragma unroll
        for (int j = 0; j < 3; ++j) { const int r = lr + 32 * j; if (r < 67) *(LAS u32x4*)(XR + r * 272 + lc * 16) = pf[j]; }
        __syncthreads();
        if (it + 1 < ntile) XR_PREFETCH(it + 1);
        { float x0[11], x1[11];
#pragma unroll
          for (int i = 0; i < 11; ++i) { const unsigned w = *(const LAS unsigned*)(XR + (8 * tg + i) * 272 + cp * 4); x0[i] = bflo(w); x1[i] = bfhi(w); }
#pragma unroll
          for (int i = 0; i < 8; ++i) { const float y0 = cw[0][0] * x0[i] + cw[0][1] * x0[i + 1] + cw[0][2] * x0[i + 2] + cw[0][3] * x0[i + 3] + cb[0];
              const float y1 = cw[1][0] * x1[i] + cw[1][1] * x1[i + 1] + cw[1][2] * x1[i + 2] + cw[1][3] * x1[i + 3] + cb[1];
              *(LAS unsigned*)(XC + (8 * tg + i) * 272 + cp * 4) = pk2(y0, y1); } }
        __syncthreads();
        { bf16x8 af[4];
#pragma unroll
          for (int ks = 0; ks < 4; ++ks) af[ks] = *(const LAS bf16x8*)(XC + (16 * mt + r16) * 272 + (32 * ks + 8 * q4) * 2);
          f32x4 acc[4];
#pragma unroll
          for (int nt = 0; nt < 4; ++nt) { acc[nt] = (f32x4){0.f, 0.f, 0.f, 0.f};
#pragma unroll
              for (int ks = 0; ks < 4; ++ks) acc[nt] = __builtin_amdgcn_mfma_f32_16x16x32_bf16(af[ks], bw[nt][ks], acc[nt], 0, 0, 0); }
#pragma unroll
          for (int db = 0; db < 2; ++db)
#pragma unroll
              for (int rg = 0; rg < 4; ++rg) { const int t = 16 * mt + 4 * q4 + rg, dloc = 32 * dh + 16 * db + r16;
                  const float gr = acc[db][rg] + br[db], gi = acc[2 + db][rg] + bi[db];
                  const float rr = __builtin_amdgcn_rcpf(1.f + __expf(-gr)), ii = __builtin_amdgcn_rcpf(1.f + __expf(-gi));
                  const float la = -sp8[db] * rr; float a = __expf(la);
                  const float x2 = 2.f * la;
                  const float ser = -x2 * (1.f + 0.5f * x2 * (1.f + (1.f / 3.f) * x2 * (1.f + 0.25f * x2 * (1.f + 0.2f * x2))));
                  const float om = (x2 > -0.125f) ? ser : (1.f - a * a);
                  const float xcv = bf2f(*(const LAS bf16_t*)(XC + t * 272 + (64 * half + dloc) * 2));
                  float bb = sqrtf(om) * (ii * xcv);
                  if (p0 + t < 0) { a = 1.f; bb = 0.f; }
                  AS[t * 64 + dloc] = a; BS[t * 64 + dloc] = bb; } }
        __syncthreads();
        float hl[8], pl[8];
        { float h = 0.f, pr = 1.f;
#pragma unroll
          for (int i = 0; i < 8; ++i) { const int j = 8 * wave + i, t = dir ? 63 - j : j; const float a = AS[t * 64 + lane], bq = BS[t * 64 + lane]; h = a * h + bq; pr *= a; hl[i] = h; pl[i] = pr; }
          SM[(wave * 64 + lane) * 2] = pr; SM[(wave * 64 + lane) * 2 + 1] = h; }
        __syncthreads();
        { float hin = CR[(it & 1) * 64 + lane];
          float sp_[7], sh_[7];
#pragma unroll
          for (int v = 0; v < 7; ++v) { sp_[v] = SM[(v * 64 + lane) * 2]; sh_[v] = SM[(v * 64 + lane) * 2 + 1]; }
#pragma unroll
          for (int v = 0; v < 7; ++v) hin = (v < wave) ? (sp_[v] * hin + sh_[v]) : hin;
#pragma unroll
          for (int i = 0; i < 8; ++i) { const int j = 8 * wave + i, t = dir ? 63 - j : j; const float h = hl[i] + pl[i] * hin; HS[t * 64 + lane] = h; if (i == 7 && wave == 7) CR[((it + 1) & 1) * 64 + lane] = h; } }
        __syncthreads();
        if (p0 >= NMETA) {
            const int c2 = (tid & 31) * 2;
#pragma unroll
            for (int ps = 0; ps < 4; ++ps) { const int t = (tid >> 5) + 16 * ps; const size_t m = (size_t)b * SEQ + (p0 + t - NMETA);
                *(unsigned*)(HO + m * DRNN + 128 * n + 64 * half + c2) = pk2(HS[t * 64 + c2], HS[t * 64 + c2 + 1]); }
        }
    }
    __syncthreads();
#undef TILE_P0
#undef XR_PREFETCH
}

__device__ __forceinline__ void normrope_rows(Frame& F, const Args& A) {
    const int gw = F.vcu * NWAVES + F.wave, NGW = F.G * NWAVES, lane = F.lane;
    bf16_t* Z = (bf16_t*)(F.ws + WS_Z); const bf16_t* ZM = (const bf16_t*)(F.ws + WS_ZM);
    bf16_t* KP = (bf16_t*)(F.ws + WS_KP); bf16_t* VP = (bf16_t*)(F.ws + WS_VP);
    const f32x2* RT = (const f32x2*)(F.ws + WS_ROPE);
    const int g = lane >> 4, i16 = lane & 15, j0 = 2 * i16;
    float gq[8], gk[8];
#pragma unroll
    for (int s = 0; s < 4; ++s) { gq[2 * s] = A.in[IN_QG][32 * s + j0]; gq[2 * s + 1] = A.in[IN_QG][32 * s + j0 + 1]; gk[2 * s] = A.in[IN_KG][32 * s + j0]; gk[2 * s + 1] = A.in[IN_KG][32 * s + j0 + 1]; }
    const int NIT = NB * KPAD;
    for (int it = gw; it < NIT; it += NGW) {
        const int b = it / KPAD, kidx = it - b * KPAD; const bool meta = (kidx >= SEQ) && (kidx < LTOT), pad = kidx >= LTOT;
        const bf16_t* row = meta ? (ZM + (size_t)(kidx - SEQ) * INC) : (Z + (size_t)(b * SEQ + (pad ? 0 : kidx)) * INC);
        if (pad) { const u32x4 z = {0u, 0u, 0u, 0u};
            *(u32x4*)(KP + ((size_t)(b * NKV + g) * KPAD + kidx) * HD + i16 * 8) = z; *(u32x4*)(VP + ((size_t)(b * NKV + g) * KPAD + kidx) * HD + i16 * 8) = z; continue; }
        f32x2 cr0 = {1.f, 0.f}, cr1 = {1.f, 0.f}, cc0 = {1.f, 0.f}, cc1 = {1.f, 0.f};
        if (!meta) { const int prow = kidx >> 6, pcol = kidx & 63; cr0 = RT[prow * 32 + j0]; cr1 = RT[prow * 32 + j0 + 1]; cc0 = RT[pcol * 32 + j0]; cc1 = RT[pcol * 32 + j0 + 1]; }
        { const bf16_t* base = row + OFF_K + g * HD;
          unsigned e[4];
#pragma unroll
          for (int sgm = 0; sgm < 4; ++sgm) e[sgm] = *(const unsigned*)(base + 32 * sgm + j0);
          float x[8]; float ss = 0.f;
#pragma unroll
          for (int sgm = 0; sgm < 4; ++sgm) { x[2 * sgm] = bflo(e[sgm]); x[2 * sgm + 1] = bfhi(e[sgm]); ss += x[2 * sgm] * x[2 * sgm] + x[2 * sgm + 1] * x[2 * sgm + 1]; }
          ss += __shfl_xor(ss, 1); ss += __shfl_xor(ss, 2); ss += __shfl_xor(ss, 4); ss += __shfl_xor(ss, 8);
          const float rstd = 1.f / sqrtf(ss * (1.f / HD) + EPS);
#pragma unroll
          for (int k = 0; k < 8; ++k) x[k] = x[k] * rstd * gk[k];
          float y[8];
          y[0] = x[0] * cr0.x - x[2] * cr0.y; y[2] = x[2] * cr0.x + x[0] * cr0.y;
          y[1] = x[1] * cr1.x - x[3] * cr1.y; y[3] = x[3] * cr1.x + x[1] * cr1.y;
          y[4] = x[4] * cc0.x - x[6] * cc0.y; y[6] = x[6] * cc0.x + x[4] * cc0.y;
          y[5] = x[5] * cc1.x - x[7] * cc1.y; y[7] = x[7] * cc1.x + x[5] * cc1.y;
          bf16_t* dst = KP + ((size_t)(b * NKV + g) * KPAD + kidx) * HD;
#pragma unroll
          for (int sgm = 0; sgm < 4; ++sgm) *(unsigned*)(dst + 32 * sgm + j0) = pk2(y[2 * sgm], y[2 * sgm + 1]); }
        { const u32x4 vv = *(const u32x4*)(row + OFF_V + lane * 8);
          *(u32x4*)(VP + ((size_t)(b * NKV + g) * KPAD + kidx) * HD + i16 * 8) = vv; }
    }
}

__device__ __forceinline__ void combine_rows(Frame& F, const Args& A) {
    const int gw = F.vcu * NWAVES + F.wave, NGW = F.G * NWAVES, lane = F.lane;
    bf16_t* MRG = (bf16_t*)(F.ws + WS_MRG); const bf16_t* HFp = (const bf16_t*)(F.ws + WS_HF); const bf16_t* HBp = (const bf16_t*)(F.ws + WS_HB); const bf16_t* Z = (const bf16_t*)(F.ws + WS_Z);
    for (int m = gw; m < MR; m += NGW) {
        u32x4* ap = (u32x4*)(MRG + (size_t)m * DM) + lane;
        u32x4 av[4]; float sa = 0.f;
#pragma unroll
        for (int j = 0; j < 4; ++j) { av[j] = ap[64 * j];
#pragma unroll
            for (int k = 0; k < 4; ++k) { const float lo = bflo(av[j][k]), hi = bfhi(av[j][k]); sa += lo * lo + hi * hi; } }
        const u32x4* fp = (const u32x4*)(HFp + (size_t)m * DRNN) + lane; const u32x4* bp = (const u32x4*)(HBp + (size_t)m * DRNN) + lane; const u32x4* yp = (const u32x4*)(Z + (size_t)m * INC + OFF_Y) + lane;
        float lv[32]; float sl = 0.f;
#pragma unroll
        for (int j = 0; j < 4; ++j) { const u32x4 f = fp[64 * j], bq = bp[64 * j], y = yp[64 * j];
#pragma unroll
            for (int k = 0; k < 4; ++k) { const float l0 = (bflo(f[k]) + bflo(bq[k])) * gelu_tanh(bflo(y[k])), l1 = (bfhi(f[k]) + bfhi(bq[k])) * gelu_tanh(bfhi(y[k]));
                lv[8 * j + 2 * k] = l0; lv[8 * j + 2 * k + 1] = l1; sl += l0 * l0 + l1 * l1; } }
        const float ra = 1.f / sqrtf(wave_sum(sa) * (1.f / DATT) + EPS), rl = 1.f / sqrtf(wave_sum(sl) * (1.f / DRNN) + EPS);
#pragma unroll
        for (int j = 0; j < 4; ++j) { u32x4 w;
#pragma unroll
            for (int k = 0; k < 4; ++k) w[k] = pk2(bflo(av[j][k]) * ra, bfhi(av[j][k]) * ra);
            ap[64 * j] = w; }
        u32x4* lp = (u32x4*)(MRG + (size_t)m * DM + DATT) + lane;
#pragma unroll
        for (int j = 0; j < 4; ++j) { u32x4 w;
#pragma unroll
            for (int k = 0; k < 4; ++k) w[k] = pk2(lv[8 * j + 2 * k] * rl, lv[8 * j + 2 * k + 1] * rl);
            lp[64 * j] = w; }
    }
}

constexpr int PIECE = 256;
__device__ __forceinline__ unsigned lane_xor1_u(unsigned v) { return (unsigned)__builtin_amdgcn_update_dpp(0, (int)v, 0xB1, 0xF, 0xF, false); }
__device__ __forceinline__ void convert_uv(Frame& F, const Args& A) {
    const int gw = F.vcu * NWAVES + F.wave, NGW = F.G * NWAVES, lane = F.lane;
    f32x4 vn[16];
    if (gw < 2 * NEXP) { const float* src = (gw < NEXP ? A.in[IN_U] + (size_t)gw * DM : A.in[IN_V] + (size_t)(gw - NEXP) * DM) + 4 * lane;
#pragma unroll
        for (int i = 0; i < 16; ++i) vn[i] = *(const f32x4*)(src + 256 * i); }
    for (int r = gw; r < 2 * NEXP; r += NGW) {
        const bool isu = r < NEXP; const int row = isu ? r : r - NEXP;
        f32x4 v[16]; float m = 0.f, ss = 0.f;
#pragma unroll
        for (int i = 0; i < 16; ++i) { const f32x4 x = vn[i]; v[i] = x;
            m = fmaxf(m, fmaxf(fmaxf(fabsf(x.x), fabsf(x.y)), fmaxf(fabsf(x.z), fabsf(x.w)))); ss += (x.x * x.x + x.y * x.y) + (x.z * x.z + x.w * x.w); }
        { const int rn = r + NGW;
          if (rn < 2 * NEXP) { const float* src = (rn < NEXP ? A.in[IN_U] + (size_t)rn * DM : A.in[IN_V] + (size_t)(rn - NEXP) * DM) + 4 * lane;
#pragma unroll
              for (int i = 0; i < 16; ++i) vn[i] = *(const f32x4*)(src + 256 * i); } }
        m = wave_max(m); ss = wave_sum(ss);
        const float rms = sqrtf(ss * (1.f / DM));
        const float step = isu ? fmaxf(fmaxf(0.49f * rms, m * (1.f / 12.f)), 1e-30f) : fmaxf(fmaxf(0.3352f * rms, m * (1.f / 15.f)), 1e-30f), inv = 1.f / step;
        unsigned char* tab = F.ws + (isu ? WS_UB : WS_VB);
        const bool odd = lane & 1;
#pragma unroll
        for (int i = 0; i < 16; ++i) {
            const float xs[4] = {v[i].x * inv, v[i].y * inv, v[i].z * inv, v[i].w * inv};
            unsigned w = 0;
            if (isu) {
#pragma unroll
                for (int k = 0; k < 4; ++k) { const float a = fabsf(xs[k]);
                    const unsigned c = (unsigned)(a > 0.25f) + (unsigned)(a > 0.75f) + (unsigned)(a > 1.25f) + (unsigned)(a > 1.75f) + (unsigned)(a > 2.5f) + (unsigned)(a > 3.5f) + (unsigned)(a > 5.f);
                    w |= (c | (xs[k] < 0.f ? 8u : 0u)) << (4 * k); }
                w = odd ? (w << 16) : w;
            } else {
#pragma unroll
                for (int k = 0; k < 4; ++k) { const unsigned n = (unsigned)min(max((int)floorf(xs[k]) + 8, 0), 15); w |= n << (8 * k); }
                w = odd ? ((w << 4) ^ 0x80808080u) : w;
            }
            w |= lane_xor1_u(w);
            if (!odd) *(unsigned*)(tab + ((size_t)(i >> 1) * NEXP + row) * PIECE + 128 * (i & 1) + 2 * lane) = w;
        }
        if (lane == 0) ((float*)(F.ws + (isu ? WS_SU : WS_SV)))[row] = step;
    }
}

__device__ __forceinline__ int lt_bit(float v, float mid) { return (int)(__float_as_uint(v - mid) >> 31); }
constexpr int CSTR = 17;
#define SKSWZ(row, colB) ((row) * 256 + ((colB) ^ (((row) & 7) << 4)))
__device__ __forceinline__ void topk_unit(Frame& F, const Args& A, int unit) {
    const int h = unit & 7, t0 = (unit >> 3) * 256 + F.wave * 32, lane = F.lane, j = lane & 31, hq = lane >> 5;
    const bf16_t* QP = (const bf16_t*)(F.ws + WS_QP); const bf16_t* SKB = (const bf16_t*)(F.ws + WS_SKB);
    LAS unsigned char* SKL = F.lds;
    LAS u32x2* CAND = (LAS u32x2*)(F.lds + 65536 + F.wave * (32 * 2 * CSTR * 8));
    __syncthreads();
    { const int row = F.tid >> 4, ch = F.tid & 15;
#pragma unroll
      for (int i = 0; i < 8; ++i) { const int rr = row + 32 * i;
          const u32x4 v = *(const u32x4*)(SKB + ((size_t)h * 256 + rr) * 128 + ch * 8);
          *(LAS u32x4*)(SKL + (rr >> 7) * 32768 + SKSWZ(rr & 127, ch * 16)) = v; } }
    __syncthreads();
    float rstd2;
    { const f32x4* sp = (const f32x4*)((const float*)(F.ws + WS_SSQ2) + (size_t)(t0 + j) * 64 + 32 * hq); float s = 0.f;
#pragma unroll
      for (int k = 0; k < 8; ++k) { const f32x4 v = sp[k]; s += (v.x + v.y) + (v.z + v.w); }
      s += __shfl_xor(s, 32);
      rstd2 = 1.f / sqrtf(s * (1.f / DM) + EPS);
      if (h == 0 && hq == 0) ((float*)(F.ws + WS_RSTD2))[t0 + j] = rstd2; }
#pragma nounroll
    for (int p = 0; p < 2; ++p) {
        f32x16 acc[4];
#pragma unroll
        for (int kt = 0; kt < 4; ++kt) acc[kt] = f32x16{};
        const bf16_t* qp = QP + (size_t)(t0 + j) * 2048 + h * 256 + p * 128 + 8 * hq;
        bf16x8 bq[8];
#pragma unroll
        for (int ks = 0; ks < 8; ++ks) bq[ks] = *(const bf16x8*)(qp + 16 * ks);
#pragma unroll
        for (int ks = 0; ks < 8; ++ks) {
#pragma unroll
            for (int kt = 0; kt < 4; ++kt) { const bf16x8 ak = *(const LAS bf16x8*)(SKL + p * 32768 + SKSWZ(32 * kt + j, (16 * ks + 8 * hq) * 2)); acc[kt] = __builtin_amdgcn_mfma_f32_32x32x16_bf16(ak, bq[ks], acc[kt], 0, 0, 0); } }
        float vmx = acc[0][0], vmn = acc[0][0];
#pragma unroll
        for (int kt = 0; kt < 4; ++kt)
#pragma unroll
            for (int r = 0; r < 16; ++r) { vmx = fmaxf(vmx, acc[kt][r]); vmn = fminf(vmn, acc[kt][r]); }
        vmx = fmaxf(vmx, __shfl_xor(vmx, 32)); vmn = fminf(vmn, __shfl_xor(vmn, 32));
        float lo = vmn, hi = vmx + 1.0f, T = vmn; int done = 0;
#pragma nounroll
        for (int iter = 0; iter < 64; ++iter) {
            if (!__any(done == 0)) break;
            const float mid = 0.5f * (lo + hi);
            int c4[4] = {0, 0, 0, 0};
#pragma unroll
            for (int kt = 0; kt < 4; ++kt)
#pragma unroll
                for (int r = 0; r < 16; ++r) c4[kt] += lt_bit(acc[kt][r], mid);
            int c = (c4[0] + c4[1]) + (c4[2] + c4[3]);
            c += __shfl_xor(c, 32); c = NKEYS - c;
            if (done == 0) {
                if (c == PTOPK) { T = mid; done = 1; }
                else if (mid <= lo || mid >= hi) { T = lo; done = 1; }
                else if (c > PTOPK) lo = mid; else hi = mid;
            }
        }
        if (done == 0) T = lo;
        int cm = 0;
#pragma unroll
        for (int kt = 0; kt < 4; ++kt)
#pragma unroll
            for (int r = 0; r < 16; ++r) cm += lt_bit(acc[kt][r], T);
        cm = 64 - cm;
        const int co = __shfl_xor(cm, 32);
        int slot = hq ? co : 0;
        f32x16 rowidx;
        { bf16x8 ac = {0, 0, 0, 0, 0, 0, 0, 0}, bc = {0, 0, 0, 0, 0, 0, 0, 0};
          if (hq == 0) { ac[0] = (short)f2bf((float)j); bc[0] = (short)0x3F80; }
          rowidx = __builtin_amdgcn_mfma_f32_32x32x16_bf16(ac, bc, f32x16{}, 0, 0, 0); }
        LAS u32x2* cb = CAND + (j * 2 + p) * CSTR;
#pragma unroll
        for (int kt = 0; kt < 4; ++kt)
#pragma unroll
            for (int r = 0; r < 16; ++r) { const float v = acc[kt][r];
                const int take = (1 - lt_bit(v, T)) & (int)((unsigned)(slot - PTOPK) >> 31);
                u32x2 w; w.x = __float_as_uint(v); w.y = (unsigned)(32 * kt + (int)rowidx[r]);
                cb[take ? slot : PTOPK] = w; slot += take; }
    }
    LDS_WAIT();
    float sv[16]; int si[16];
    { LAS u32x2* cb = CAND + (j * 2 + hq) * CSTR;
#pragma unroll
      for (int k = 0; k < 16; ++k) { const u32x2 w = cb[k]; sv[k] = __uint_as_float(w.x); si[k] = (int)w.y; } }
#pragma unroll
    for (int k = 2; k <= 16; k <<= 1)
#pragma unroll
        for (int jj = k >> 1; jj > 0; jj >>= 1)
#pragma unroll
            for (int i = 0; i < 16; ++i) { const int l = i ^ jj;
                if (l > i) { const bool desc = ((i & k) == 0); const bool sw = desc ? (sv[i] < sv[l]) : (sv[i] > sv[l]);
                    const float tv = sw ? sv[l] : sv[i], tw = sw ? sv[i] : sv[l]; const int ti = sw ? si[l] : si[i], tj = sw ? si[i] : si[l];
                    sv[i] = tv; sv[l] = tw; si[i] = ti; si[l] = tj; } }
    float s1[16], s2[16]; int i1[16], i2[16];
#pragma unroll
    for (int k = 0; k < 16; ++k) { const float ov = __shfl_xor(sv[k], 32); const int oi = __shfl_xor(si[k], 32);
        s1[k] = hq ? ov : sv[k]; s2[k] = hq ? sv[k] : ov; i1[k] = hq ? oi : si[k]; i2[k] = hq ? si[k] : oi; }
    float cs[50];
    { int q = 0;
#pragma unroll
      for (int a = 0; a < 16; ++a)
#pragma unroll
          for (int b2 = 0; b2 < 16; ++b2) if ((a + 1) * (b2 + 1) <= 16) { cs[q] = s1[a] + s2[b2]; ++q; } }
    float lo = fminf(s1[15] + s2[0], s1[0] + s2[15]), hi = s1[0] + s2[0] + 1.0f, T = lo; int done = 0;
#pragma nounroll
    for (int iter = 0; iter < 64; ++iter) {
        if (!__any(done == 0)) break;
        const float mid = 0.5f * (lo + hi);
        int c4[5] = {0, 0, 0, 0, 0};
#pragma unroll
        for (int q = 0; q < 50; ++q) c4[q % 5] += lt_bit(cs[q], mid);
        const int c = 50 - ((c4[0] + c4[1]) + (c4[2] + c4[3]) + c4[4]);
        if (done == 0) {
            if (c == PTOPK) { T = mid; done = 1; }
            else if (mid <= lo || mid >= hi) { T = lo; done = 1; }
            else if (c > PTOPK) lo = mid; else hi = mid;
        }
    }
    if (done == 0) T = lo;
    LAS u32x2* wb = CAND + (j * 2) * CSTR;
    if (hq == 0) { int slot = 0; int q = 0;
#pragma unroll
        for (int a = 0; a < 16; ++a)
#pragma unroll
            for (int b2 = 0; b2 < 16; ++b2) if ((a + 1) * (b2 + 1) <= 16) {
                const int take = (1 - lt_bit(cs[q], T)) & (int)((unsigned)(slot - PTOPK) >> 31);
                u32x2 w; w.x = __float_as_uint(cs[q]); w.y = (unsigned)(i1[a] * NKEYS + i2[b2]);
                wb[take ? slot : PTOPK] = w; slot += take; ++q; } }
    LDS_WAIT();
    float wv[16]; int wi[16]; float mx = -1e30f;
#pragma unroll
    for (int k = 0; k < 16; ++k) { const u32x2 w = wb[k]; wv[k] = __uint_as_float(w.x); wi[k] = (int)w.y; mx = fmaxf(mx, wv[k]); }
    float se = 0.f;
#pragma unroll
    for (int k = 0; k < 16; ++k) { wv[k] = __expf((wv[k] - mx) * rstd2); se += wv[k]; }
    const float inv = 1.f / se;
    int* IDX = (int*)(F.ws + WS_IDX) + (size_t)(t0 + j) * PE + h * PTOPK + 8 * hq; float* GT = (float*)(F.ws + WS_GATE) + (size_t)(t0 + j) * PE + h * PTOPK + 8 * hq;
    float* SUT = (float*)(F.ws + WS_SUT) + (size_t)(t0 + j) * PE + h * PTOPK + 8 * hq; float* GS = (float*)(F.ws + WS_GS) + (size_t)(t0 + j) * PE + h * PTOPK + 8 * hq;
#pragma unroll
    for (int k = 0; k < 8; ++k) { const int id = hq ? wi[8 + k] : wi[k]; const float gte = (hq ? wv[8 + k] : wv[k]) * inv;
        IDX[k] = id; GT[k] = gte; SUT[k] = ((const float*)(F.ws + WS_SU))[id]; GS[k] = gte * ((const float*)(F.ws + WS_SV))[id]; }
    LDS_WAIT();
}

__device__ __forceinline__ int row_sum16(int v) {
    v += __builtin_amdgcn_update_dpp(0, v, 0xB1, 0xF, 0xF, false);
    v += __builtin_amdgcn_update_dpp(0, v, 0x4E, 0xF, 0xF, false);
    v += __builtin_amdgcn_update_dpp(0, v, 0x141, 0xF, 0xF, false);
    v += __builtin_amdgcn_update_dpp(0, v, 0x128, 0xF, 0xF, false);
    return v;
}
typedef int i32x8 __attribute__((ext_vector_type(8)));
struct PeerUMeta { u32x4 hv; int id0, id1; float rstd2; };
__device__ __forceinline__ void peer_u_meta(Frame& F, int t, int x, PeerUMeta& M) {
    const int lane = F.lane;
    const bf16_t* H1B = (const bf16_t*)(F.ws + WS_XN);
    M.hv = *(const u32x4*)(H1B + (size_t)t * DM + 512 * x + 8 * lane);
    const int* IDX = (const int*)(F.ws + WS_IDX) + (size_t)t * PE;
    M.id0 = IDX[lane]; M.id1 = IDX[64 + lane]; M.rstd2 = ((const float*)(F.ws + WS_RSTD2))[t];
}
__device__ __forceinline__ int wave_sum_i(int v) { v = row_sum16(v); v += __shfl_xor(v, 16); v += __shfl_xor(v, 32); return v; }
__device__ __forceinline__ int row_max16i(int v) {
    v = max(v, __builtin_amdgcn_update_dpp(0, v, 0xB1, 0xF, 0xF, false)); v = max(v, __builtin_amdgcn_update_dpp(0, v, 0x4E, 0xF, 0xF, false));
    v = max(v, __builtin_amdgcn_update_dpp(0, v, 0x141, 0xF, 0xF, false)); v = max(v, __builtin_amdgcn_update_dpp(0, v, 0x128, 0xF, 0xF, false));
    return v;
}
__device__ __forceinline__ float quad_swap1(float v) { return __builtin_bit_cast(float, __builtin_amdgcn_update_dpp(0, __builtin_bit_cast(int, v), 0xB1, 0xF, 0xF, false)); }
#ifndef PROBE_MODE
#define PROBE_MODE 0
#endif
__device__ __forceinline__ float quad_swap2(float v) { return __builtin_bit_cast(float, __builtin_amdgcn_update_dpp(0, __builtin_bit_cast(int, v), 0x4E, 0xF, 0xF, false)); }
__device__ __forceinline__ float row_ror4(float v) { return __builtin_bit_cast(float, __builtin_amdgcn_update_dpp(0, __builtin_bit_cast(int, v), 0x124, 0xF, 0xF, false)); }
__device__ __forceinline__ void peer_u_issue(const unsigned char* UBs, int idv, int lane, u32x4 (&w)[16]) {
    const int ei = lane & 15, gk = lane >> 4, r4 = ei >> 2, quarter = ei & 3;
#pragma unroll
    for (int b = 0; b < 16; ++b) { const int row = __builtin_amdgcn_ds_bpermute((16 * r4 + b) * 4, idv);
        w[b] = *(const u32x4*)(UBs + (((unsigned)row << 8) + 64u * (unsigned)gk + 16u * (unsigned)quarter)); }
}
__device__ __forceinline__ float sel4(float a, float b, float c, float d, unsigned m0, unsigned m1, unsigned m2, unsigned m3) {
    return __builtin_bit_cast(float, (__builtin_bit_cast(unsigned, a) & m0) | (__builtin_bit_cast(unsigned, b) & m1) | (__builtin_bit_cast(unsigned, c) & m2) | (__builtin_bit_cast(unsigned, d) & m3)); }
__device__ __forceinline__ void peer_u_consume(const u32x4 (&w)[16], const i32x8& B, int lane, unsigned m0, unsigned m1, unsigned m2, unsigned m3, float& keep) {
    const int ei = lane & 15;
#pragma unroll
    for (int b0 = 0; b0 < 16; b0 += 4) {
        f32x4 D[4];
#pragma unroll
        for (int k = 0; k < 4; ++k) { const f32x4 z = {0.f, 0.f, 0.f, 0.f};
            const i32x8 a = {(int)w[b0 + k].x, (int)w[b0 + k].y, (int)w[b0 + k].z, (int)w[b0 + k].w, 0, 0, 0, 0};
            D[k] = __builtin_amdgcn_mfma_scale_f32_16x16x128_f8f6f4(a, B, z, 4, 0, 0, 0x7f7f7f7f, 0, 0x7f7f7f7f); }
        __builtin_amdgcn_sched_barrier(0);
        float v[4];
#pragma unroll
        for (int k = 0; k < 4; ++k) v[k] = sel4(D[k].x, D[k].y, D[k].z, D[k].w, m0, m1, m2, m3);
#pragma unroll
        for (int k = 0; k < 4; ++k) v[k] += quad_swap1(v[k]);
#pragma unroll
        for (int k = 0; k < 4; ++k) v[k] += quad_swap2(v[k]);
#pragma unroll
        for (int k = 0; k < 4; ++k) v[k] += row_ror4(v[k]);
#pragma unroll
        for (int k = 0; k < 4; ++k) keep = (ei == b0 + k) ? v[k] : keep;
    }
}
__device__ __forceinline__ float peer_u_xquant(Frame& F, const PeerUMeta& M, const float (&g2s)[8], i32x8& B) {
    const int lane = F.lane, ei = lane & 15, g = lane >> 4, qn = (ei >> 1) & 3;
    LAS unsigned char* XB = F.lds + F.wave * 1024;
    float xf[8];
    { const float rs = M.rstd2; const u32x4 hv = M.hv;
      xf[0] = bflo(hv.x) * rs * g2s[0]; xf[1] = bfhi(hv.x) * rs * g2s[1]; xf[2] = bflo(hv.y) * rs * g2s[2]; xf[3] = bfhi(hv.y) * rs * g2s[3];
      xf[4] = bflo(hv.z) * rs * g2s[4]; xf[5] = bfhi(hv.z) * rs * g2s[5]; xf[6] = bflo(hv.w) * rs * g2s[6]; xf[7] = bfhi(hv.w) * rs * g2s[7]; }
    float m = 0.f;
#pragma unroll
    for (int i = 0; i < 8; ++i) m = fmaxf(m, fabsf(xf[i]));
    int mi = row_max16i(__builtin_bit_cast(int, m)); mi = max(mi, __shfl_xor(mi, 16)); mi = max(mi, __shfl_xor(mi, 32));
    m = fmaxf(__builtin_bit_cast(float, mi), 1e-30f); const float sx = m * (1.f / 224.f), inv = 224.f * __builtin_amdgcn_rcpf(m);
    { u32x2 hi, lo;
#pragma unroll
      for (int d = 0; d < 2; ++d) { const float a0 = xf[4 * d] * inv, a1 = xf[4 * d + 1] * inv, a2 = xf[4 * d + 2] * inv, a3 = xf[4 * d + 3] * inv;
          int h = __builtin_amdgcn_cvt_pk_fp8_f32(a0, a1, 0, false); h = __builtin_amdgcn_cvt_pk_fp8_f32(a2, a3, h, true);
          const f32x2 b01 = __builtin_amdgcn_cvt_pk_f32_fp8(h, false), b23 = __builtin_amdgcn_cvt_pk_f32_fp8(h, true);
          int l = __builtin_amdgcn_cvt_pk_fp8_f32(a0 - b01.x, a1 - b01.y, 0, false); l = __builtin_amdgcn_cvt_pk_fp8_f32(a2 - b23.x, a3 - b23.y, l, true);
          hi[d] = (unsigned)h; lo[d] = (unsigned)l; }
      *(LAS u32x2*)(XB + 8 * lane) = hi; *(LAS u32x2*)(XB + 512 + 8 * lane) = lo; }
    LDS_WAIT();
    { LAS const unsigned char* p = XB + ((ei & 1) ? 512 : 0) + 128 * (g >> 1) + 32 * qn + 16 * (g & 1);
      const u32x4 b0 = *(LAS const u32x4*)p, b1 = *(LAS const u32x4*)(p + 256);
      B = i32x8{(int)b0.x, (int)b0.y, (int)b0.z, (int)b0.w, (int)b1.x, (int)b1.y, (int)b1.z, (int)b1.w}; }
    LDS_WAIT();
    return sx;
}
__device__ __forceinline__ void peer_u_meta_async(Frame& F, int t, int x, PeerUMeta& M) {
    const int lane = F.lane;
    const bf16_t* hp = (const bf16_t*)(F.ws + WS_XN) + (size_t)t * DM + 512 * x + 8 * lane;
    const int* ip = (const int*)(F.ws + WS_IDX) + (size_t)t * PE + lane; const float* rp = (const float*)(F.ws + WS_RSTD2) + t;
    asm volatile("global_load_dwordx4 %0, %1, off" : "=v"(M.hv) : "v"(hp) : "memory");
    asm volatile("global_load_dword %0, %1, off" : "=v"(M.id0) : "v"(ip) : "memory");
    asm volatile("global_load_dword %0, %1, off offset:256" : "=v"(M.id1) : "v"(ip) : "memory");
    asm volatile("global_load_dword %0, %1, off" : "=v"(M.rstd2) : "v"(rp) : "memory");
}
template <bool DRY> __device__ __forceinline__ void peer_u_loop(Frame& F, int x, int tb, int tstep, const float (&g2s)[8]) {
    const int lane = F.lane;
    const unsigned char* UBs = F.ws + WS_UB + (size_t)x * NEXP * PIECE;
    PeerUMeta M, Mn, Mn2;
    peer_u_meta(F, tb, x, M); peer_u_meta(F, tb + tstep, x, Mn); Mn2 = Mn;
    u32x4 wA[16], wB[16];
    peer_u_issue(UBs, M.id0, lane, wA);
    unsigned m0, m1, m2, m3; { const int qn = (lane >> 1) & 3; m0 = qn == 0 ? ~0u : 0u; m1 = qn == 1 ? ~0u : 0u; m2 = qn == 2 ? ~0u : 0u; m3 = qn == 3 ? ~0u : 0u; asm volatile("" : "+v"(m0), "+v"(m1), "+v"(m2), "+v"(m3)); }
    i32x8 B, Bn; float sx = peer_u_xquant(F, M, g2s, B), sxn = sx; Bn = B;
#pragma nounroll
    for (int t = tb; t < MR; t += tstep) {
        if (t + 2 * tstep < MR) peer_u_meta_async(F, t + 2 * tstep, x, Mn2);
        float keep0 = 0.f, keep1 = 0.f;
        peer_u_issue(UBs, M.id1, lane, wB);
        __builtin_amdgcn_sched_barrier(0);
        peer_u_consume(wA, B, lane, m0, m1, m2, m3, keep0);
        __builtin_amdgcn_sched_barrier(0);
        if (t + tstep < MR) { peer_u_issue(UBs, Mn.id0, lane, wA); __builtin_amdgcn_sched_barrier(0); sxn = peer_u_xquant(F, Mn, g2s, Bn); }
        __builtin_amdgcn_sched_barrier(0);
        peer_u_consume(wB, B, lane, m0, m1, m2, m3, keep1);
        __builtin_amdgcn_sched_barrier(0);
        if constexpr (!DRY) { float* pa = (float*)(F.ws + WS_PACT) + ((size_t)t * 8 + x) * PE;
            pa[lane] = keep0 * sx; pa[64 + lane] = keep1 * sx; }
        else asm volatile("" :: "v"(keep0), "v"(keep1));
        asm volatile("" : "+v"(Mn2.hv), "+v"(Mn2.id0), "+v"(Mn2.id1), "+v"(Mn2.rstd2));
        M = Mn; Mn = Mn2; B = Bn; sx = sxn;
    }
}
typedef int i32x4 __attribute__((ext_vector_type(4)));
struct PeerVRest { float pa0[8], pa1[8]; float su0, su1, gs0, gs1; u32x4 hv; };
struct PeerVIds { int id0, id1; };
__device__ __forceinline__ void peer_v_ids(Frame& F, int t, PeerVIds& I) { const int* IDX = (const int*)(F.ws + WS_IDX) + (size_t)t * PE; I.id0 = IDX[F.lane]; I.id1 = IDX[64 + F.lane]; }
__device__ __forceinline__ void peer_v_rest(Frame& F, int t, int x, PeerVRest& R) {
    const int lane = F.lane, r = lane >> 4, sp = lane & 15;
    const float* SUT = (const float*)(F.ws + WS_SUT) + (size_t)t * PE; const float* GS = (const float*)(F.ws + WS_GS) + (size_t)t * PE;
    R.su0 = SUT[lane]; R.su1 = SUT[64 + lane]; R.gs0 = GS[lane]; R.gs1 = GS[64 + lane];
    const float* pa = (const float*)(F.ws + WS_PACT) + (size_t)t * 8 * PE;
#pragma unroll
    for (int xx = 0; xx < 8; ++xx) { R.pa0[xx] = pa[xx * PE + lane]; R.pa1[xx] = pa[xx * PE + 64 + lane]; }
    R.hv = *(const u32x4*)((const bf16_t*)(F.ws + WS_XN) + (size_t)t * DM + 512 * x + 32 * sp + 8 * r);
}
__device__ __forceinline__ void peer_v_ids_async(Frame& F, int t, PeerVIds& I) {
    const int* ip = (const int*)(F.ws + WS_IDX) + (size_t)t * PE + F.lane;
    asm volatile("global_load_dword %0, %1, off" : "=v"(I.id0) : "v"(ip) : "memory");
    asm volatile("global_load_dword %0, %1, off offset:256" : "=v"(I.id1) : "v"(ip) : "memory");
}
__device__ __forceinline__ void peer_v_rest_async(Frame& F, int t, int x, PeerVRest& R) {
    const int lane = F.lane, r = lane >> 4, sp = lane & 15;
    const float* sp_ = (const float*)(F.ws + WS_SUT) + (size_t)t * PE + lane; const float* gp = (const float*)(F.ws + WS_GS) + (size_t)t * PE + lane;
    const float* pa = (const float*)(F.ws + WS_PACT) + (size_t)t * 8 * PE + lane;
    const bf16_t* hp = (const bf16_t*)(F.ws + WS_XN) + (size_t)t * DM + 512 * x + 32 * sp + 8 * r;
    asm volatile("global_load_dword %0, %1, off" : "=v"(R.su0) : "v"(sp_) : "memory");
    asm volatile("global_load_dword %0, %1, off offset:256" : "=v"(R.su1) : "v"(sp_) : "memory");
    asm volatile("global_load_dword %0, %1, off" : "=v"(R.gs0) : "v"(gp) : "memory");
    asm volatile("global_load_dword %0, %1, off offset:256" : "=v"(R.gs1) : "v"(gp) : "memory");
#define PA_LD(xx) asm volatile("global_load_dword %0, %2, off offset:%3\n\tglobal_load_dword %1, %2, off offset:%4" : "=&v"(R.pa0[xx]), "=&v"(R.pa1[xx]) : "v"(pa), "n"((xx) * 512), "n"((xx) * 512 + 256) : "memory")
    PA_LD(0); PA_LD(1); PA_LD(2); PA_LD(3); PA_LD(4); PA_LD(5); PA_LD(6); PA_LD(7);
#undef PA_LD
    asm volatile("global_load_dwordx4 %0, %1, off" : "=v"(R.hv) : "v"(hp) : "memory");
}
__device__ __forceinline__ void peer_v_pin(PeerVRest& R) {
    asm volatile("" : "+v"(R.su0), "+v"(R.su1), "+v"(R.gs0), "+v"(R.gs1), "+v"(R.hv));
#pragma unroll
    for (int xx = 0; xx < 8; ++xx) asm volatile("" : "+v"(R.pa0[xx]), "+v"(R.pa1[xx]));
}
__device__ __forceinline__ void peer_v_prologue(Frame& F, const PeerVRest& R, float& sw, int& qw) {
    const int lane = F.lane;
    LAS unsigned char* QW8 = F.lds + F.wave * 256;
    float a0 = 0.f, a1 = 0.f;
#pragma unroll
    for (int xx = 0; xx < 8; ++xx) { a0 += R.pa0[xx]; a1 += R.pa1[xx]; }
    const float w0 = R.gs0 * gelu_tanh(a0 * R.su0), w1 = R.gs1 * gelu_tanh(a1 * R.su1);
    int wmi = row_max16i(__builtin_bit_cast(int, fmaxf(fabsf(w0), fabsf(w1)))); wmi = max(wmi, __shfl_xor(wmi, 16)); wmi = max(wmi, __shfl_xor(wmi, 32));
    const float wm = fmaxf(__builtin_bit_cast(float, wmi), 1e-30f); sw = wm * (1.f / 127.f); const float winv = 127.f * __builtin_amdgcn_rcpf(wm);
    const int q0 = max(min((int)__builtin_rintf(w0 * winv), 127), -127), q1 = max(min((int)__builtin_rintf(w1 * winv), 127), -127);
    qw = wave_sum_i(q0 + q1);
    QW8[((lane >> 4) * 4 + (lane & 3)) * 4 + ((lane >> 2) & 3)] = (unsigned char)(q0 & 0xff);
    QW8[(((64 + lane) >> 4) * 4 + (lane & 3)) * 4 + ((lane >> 2) & 3)] = (unsigned char)(q1 & 0xff);
    LDS_WAIT();
}
template <bool DRY> __device__ __forceinline__ void peer_v_issue4(const unsigned char* VBs, int idv, int lane, int gg, u32x4 (&w)[16]) {
    const int r = lane >> 4, sp = lane & 15;
#pragma unroll
    for (int k = 0; k < 4; ++k) { const int q = 4 * gg + k; const int row = __builtin_amdgcn_ds_bpermute((4 * q + r) * 4, idv);
#if PROBE_MODE == 1
        if constexpr (DRY) { const unsigned ur = (unsigned)row + r; w[q] = u32x4{ur, ur * 3u, ur * 5u, ur * 7u}; } else
#endif
        w[q] = *(const u32x4*)(VBs + (((unsigned)row << 8) + 16u * (unsigned)sp)); }
}
template <bool DRY> __device__ __forceinline__ void peer_v_round(Frame& F, const unsigned char* VBs, u32x4 (&w)[16], int h, int idv_next, int lane, const unsigned (&sel)[4], i32x4 (&Dl)[4], i32x4 (&Dh)[4]) {
    const int r = lane >> 4;
    LAS const unsigned char* QW8 = F.lds + F.wave * 256;
#pragma unroll
    for (int gg = 0; gg < 4; ++gg) {
        i32x4 blo[4], bhi[4];
#pragma unroll
        for (int j = 0; j < 4; ++j) {
            blo[j] = i32x4{(int)(w[4 * gg][j] & 0x0F0F0F0Fu), (int)(w[4 * gg + 1][j] & 0x0F0F0F0Fu), (int)(w[4 * gg + 2][j] & 0x0F0F0F0Fu), (int)(w[4 * gg + 3][j] & 0x0F0F0F0Fu)};
            bhi[j] = i32x4{(int)(w[4 * gg][j] & 0xF0F0F0F0u), (int)(w[4 * gg + 1][j] & 0xF0F0F0F0u), (int)(w[4 * gg + 2][j] & 0xF0F0F0F0u), (int)(w[4 * gg + 3][j] & 0xF0F0F0F0u)}; }
        __builtin_amdgcn_sched_barrier(0);
        peer_v_issue4<DRY>(VBs, idv_next, lane, gg, w);
        __builtin_amdgcn_sched_barrier(0);
#if PROBE_MODE == 2
        if constexpr (DRY) { _Pragma("unroll") for (int j = 0; j < 4; ++j) { Dl[j].x ^= blo[j].x ^ blo[j].y ^ blo[j].z ^ blo[j].w; Dh[j].x ^= bhi[j].x ^ bhi[j].y ^ bhi[j].z ^ bhi[j].w; } continue; }
#endif
        const unsigned wpk = *(const LAS unsigned*)(QW8 + ((4 * h + gg) * 4 + r) * 4);
        const i32x4 a = {(int)__builtin_amdgcn_perm(wpk, wpk, sel[0]), (int)__builtin_amdgcn_perm(wpk, wpk, sel[1]), (int)__builtin_amdgcn_perm(wpk, wpk, sel[2]), (int)__builtin_amdgcn_perm(wpk, wpk, sel[3])};
#pragma unroll
        for (int j = 0; j < 4; ++j) { Dl[j] = __builtin_amdgcn_mfma_i32_16x16x64_i8(a, blo[j], Dl[j], 0, 0, 0); Dh[j] = __builtin_amdgcn_mfma_i32_16x16x64_i8(a, bhi[j], Dh[j], 0, 0, 0); }
        __builtin_amdgcn_sched_barrier(0);
    }
}
__device__ __forceinline__ int sel4i(int a, int b, int c, int d, unsigned m0, unsigned m1, unsigned m2, unsigned m3) { return (int)(((unsigned)a & m0) | ((unsigned)b & m1) | ((unsigned)c & m2) | ((unsigned)d & m3)); }
template <bool DRY> __device__ __forceinline__ void peer_v_loop(Frame& F, int x, int tb, int tstep) {
    const int lane = F.lane, r = lane >> 4, sp = lane & 15;
    const unsigned char* VBs = F.ws + WS_VB + (size_t)x * NEXP * PIECE;
    unsigned sel[4];
#pragma unroll
    for (int e = 0; e < 4; ++e) sel[e] = (0x0C0C0C0Cu & ~(0xFFu << (8 * (lane & 3)))) | ((unsigned)e << (8 * (lane & 3)));
    unsigned m0 = r == 0 ? ~0u : 0u, m1 = r == 1 ? ~0u : 0u, m2 = r == 2 ? ~0u : 0u, m3 = r == 3 ? ~0u : 0u;
    asm volatile("" : "+v"(m0), "+v"(m1), "+v"(m2), "+v"(m3));
    PeerVIds I, In, I2; PeerVRest R, Rn;
    peer_v_ids(F, tb, I); peer_v_ids(F, tb + tstep, In); I2 = In;
    peer_v_rest(F, tb, x, R); Rn = R;
    u32x4 w[16];
#pragma unroll
    for (int gg = 0; gg < 4; ++gg) peer_v_issue4<DRY>(VBs, I.id0, lane, gg, w);
    float sw; int qw; u32x4 hv = R.hv;
    peer_v_prologue(F, R, sw, qw);
#pragma nounroll
    for (int t = tb; t < MR; t += tstep) {
        const bool more = t + tstep < MR;
        if (more) peer_v_rest_async(F, t + tstep, x, Rn);
        if (t + 2 * tstep < MR) peer_v_ids_async(F, t + 2 * tstep, I2);
        i32x4 Dl[4], Dh[4];
#pragma unroll
        for (int j = 0; j < 4; ++j) { Dl[j] = i32x4{0, 0, 0, 0}; Dh[j] = i32x4{0, 0, 0, 0}; }
        peer_v_round<DRY>(F, VBs, w, 0, I.id1, lane, sel, Dl, Dh);
        peer_v_round<DRY>(F, VBs, w, 1, In.id0, lane, sel, Dl, Dh);
        if constexpr (!DRY) {
            int a8[8];
            a8[0] = sel4i(Dl[0].x, Dl[1].x, Dl[2].x, Dl[3].x, m0, m1, m2, m3); a8[1] = sel4i(Dl[0].y, Dl[1].y, Dl[2].y, Dl[3].y, m0, m1, m2, m3);
            a8[2] = sel4i(Dl[0].z, Dl[1].z, Dl[2].z, Dl[3].z, m0, m1, m2, m3); a8[3] = sel4i(Dl[0].w, Dl[1].w, Dl[2].w, Dl[3].w, m0, m1, m2, m3);
            a8[4] = sel4i(Dh[0].x, Dh[1].x, Dh[2].x, Dh[3].x, m0, m1, m2, m3); a8[5] = sel4i(Dh[0].y, Dh[1].y, Dh[2].y, Dh[3].y, m0, m1, m2, m3);
            a8[6] = sel4i(Dh[0].z, Dh[1].z, Dh[2].z, Dh[3].z, m0, m1, m2, m3); a8[7] = sel4i(Dh[0].w, Dh[1].w, Dh[2].w, Dh[3].w, m0, m1, m2, m3);
            const float c75 = 7.5f * (float)qw, c05 = 0.5f * (float)qw;
            f32x4 o0, o1;
            o0.x = bflo(hv.x) + sw * ((float)a8[0] - c75); o0.y = bfhi(hv.x) + sw * ((float)a8[1] - c75); o0.z = bflo(hv.y) + sw * ((float)a8[2] - c75); o0.w = bfhi(hv.y) + sw * ((float)a8[3] - c75);
            o1.x = bflo(hv.z) + sw * ((float)(a8[4] >> 4) + c05); o1.y = bfhi(hv.z) + sw * ((float)(a8[5] >> 4) + c05); o1.z = bflo(hv.w) + sw * ((float)(a8[6] >> 4) + c05); o1.w = bfhi(hv.w) + sw * ((float)(a8[7] >> 4) + c05);
            float* op = F.out + (size_t)t * DM + 512 * x + 32 * sp + 8 * r;
            __builtin_nontemporal_store(o0, (f32x4*)op); __builtin_nontemporal_store(o1, (f32x4*)(op + 4));
        } else { _Pragma("unroll") for (int j = 0; j < 4; ++j) asm volatile("" :: "v"(Dl[j]), "v"(Dh[j])); }
        if (more) { peer_v_pin(Rn); hv = Rn.hv; peer_v_prologue(F, Rn, sw, qw); }
        asm volatile("" : "+v"(I2.id0), "+v"(I2.id1));
        I = In; In = I2;
    }
}

template <int ONLY> __global__ void __launch_bounds__(NWAVES * 64, 2) mega(Args args) {
    extern __shared__ __attribute__((aligned(16))) unsigned char lds[];
    Frame F;
    F.lds = (LAS unsigned char*)lds; F.ldsg = (char*)lds;
    F.tid = threadIdx.x; F.lane = F.tid & 63; F.wave = __builtin_amdgcn_readfirstlane(F.tid >> 6);
    F.G = gridDim.x; { const int bx = blockIdx.x; F.vcu = (F.G % 8 == 0) ? (bx % 8) * (F.G / 8) + bx / 8 : bx; }
    F.out = args.out; F.ws = args.ws;
    const int lo = args.ph_lo, hi = args.ph_hi;
#define IN(k) ((ONLY < 0 || ONLY == (k)) && lo <= (k) && (k) < hi)
    XcdBarrier bar; bar.bar = nullptr; bar.x = 0; bar.st = nullptr;
    if constexpr (ONLY < 0) {
        volatile LAS unsigned* MISC = (volatile LAS unsigned*)(F.lds + LDS_MISC);
        if (F.tid < 64) MISC[F.tid] = 0u;
        __syncthreads();
        bar = xcd_barrier_post((unsigned*)(F.ws + WS_CTL) + 4096, MISC + 8);
    }
#ifndef PROBE_REPEAT
#define PROBE_REPEAT 0
#endif
#define NREP(k) (((PROBE_REPEAT >> (k)) & 1) ? 2 : 1)
#define SEAM(k) do { if constexpr (ONLY < 0) { if (IN(k) && IN((k) + 1)) xcd_barrier(bar); } } while (0)

    if (IN(0)) { for (int rep = 0; rep < NREP(0); ++rep) { p0_prologue(F, args); if (rep + 1 < NREP(0)) xcd_barrier(bar); } }
    SEAM(0);
    if (IN(1)) for (int rep = 0; rep < NREP(1); ++rep) {
        if (rep) xcd_barrier(bar);
        p1_meta_gemm(F, args);
        pg8::Gemm g{(const bf16_t*)(F.ws + WS_XN), (const bf16_t*)(F.ws + WS_WT1), MR, INC, DM}; pg8::StaticOrder S; S.init(MR, INC, F.G, (int)blockIdx.x);
        pg8::EpiBf16 E{(bf16_t*)(F.ws + WS_Z), INC};
        pg8::gemm_phase<pg8::EpiBf16>(F.lds, g, S, E);
    }
    SEAM(1);
    if (IN(2)) {
        for (int rep = 0; rep < NREP(2); ++rep) { if (rep) xcd_barrier(bar); for (int u = F.vcu; u < 256; u += F.G) { if (u & 1) scan_unit<1>(F, args, u); else scan_unit<0>(F, args, u); } }
        normrope_rows(F, args);
    }
    SEAM(2);
    if (IN(3)) for (int rep = 0; rep < NREP(3); ++rep) {
        if (rep) xcd_barrier(bar);
        const bf16_t* Z = (const bf16_t*)(F.ws + WS_Z); const bf16_t* KP = (const bf16_t*)(F.ws + WS_KP); const bf16_t* VP = (const bf16_t*)(F.ws + WS_VP); bf16_t* MRG = (bf16_t*)(F.ws + WS_MRG);
        for (int u = F.vcu; u < NB * NQ * (SEQ / 256); u += F.G) {
            const int grp = u >> 6, within = u & 63, b = grp >> 2, kvh = grp & 3, hq = within >> 4, qb = within & 15, h = kvh * 4 + hq;
            att::attn_unit(Z + (size_t)(b * SEQ + qb * 256) * INC + h * HD, KP + (size_t)(b * NKV + kvh) * KPAD * HD, VP + (size_t)(b * NKV + kvh) * KPAD * HD,
                           MRG + (size_t)(b * SEQ + qb * 256) * DM + h * HD, F.ldsg, qb * 256, args.in[IN_QG], (const f32x2*)(F.ws + WS_ROPE));
        }
    }
    SEAM(3);
    if (IN(4)) { combine_rows(F, args); }
    SEAM(4);
    if (IN(5)) for (int rep = 0; rep < NREP(5); ++rep) {
        if (rep) xcd_barrier(bar);
        pg8::Gemm g{(const bf16_t*)(F.ws + WS_MRG), (const bf16_t*)(F.ws + WS_WT2), MR, DM, DM}; pg8::StaticOrder S; S.init(MR, DM, F.G, (int)blockIdx.x);
        pg8::EpiResid E{args.in[IN_X], F.out, (bf16_t*)(F.ws + WS_XN), (float*)(F.ws + WS_SSQ2), DM};
        pg8::gemm_phase<pg8::EpiResid>(F.lds, g, S, E);
    }
    SEAM(5);
    if (IN(6)) for (int rep = 0; rep < NREP(6); ++rep) {
        if (rep) xcd_barrier(bar);
        convert_uv(F, args);
        pg8::Gemm g{(const bf16_t*)(F.ws + WS_XN), (const bf16_t*)(F.ws + WS_WT3), MR, 2048, DM}; pg8::StaticOrder S; S.init(MR, 2048, F.G, (int)blockIdx.x);
        pg8::EpiBf16 E{(bf16_t*)(F.ws + WS_QP), 2048};
        pg8::gemm_phase<pg8::EpiBf16>(F.lds, g, S, E);
    }
    SEAM(6);
    if (IN(7)) { for (int rep = 0; rep < NREP(7); ++rep) { if (rep) xcd_barrier(bar); for (int u = F.vcu; u < MR / 32; u += F.G) topk_unit(F, args, u); } }
    SEAM(7);
    if (IN(8)) {
        const int x = (int)blockIdx.x & 7, y = (int)blockIdx.x >> 3, ny = F.G >> 3;
        float g2s[8];
#pragma unroll
        for (int i = 0; i < 8; ++i) g2s[i] = args.in[IN_G2][512 * x + 8 * F.lane + i];
        const int tstep = ny * NWAVES;
        if (NREP(8) == 2) { peer_u_loop<true>(F, x, y * NWAVES + F.wave, tstep, g2s); xcd_barrier(bar); }
        peer_u_loop<false>(F, x, y * NWAVES + F.wave, tstep, g2s);
    }
    SEAM(8);
    if (IN(9)) {
        const int x = (int)blockIdx.x & 7, y = (int)blockIdx.x >> 3, ny = F.G >> 3; const int tstep = ny * NWAVES;
        if (NREP(9) == 2) { peer_v_loop<true>(F, x, y * NWAVES + F.wave, tstep); xcd_barrier(bar); }
        peer_v_loop<false>(F, x, y * NWAVES + F.wave, tstep);
    }
#undef IN
#undef SEAM
}

template <int P> static void launch_phase(int grid, hipStream_t stream, Args a) {
    static bool attr = false;
    if (!attr) { if (hipFuncSetAttribute((const void*)mega<P>, hipFuncAttributeMaxDynamicSharedMemorySize, LDS_BYTES) != hipSuccess) fprintf(stderr, "hipFuncSetAttribute failed (phase %d)\n", P); attr = true; }
    a.ph_lo = P; a.ph_hi = P + 1;
    hipLaunchKernelGGL(mega<P>, dim3(grid), dim3(NWAVES * 64), LDS_BYTES, stream, a);
}
extern "C" void kernel_launch(void* const* d_in, const int* in_sizes, int n_in, void* d_out, int out_size, void* d_ws, size_t ws_size, hipStream_t stream) {
    static int grid = 0;
    if (grid == 0) {
        if (n_in != 21 || out_size != MR * DM || ws_size < WS_END) { fprintf(stderr, "kernel_launch: unexpected shapes n_in %d out %d ws %zu\n", n_in, out_size, ws_size); grid = -1; return; }
        int dev = 0, cus = 0;
        (void)hipGetDevice(&dev); (void)hipDeviceGetAttribute(&cus, hipDeviceAttributeMultiprocessorCount, dev);
        grid = (cus / 8) * 8;
        if (grid < 8) { fprintf(stderr, "kernel_launch: device with %d CUs not supported\n", cus); grid = -1; return; }
#if N_LAUNCH_MODE == 1
        int per_cu = 0;
        if (hipFuncSetAttribute((const void*)mega<-1>, hipFuncAttributeMaxDynamicSharedMemorySize, LDS_BYTES) != hipSuccess) { fprintf(stderr, "kernel_launch: hipFuncSetAttribute failed\n"); grid = -1; return; }
        if (hipOccupancyMaxActiveBlocksPerMultiprocessor(&per_cu, (const void*)mega<-1>, NWAVES * 64, LDS_BYTES) != hipSuccess || per_cu < 1) { fprintf(stderr, "kernel_launch: occupancy query %d\n", per_cu); grid = -1; return; }
        (void)hipGetLastError();
#endif
    }
    if (grid < 0) return;
    Args a{};
    for (int i = 0; i < 21; ++i) a.in[i] = (const float*)d_in[i];
    a.out = (float*)d_out; a.ws = (unsigned char*)d_ws;
#if N_LAUNCH_MODE == 0
    launch_phase<0>(grid, stream, a); launch_phase<1>(grid, stream, a); launch_phase<2>(grid, stream, a); launch_phase<3>(grid, stream, a); launch_phase<4>(grid, stream, a);
    launch_phase<5>(grid, stream, a); launch_phase<6>(grid, stream, a); launch_phase<7>(grid, stream, a); launch_phase<8>(grid, stream, a); launch_phase<9>(grid, stream, a);
#else
    if (hipMemsetAsync((char*)d_ws + WS_CTL, 0, 65536, stream) != hipSuccess) { fprintf(stderr, "kernel_launch: memset failed\n"); return; }
    a.ph_lo = 0; a.ph_hi = NPHASE;
    void* kargs[] = {&a};
    hipError_t e = hipLaunchCooperativeKernel((const void*)mega<-1>, dim3(grid), dim3(NWAVES * 64), kargs, LDS_BYTES, stream);
    if (e != hipSuccess) fprintf(stderr, "cooperative launch failed: %s (grid %d)\n", hipGetErrorString(e), grid);
#endif
    const hipError_t le = hipPeekAtLastError();
    if (le != hipSuccess) fprintf(stderr, "kernel_launch: launch failed: %s\n", hipGetErrorName(le));
}
```

```cpp
#include <hip/hip_runtime.h>
#include <hip/hip_cooperative_groups.h>
#include <cstdio>
#include <cstdint>
namespace cg = cooperative_groups;

#ifndef N_LAUNCH_MODE
#define N_LAUNCH_MODE 1
#endif

#define GAS __attribute__((address_space(1)))
#define LAS __attribute__((address_space(3)))
typedef unsigned short bf16_t;
typedef short bf16x8 __attribute__((ext_vector_type(8)));
typedef short s16x4 __attribute__((ext_vector_type(4)));
typedef float f32x2 __attribute__((ext_vector_type(2)));
typedef float f32x4 __attribute__((ext_vector_type(4)));
typedef float f32x16 __attribute__((ext_vector_type(16)));
typedef unsigned u32x2 __attribute__((ext_vector_type(2)));
typedef unsigned u32x4 __attribute__((ext_vector_type(4)));
typedef __bf16 bf16x2 __attribute__((ext_vector_type(2)));

constexpr int DM = 4096, NB = 4, SEQ = 4096, NMETA = 16, LTOT = SEQ + NMETA;
constexpr int MR = NB * SEQ;
constexpr int INC = 7168, OFF_K = 2048, OFF_V = 2560, OFF_X = 3072, OFF_Y = 5120;
constexpr int HD = 128, NQ = 16, NKV = 4, DATT = 2048, DRNN = 2048;
constexpr int KPAD = 4224;
constexpr int NT_REAL = 64;
constexpr int PH = 8, NKEYS = 128, PDQ = 256, PTOPK = 16, PE = 128, NEXP = 16384;
constexpr float EPS = 1e-6f;

constexpr size_t MiB = 1u << 20;
constexpr size_t WS_CTL = 0;
constexpr size_t WS_ROPE = 1 * MiB;
constexpr size_t WS_RSTD2 = 1 * MiB + 65536;
constexpr size_t WS_SU = 1 * MiB + 131072;
constexpr size_t WS_SV = 1 * MiB + 196608;
constexpr size_t WS_SKB = 2 * MiB;
constexpr size_t WS_ZM = 2 * MiB + 524288;
constexpr size_t WS_WG = 3 * MiB;
constexpr size_t WS_WT1 = 5 * MiB;
constexpr size_t WS_WT2 = 61 * MiB;
constexpr size_t WS_WT3 = 93 * MiB;
constexpr size_t WS_XN = 109 * MiB;
constexpr size_t WS_KP = 238 * MiB;
constexpr size_t WS_VP = 255 * MiB;
constexpr size_t WS_MRG = 272 * MiB;
constexpr size_t WS_SSQ2 = 400 * MiB;
constexpr size_t WS_IDX = 404 * MiB;
constexpr size_t WS_GATE = 412 * MiB;
constexpr size_t WS_QP = 420 * MiB;
constexpr size_t WS_Z = 484 * MiB;
constexpr size_t WS_HF = 708 * MiB;
constexpr size_t WS_HB = 772 * MiB;
constexpr size_t WS_UB = 484 * MiB;
constexpr size_t WS_VB = 516 * MiB;
constexpr size_t WS_SUT = 336 * MiB;
constexpr size_t WS_GS = 344 * MiB;
constexpr size_t WS_PACT = 272 * MiB;
constexpr size_t WS_END = 836 * MiB;

constexpr int LDS_BYTES = 147456; constexpr int LDS_MISC = 147456 - 256;
constexpr int NWAVES = 8;
constexpr int NPHASE = 10;

__device__ __forceinline__ unsigned f2bf(float f) { unsigned u = __builtin_bit_cast(unsigned, f); return (u + 0x7fffu + ((u >> 16) & 1u)) >> 16; }
__device__ __forceinline__ unsigned pk2(float lo, float hi) { return f2bf(lo) | (f2bf(hi) << 16); }
__device__ __forceinline__ float bflo(unsigned w) { return __builtin_bit_cast(float, w << 16); }
__device__ __forceinline__ float bfhi(unsigned w) { return __builtin_bit_cast(float, w & 0xffff0000u); }
__device__ __forceinline__ float bf2f(bf16_t b) { return __builtin_bit_cast(float, ((unsigned)b) << 16); }
__device__ __forceinline__ unsigned cvt_pk_bf16(float lo, float hi) { unsigned r; asm volatile("v_cvt_pk_bf16_f32 %0, %1, %2" : "=v"(r) : "v"(lo), "v"(hi)); return r; }
__device__ __forceinline__ float wave_sum(float v) {
#pragma unroll
    for (int o = 1; o < 64; o <<= 1) v += __shfl_xor(v, o);
    return v;
}
__device__ __forceinline__ float gelu_tanh(float x) {
    const float y = 0.7978845608028654f * (x + 0.044715f * x * x * x);
    const float e = __expf(2.f * y);
    const float th = 1.f - 2.f / (1.f + e);
    return 0.5f * x * (1.f + th);
}
__device__ __forceinline__ float sigmoidf_(float x) { return 1.f / (1.f + __expf(-x)); }
__device__ __forceinline__ float dot2bf(unsigned w, unsigned x, float acc) { return __builtin_amdgcn_fdot2_f32_bf16(__builtin_bit_cast(bf16x2, w), __builtin_bit_cast(bf16x2, x), acc, false); }
__device__ __forceinline__ float ub0(unsigned x) { float r; asm("v_cvt_f32_ubyte0 %0, %1" : "=v"(r) : "v"(x)); return r; }
__device__ __forceinline__ float ub1(unsigned x) { float r; asm("v_cvt_f32_ubyte1 %0, %1" : "=v"(r) : "v"(x)); return r; }
__device__ __forceinline__ float ub2(unsigned x) { float r; asm("v_cvt_f32_ubyte2 %0, %1" : "=v"(r) : "v"(x)); return r; }
__device__ __forceinline__ float ub3(unsigned x) { float r; asm("v_cvt_f32_ubyte3 %0, %1" : "=v"(r) : "v"(x)); return r; }
__device__ __forceinline__ float wave_max(float v) {
#pragma unroll
    for (int o = 1; o < 64; o <<= 1) v = fmaxf(v, __shfl_xor(v, o));
    return v;
}
__device__ __forceinline__ unsigned pack_i8x4(float a, float b, float c, float d, int bias) {
    const int ia = (int)__builtin_rintf(a) + bias, ib = (int)__builtin_rintf(b) + bias, ic = (int)__builtin_rintf(c) + bias, id = (int)__builtin_rintf(d) + bias;
    return (unsigned)(ia & 0xff) | ((unsigned)(ib & 0xff) << 8) | ((unsigned)(ic & 0xff) << 16) | ((unsigned)id << 24);
}
#define LDS_WAIT() asm volatile("s_waitcnt lgkmcnt(0)" ::: "memory")

namespace pg8 {
constexpr int BM = 256, BK = 64, HALF = 128, HTB = HALF * BK * 2, STAGE_BYTES = 8 * HTB, NXCD = 8, WGM = 8;
__host__ __device__ __forceinline__ int lds_byte(int r, int c) { const int st = (r >> 4) * 2 + (c >> 5), rr = r & 15, cc = c & 31, ob = rr * 64 + cc * 2; return st * 1024 + (ob ^ (((ob >> 9) & 1) << 5)); }
__host__ __device__ __forceinline__ void stage_rc(int b, int& R, int& C) { const int st = b / 1024, sb = b % 1024, swz = sb ^ (((sb >> 9) & 1) << 5); R = (st >> 1) * 16 + swz / 64; C = (st & 1) * 32 + (swz % 64) / 2; }
__host__ __device__ __forceinline__ int perm32(int rho) { const int n = rho >> 4, i = rho & 15; return 8 * (i >> 2) + 4 * n + (i & 3); }
struct Unit { int pm, pn; };
struct Gemm { const bf16_t* A; const bf16_t* Bt; int M, N, K; };
struct StaticOrder {
    int nM, nN, nwg, G, c;
    __host__ __device__ void init(int M, int N, int G_, int c_) { nM = M / BM; nN = N / BM; nwg = nM * nN; G = G_; c = c_; }
    __host__ __device__ bool next(int i, Unit& u) const {
        const long L = (long)i * G + c; if (L >= nwg) return false;
        int wgid = (int)L; { const int q = nwg / NXCD, r = nwg % NXCD, xcd = wgid % NXCD, off = wgid / NXCD; wgid = (xcd < r ? xcd * (q + 1) : r * (q + 1) + (xcd - r) * q) + off; }
        const int nig = WGM * nN, gid = wgid / nig, fm = gid * WGM, gsz = (nM - fm) < WGM ? (nM - fm) : WGM;
        u.pm = fm + ((wgid % nig) % gsz); u.pn = (wgid % nig) / gsz; return true;
    }
};
struct EpiBf16 {
    bf16_t* O; int ldc;
    __device__ __forceinline__ void operator()(const f32x4 (&acc)[2][2][4][2], const Unit& u, int wr, int wc, int fr, int fq) const {
        const int row0 = u.pm * BM + wr * 64 + fr; const int col0 = u.pn * BM + wc * 32 + 8 * fq;
#pragma unroll
        for (int ai = 0; ai < 2; ++ai)
#pragma unroll
            for (int m = 0; m < 4; ++m) { bf16_t* rowp = O + (size_t)(row0 + ai * HALF + m * 16) * ldc + col0;
#pragma unroll
                for (int bj = 0; bj < 2; ++bj) { const f32x4 v0 = acc[ai][bj][m][0], v1 = acc[ai][bj][m][1];
                    u32x4 w; w.x = cvt_pk_bf16(v0[0], v0[1]); w.y = cvt_pk_bf16(v0[2], v0[3]); w.z = cvt_pk_bf16(v1[0], v1[1]); w.w = cvt_pk_bf16(v1[2], v1[3]);
                    *(u32x4*)(rowp + bj * HALF) = w; } }
    }
};
struct EpiResid {
    const float* X; float* OUT; bf16_t* HB; float* SSQ; int ldc;
    __device__ __forceinline__ void operator()(const f32x4 (&acc)[2][2][4][2], const Unit& u, int wr, int wc, int fr, int fq) const {
        const int row0 = u.pm * BM + wr * 64 + fr; const int col0 = u.pn * BM + wc * 32 + 8 * fq;
#pragma unroll
        for (int ai = 0; ai < 2; ++ai)
#pragma unroll
            for (int m = 0; m < 4; ++m) { const int row = row0 + ai * HALF + m * 16; const size_t off = (size_t)row * ldc + col0; float ss = 0.f;
#pragma unroll
                for (int bj = 0; bj < 2; ++bj) {
                    const f32x4 x0 = *(const f32x4*)(X + off + bj * HALF), x1 = *(const f32x4*)(X + off + bj * HALF + 4);
                    const f32x4 v0 = acc[ai][bj][m][0] + x0, v1 = acc[ai][bj][m][1] + x1;
                    u32x4 w; w.x = cvt_pk_bf16(v0[0], v0[1]); w.y = cvt_pk_bf16(v0[2], v0[3]); w.z = cvt_pk_bf16(v1[0], v1[1]); w.w = cvt_pk_bf16(v1[2], v1[3]);
                    *(u32x4*)(HB + off + bj * HALF) = w;
                    ss += (v0[0] * v0[0] + v0[1] * v0[1]) + (v0[2] * v0[2] + v0[3] * v0[3]) + (v1[0] * v1[0] + v1[1] * v1[1]) + (v1[2] * v1[2] + v1[3] * v1[3]); }
                ss += __shfl_xor(ss, 16); ss += __shfl_xor(ss, 32);
                if (fq == 0) SSQ[(size_t)row * 64 + u.pn * 4 + wc] = ss; }
    }
};

template <class Epi>
__device__ __forceinline__ void gemm_phase(LAS unsigned char* lds, const Gemm g, const StaticOrder& S, const Epi& E) {
    const int tid = threadIdx.x, wid = __builtin_amdgcn_readfirstlane(tid >> 6), lane = tid & 63, wr = wid >> 2, wc = wid & 3, fr = lane & 15, fq = lane >> 4;
    const int K = g.K, nt = K / BK;
    unsigned voffA[2], voffB[2];
#pragma unroll
    for (int i = 0; i < 2; ++i) { int R, C; stage_rc(tid * 16 + i * 8192, R, C); const int Rb = (R & ~31) + perm32(R & 31);
        voffA[i] = (unsigned)(R * K + C) * 2u; voffB[i] = (unsigned)(Rb * K + C) * 2u; }
    const size_t kstep = (size_t)(BK * 2);
    const size_t hstep = (size_t)HALF * K * 2;
    const size_t tstep = 2 * hstep;
    const unsigned ldsw = (unsigned)wid * 1024u;
    const int aoff = lds_byte(wr * 64 + fr, fq * 8), boff = lds_byte(wc * 32 + fr, fq * 8);
#define PG8_SA(b, h) (((b) * 2 + (h)) * HTB)
#define PG8_SB(b, h) ((4 + (b) * 2 + (h)) * HTB)
#define PG8_STAGE(bufoff, gbase, voff) do { _Pragma("unroll") for (int _i = 0; _i < 2; ++_i) \
        __builtin_amdgcn_global_load_lds((const unsigned*)((const char*)(gbase) + (voff)[_i]), (LAS unsigned*)(lds + (bufoff) + ldsw + _i * 8192), 16, 0, 0); } while (0)
#define PG8_LDA(dst, b, h) do { _Pragma("unroll") for (int m = 0; m < 4; ++m) _Pragma("unroll") for (int k = 0; k < 2; ++k) dst[m][k] = *(const LAS bf16x8*)(lds + PG8_SA(b, h) + aoff + m * 2048 + k * 1024); } while (0)
#define PG8_LDB(dst, b, h) do { _Pragma("unroll") for (int n = 0; n < 2; ++n) _Pragma("unroll") for (int k = 0; k < 2; ++k) dst[n][k] = *(const LAS bf16x8*)(lds + PG8_SB(b, h) + boff + n * 2048 + k * 1024); } while (0)
#define PG8_MMA(ai, bj, At, Bt) do { __builtin_amdgcn_s_setprio(1); _Pragma("unroll") for (int m = 0; m < 4; ++m) _Pragma("unroll") for (int n = 0; n < 2; ++n) _Pragma("unroll") for (int k = 0; k < 2; ++k) \
        acc[ai][bj][m][n] = __builtin_amdgcn_mfma_f32_16x16x32_bf16(Bt[n][k], At[m][k], acc[ai][bj][m][n], 0, 0, 0); __builtin_amdgcn_s_setprio(0); } while (0)
#define PG8_WAIT_V(n) asm volatile("s_waitcnt vmcnt(" #n ")" ::: "memory")
#define PG8_WAIT_L(n) asm volatile("s_waitcnt lgkmcnt(" #n ")" ::: "memory")
#define PG8_BAR __builtin_amdgcn_s_barrier()
#define PG8_SCHED __builtin_amdgcn_sched_barrier(0)
    Unit cur, nxt; int ui = 0;
    if (!S.next(0, cur)) return;
    f32x4 acc[2][2][4][2];
#pragma unroll
    for (int a = 0; a < 2; ++a)
#pragma unroll
        for (int b = 0; b < 2; ++b)
#pragma unroll
            for (int m = 0; m < 4; ++m)
#pragma unroll
                for (int n = 0; n < 2; ++n) acc[a][b][m][n] = (f32x4){0.f, 0.f, 0.f, 0.f};
    bf16x8 At[4][2], B0[2][2], B1[2][2];
    const char* cA = (const char*)g.A + (size_t)cur.pm * tstep; const char* cB = (const char*)g.Bt + (size_t)cur.pn * tstep;
    PG8_STAGE(PG8_SB(0, 0), cB, voffB); PG8_STAGE(PG8_SB(0, 1), cB + hstep, voffB); PG8_STAGE(PG8_SA(0, 0), cA, voffA); PG8_STAGE(PG8_SA(0, 1), cA + hstep, voffA);
    if (wr == 1) PG8_BAR;
    PG8_WAIT_V(2); PG8_BAR;
    PG8_STAGE(PG8_SB(1, 0), cB + kstep, voffB); PG8_STAGE(PG8_SA(1, 0), cA + kstep, voffA); PG8_STAGE(PG8_SB(1, 1), cB + hstep + kstep, voffB);
    PG8_WAIT_V(6); PG8_BAR;
    for (;;) {
        const bool has_next = S.next(ui + 1, nxt);
        const char* nA = has_next ? (const char*)g.A + (size_t)nxt.pm * tstep : cA; const char* nB = has_next ? (const char*)g.Bt + (size_t)nxt.pn * tstep : cB;
        for (int t = 0; t < nt; t += 2) {
            const bool last = (t == nt - 2);
            const char* a1 = cA + (size_t)(t + 1) * kstep;
            const char* a2 = last ? nA : cA + (size_t)(t + 2) * kstep; const char* b2 = last ? nB : cB + (size_t)(t + 2) * kstep;
            const char* a3 = a2 + kstep; const char* b3 = b2 + kstep;
            PG8_LDB(B0, 0, 0); PG8_LDB(B1, 0, 1); PG8_SCHED; PG8_LDA(At, 0, 0); PG8_STAGE(PG8_SA(1, 1), a1 + hstep, voffA);
            PG8_WAIT_V(8); PG8_WAIT_L(0); PG8_BAR; PG8_MMA(0, 0, At, B0); PG8_MMA(0, 1, At, B1); PG8_BAR; PG8_SCHED;
            PG8_LDA(At, 0, 1); PG8_STAGE(PG8_SB(0, 0), b2, voffB); PG8_STAGE(PG8_SB(0, 1), b2 + hstep, voffB); PG8_STAGE(PG8_SA(0, 0), a2, voffA);
            PG8_WAIT_V(8); PG8_WAIT_L(0); PG8_BAR; PG8_MMA(1, 0, At, B0); PG8_MMA(1, 1, At, B1); PG8_BAR; PG8_SCHED;
            PG8_LDB(B0, 1, 0); PG8_LDB(B1, 1, 1); PG8_SCHED; PG8_LDA(At, 1, 0); PG8_STAGE(PG8_SA(0, 1), a2 + hstep, voffA);
            PG8_WAIT_V(8); PG8_WAIT_L(0); PG8_BAR; PG8_MMA(0, 0, At, B0); PG8_MMA(0, 1, At, B1); PG8_BAR; PG8_SCHED;
            PG8_LDA(At, 1, 1); PG8_STAGE(PG8_SB(1, 0), b3, voffB); PG8_STAGE(PG8_SB(1, 1), b3 + hstep, voffB); PG8_STAGE(PG8_SA(1, 0), a3, voffA);
            PG8_WAIT_V(8); PG8_WAIT_L(0); PG8_BAR; PG8_MMA(1, 0, At, B0); PG8_MMA(1, 1, At, B1); PG8_BAR; PG8_SCHED;
        }
        if (wr == 0) PG8_BAR;
        E(acc, cur, wr, wc, fr, fq);
        if (!has_next) break;
#pragma unroll
        for (int a = 0; a < 2; ++a)
#pragma unroll
            for (int b = 0; b < 2; ++b)
#pragma unroll
                for (int m = 0; m < 4; ++m)
#pragma unroll
                    for (int n = 0; n < 2; ++n) acc[a][b][m][n] = (f32x4){0.f, 0.f, 0.f, 0.f};
        cur = nxt; cA = nA; cB = nB; ++ui;
        if (wr == 1) PG8_BAR;
    }
    PG8_WAIT_V(0);
    PG8_BAR;
#undef PG8_SA
#undef PG8_SB
#undef PG8_STAGE
#undef PG8_LDA
#undef PG8_LDB
#undef PG8_MMA
#undef PG8_WAIT_V
#undef PG8_WAIT_L
#undef PG8_BAR
#undef PG8_SCHED
}
}

namespace att {
constexpr int D = 128, NW = 8, QBLK = 32, KVBLK = 64;
constexpr float SCALE = 0.088388347648318440f;
constexpr float THR = 8.f;
constexpr int LDQ = INC, LDK = HD, LDO = DM;
constexpr size_t SHM_V = KVBLK * D * 2, SHM_K = KVBLK * D * 2, SHM_ATTN = 2 * SHM_V + 2 * SHM_K + NW * 64 * 4;
#define KSWZ(row, colB) ((row) * 256 + ((colB) ^ (((row) & 7) << 4)))
#define SBAR() __builtin_amdgcn_sched_barrier(0)
__device__ __forceinline__ int crow(int r, int hi) { return (r & 3) + 8 * (r >> 2) + 4 * hi; }
__device__ __forceinline__ unsigned cvtpk(float lo, float hi) { unsigned r; asm volatile("v_cvt_pk_bf16_f32 %0, %1, %2" : "=v"(r) : "v"(lo), "v"(hi)); return r; }
template <int NV> __device__ __forceinline__ void partialSM(f32x16& p0, f32x16& p1, float& m_reg, float& mn, float& alpha) {
    constexpr float C = SCALE * 1.4426950408889634f;
    float pmax = p0[0];
#pragma unroll
    for (int r = 1; r < 16; ++r) pmax = fmaxf(pmax, p0[r]);
#pragma unroll
    for (int r = 0; r < 16; ++r) pmax = fmaxf(pmax, p1[r]);
    { auto rr = __builtin_amdgcn_permlane32_swap(__float_as_uint(pmax), __float_as_uint(pmax), false, false);
      pmax = fmaxf(__uint_as_float(rr[0]), __uint_as_float(rr[1])); }
    if (__builtin_expect(__all(pmax - m_reg <= THR / SCALE), 1)) { mn = m_reg; alpha = 1.f; }
    else { mn = fmaxf(m_reg, pmax); alpha = __builtin_amdgcn_exp2f((m_reg - mn) * C); m_reg = mn; }
    float mnC = -mn * C;
#pragma unroll
    for (int r = 0; r < 16; ++r) p0[r] = fmaf(p0[r], C, mnC);
#pragma unroll
    for (int r = 0; r < 16; ++r) p1[r] = fmaf(p1[r], C, mnC);
#pragma unroll
    for (int r = 0; r < 16; ++r) p0[r] = __builtin_amdgcn_exp2f(p0[r]);
}
__device__ __forceinline__ void finishSM(f32x16& p0, f32x16& p1, float alpha, float& l_reg, bf16x8& pa0, bf16x8& pa1, bf16x8& pa2, bf16x8& pa3) {
#pragma unroll
    for (int r = 0; r < 16; ++r) p1[r] = __builtin_amdgcn_exp2f(p1[r]);
    float ps = 0;
#pragma unroll
    for (int r = 0; r < 16; ++r) ps += p0[r];
#pragma unroll
    for (int r = 0; r < 16; ++r) ps += p1[r];
    { auto rr = __builtin_amdgcn_permlane32_swap(__float_as_uint(ps), __float_as_uint(ps), false, false);
      ps = __uint_as_float(rr[0]) + __uint_as_float(rr[1]); }
    l_reg = l_reg * alpha + ps;
#define PK4(P, BASE, OUT) do { unsigned a0 = cvtpk(P[BASE + 0], P[BASE + 1]), a1 = cvtpk(P[BASE + 2], P[BASE + 3]);   \
    unsigned b0 = cvtpk(P[BASE + 4], P[BASE + 5]), b1 = cvtpk(P[BASE + 6], P[BASE + 7]);                              \
    auto r0 = __builtin_amdgcn_permlane32_swap(a0, b0, false, false); auto r1 = __builtin_amdgcn_permlane32_swap(a1, b1, false, false); \
    u32x4 w = {r0[0], r1[0], r0[1], r1[1]}; OUT = *reinterpret_cast<bf16x8*>(&w); } while (0)
    PK4(p0, 0, pa0); PK4(p0, 8, pa1); PK4(p1, 0, pa2); PK4(p1, 8, pa3);
#undef PK4
}
__device__ __forceinline__ void qkt(f32x16& p0, f32x16& p1, const bf16_t* Ks, const bf16x8* qr, int r32, int hi) {
    p0 = f32x16{}; p1 = f32x16{};
#pragma unroll
    for (int d0 = 0; d0 < 8; ++d0) { int cb = (d0 * 16 + hi * 8) * 2;
        bf16x8 b0 = *reinterpret_cast<const bf16x8*>((const char*)Ks + KSWZ(r32, cb));
        bf16x8 b1 = *reinterpret_cast<const bf16x8*>((const char*)Ks + KSWZ(32 + r32, cb));
        p0 = __builtin_amdgcn_mfma_f32_32x32x16_bf16(b0, qr[d0], p0, 0, 0, 0);
        p1 = __builtin_amdgcn_mfma_f32_32x32x16_bf16(b1, qr[d0], p1, 0, 0, 0); }
}
__device__ __forceinline__ int v_st(int k, int c) { const int kk = (k & ~0xC) | ((k & 4) << 1) | ((k & 8) >> 1); return ((kk >> 3) * 4 + (c >> 5)) * 512 + ((kk & 7) * 32 + (c & 31)) * 2; }
__device__ __forceinline__ int v_rd_base(int lane) { return ((lane & 3) << 3) | (((lane >> 2) & 3) << 6) | (((lane >> 4) & 1) << 5) | (((lane >> 5) & 1) << 8); }
constexpr int v_rd_off(int d0, int ks, int half) { return d0 * 512 + ks * 4096 + half * 2048; }
template <int OFF> __device__ __forceinline__ s16x4 tr_read(int vb) {
    s16x4 r; asm volatile("ds_read_b64_tr_b16 %0, %1 offset:%2" : "=&v"(r) : "v"(vb), "i"(OFF) : "memory"); return r;
}
template <int D0> __device__ __forceinline__ void pv_one(f32x16& od, int vb, bf16x8 pa0, bf16x8 pa1, bf16x8 pa2, bf16x8 pa3) {
    const s16x4 l0 = tr_read<v_rd_off(D0, 0, 0)>(vb), h0 = tr_read<v_rd_off(D0, 0, 1)>(vb), l1 = tr_read<v_rd_off(D0, 1, 0)>(vb), h1 = tr_read<v_rd_off(D0, 1, 1)>(vb);
    const s16x4 l2 = tr_read<v_rd_off(D0, 2, 0)>(vb), h2 = tr_read<v_rd_off(D0, 2, 1)>(vb), l3 = tr_read<v_rd_off(D0, 3, 0)>(vb), h3 = tr_read<v_rd_off(D0, 3, 1)>(vb);
    asm volatile("s_waitcnt lgkmcnt(0)" ::: "memory"); SBAR();
#define PK(L, H) (bf16x8){L[0], L[1], L[2], L[3], H[0], H[1], H[2], H[3]}
    od = __builtin_amdgcn_mfma_f32_32x32x16_bf16(pa0, PK(l0, h0), od, 0, 0, 0);
    od = __builtin_amdgcn_mfma_f32_32x32x16_bf16(pa1, PK(l1, h1), od, 0, 0, 0);
    od = __builtin_amdgcn_mfma_f32_32x32x16_bf16(pa2, PK(l2, h2), od, 0, 0, 0);
    od = __builtin_amdgcn_mfma_f32_32x32x16_bf16(pa3, PK(l3, h3), od, 0, 0, 0);
#undef PK
}
__device__ __forceinline__ void pv_d0(f32x16* o, int vb, bf16x8 pa0, bf16x8 pa1, bf16x8 pa2, bf16x8 pa3) {
    pv_one<0>(o[0], vb, pa0, pa1, pa2, pa3); pv_one<1>(o[1], vb, pa0, pa1, pa2, pa3); pv_one<2>(o[2], vb, pa0, pa1, pa2, pa3); pv_one<3>(o[3], vb, pa0, pa1, pa2, pa3);
}

__device__ __forceinline__ void attn_unit(const bf16_t* __restrict__ Qb, const bf16_t* __restrict__ Kh, const bf16_t* __restrict__ Vh, bf16_t* __restrict__ Ob, char* lds,
                                          const int s0, const float* __restrict__ gq, const f32x2* __restrict__ RT) {
    const int tid = threadIdx.x, wid = tid >> 6, lane = tid & 63, r32 = lane & 31, hi = lane >> 5;
    bf16_t* V_lds = (bf16_t*)lds; bf16_t* K_lds = (bf16_t*)(lds + 2 * SHM_V);
    float* ws = (float*)(lds + 2 * SHM_V + 2 * SHM_K) + wid * 64; float* li_l = ws; float* al_l = ws + 32;
    float m_reg = -1e30f, l_reg = 0; bf16x8 qr[8];
    const bf16_t* Qw = Qb + (long)(wid * QBLK + r32) * LDQ + hi * 8;
#pragma unroll
    for (int d0 = 0; d0 < 8; ++d0) qr[d0] = *reinterpret_cast<const bf16x8*>(Qw + d0 * 16);
    { float ss = 0.f;
#pragma unroll
      for (int d0 = 0; d0 < 8; ++d0)
#pragma unroll
          for (int j = 0; j < 8; ++j) { const float x = bf2f((bf16_t)qr[d0][j]); ss += x * x; }
      ss += __shfl_xor(ss, 32);
      const float rstd = 1.f / sqrtf(ss * (1.f / HD) + EPS);
      const int sq = s0 + wid * QBLK + r32, prow = sq >> 6, pcol = sq & 63;
#pragma unroll
      for (int pr = 0; pr < 4; ++pr) { const int da = (pr & 1) + 4 * (pr >> 1), db = da + 2; const int pos = (pr < 2) ? prow : pcol;
          const f32x4* cs4 = (const f32x4*)(RT + pos * 32 + (da & 1) * 16 + hi * 8);
          const f32x4* ga4 = (const f32x4*)(gq + da * 16 + hi * 8); const f32x4* gb4 = (const f32x4*)(gq + db * 16 + hi * 8);
          unsigned wa[4], wb[4];
#pragma unroll
          for (int jj = 0; jj < 4; ++jj) { const f32x4 cs = cs4[jj]; const f32x4 ga = ga4[jj >> 1], gb = gb4[jj >> 1];
              const int j = 2 * jj; const float g0a = (jj & 1) ? ga.z : ga.x, g1a = (jj & 1) ? ga.w : ga.y, g0b = (jj & 1) ? gb.z : gb.x, g1b = (jj & 1) ? gb.w : gb.y;
              const float xa0 = bf2f((bf16_t)qr[da][j]) * rstd * g0a, xa1 = bf2f((bf16_t)qr[da][j + 1]) * rstd * g1a;
              const float xb0 = bf2f((bf16_t)qr[db][j]) * rstd * g0b, xb1 = bf2f((bf16_t)qr[db][j + 1]) * rstd * g1b;
              wa[jj] = cvtpk(xa0 * cs.x - xb0 * cs.y, xa1 * cs.z - xb1 * cs.w);
              wb[jj] = cvtpk(xb0 * cs.x + xa0 * cs.y, xb1 * cs.z + xa1 * cs.w); }
          const u32x4 va = {wa[0], wa[1], wa[2], wa[3]}, vb = {wb[0], wb[1], wb[2], wb[3]};
          qr[da] = *reinterpret_cast<const bf16x8*>(&va); qr[db] = *reinterpret_cast<const bf16x8*>(&vb); } }
    f32x16 o[4] = {};
    const int sr = tid >> 4, sc = (tid & 15) * 8, vst0 = v_st(sr, sc), vst1 = v_st(32 + sr, sc);
    const int vb0 = (int)(uintptr_t)V_lds + v_rd_base(lane);
    struct { bf16x8 vs0, vs1, ks0, ks1; } sr_[2];
    const unsigned toff = (unsigned)(sr * LDK + sc) * 2u;
#define SLOAD(i, k0) do { const char* _kb = (const char*)Kh + (size_t)(k0) * (LDK * 2); const char* _vb = (const char*)Vh + (size_t)(k0) * (LDK * 2); \
    sr_[i].vs0 = *reinterpret_cast<const bf16x8*>(_vb + toff); sr_[i].vs1 = *reinterpret_cast<const bf16x8*>(_vb + 32 * LDK * 2 + toff); \
    sr_[i].ks0 = *reinterpret_cast<const bf16x8*>(_kb + toff); sr_[i].ks1 = *reinterpret_cast<const bf16x8*>(_kb + 32 * LDK * 2 + toff); } while (0)
#define SWRITE(b, i) do { *(bf16x8*)((char*)V_lds + (b) * SHM_V + vst0) = sr_[i].vs0;          \
    *(bf16x8*)((char*)V_lds + (b) * SHM_V + vst1) = sr_[i].vs1; int kc = sc * 2;               \
    *(bf16x8*)((char*)K_lds + (b) * SHM_K + KSWZ(sr, kc)) = sr_[i].ks0;                       \
    *(bf16x8*)((char*)K_lds + (b) * SHM_K + KSWZ(32 + sr, kc)) = sr_[i].ks1; } while (0)
#define SWAIT() asm volatile("s_waitcnt vmcnt(4)" ::: "memory")
#define RESC(a) do { if (__any((a) < 1.f)) { if (hi == 0) al_l[r32] = (a); asm volatile("s_waitcnt lgkmcnt(0)" ::: "memory"); \
    _Pragma("unroll") for (int d = 0; d < 4; ++d) _Pragma("unroll") for (int r = 0; r < 16; ++r) o[d][r] *= al_l[crow(r, hi)]; } } while (0)
    f32x16 pA0, pA1, pB0, pB1; float mnA, mnB, alA, alB; bf16x8 pa0, pa1, pa2, pa3; constexpr int NT = KPAD / KVBLK; static_assert(NT == NT_REAL + 2, "tile count");
    constexpr int SE = 0, SO = 1;
    SLOAD(SE, 0); asm volatile("s_waitcnt vmcnt(0)" ::: "memory"); SWRITE(0, SE); __syncthreads();
    qkt(pA0, pA1, K_lds, qr, r32, hi); partialSM<64>(pA0, pA1, m_reg, mnA, alA);
    SLOAD(SO, KVBLK); SLOAD(SE, 2 * KVBLK);
    SWAIT(); SWRITE(1, SO); __syncthreads();
    for (int j = 1; j + 1 < NT; j += 2) {
        SBAR(); qkt(pB0, pB1, (bf16_t*)((char*)K_lds + SHM_K), qr, r32, hi);
        finishSM(pA0, pA1, alA, l_reg, pa0, pa1, pa2, pa3); SBAR();
        SLOAD(SO, (j + 2) * KVBLK); SBAR();
        pv_d0(o, vb0, pa0, pa1, pa2, pa3); partialSM<64>(pB0, pB1, m_reg, mnB, alB);
        __syncthreads(); SWAIT(); SWRITE(0, SE);
        RESC(alB); __syncthreads();
        SBAR(); qkt(pA0, pA1, K_lds, qr, r32, hi);
        finishSM(pB0, pB1, alB, l_reg, pa0, pa1, pa2, pa3); SBAR();
        if (j + 3 < NT) SLOAD(SE, (j + 3) * KVBLK); SBAR();
        pv_d0(o, vb0 + (int)SHM_V, pa0, pa1, pa2, pa3); partialSM<64>(pA0, pA1, m_reg, mnA, alA);
        __syncthreads(); SWAIT(); SWRITE(1, SO);
        RESC(alA); __syncthreads();
    }
    SBAR(); qkt(pB0, pB1, (bf16_t*)((char*)K_lds + SHM_K), qr, r32, hi);
    finishSM(pA0, pA1, alA, l_reg, pa0, pa1, pa2, pa3); SBAR();
    pv_d0(o, vb0, pa0, pa1, pa2, pa3); partialSM<64>(pB0, pB1, m_reg, mnB, alB);
    __syncthreads(); RESC(alB);
    finishSM(pB0, pB1, alB, l_reg, pa0, pa1, pa2, pa3); SBAR();
    pv_d0(o, vb0 + (int)SHM_V, pa0, pa1, pa2, pa3);
    l_reg -= (float)(KPAD - LTOT) * __builtin_amdgcn_exp2f(-m_reg * (SCALE * 1.4426950408889634f));
    if (hi == 0) li_l[r32] = l_reg; asm volatile("s_waitcnt lgkmcnt(0)" ::: "memory");
    float rli[16];
#pragma unroll
    for (int r = 0; r < 16; ++r) rli[r] = __builtin_amdgcn_rcpf(li_l[crow(r, hi)]);
    bf16_t* Ow = Ob + (long)(wid * QBLK) * LDO;
    const int odd = lane & 1;
#pragma unroll
    for (int r = 0; r < 16; r += 2) {
#pragma unroll
        for (int d0 = 0; d0 < 4; ++d0) {
            const float a = o[d0][r] * rli[r], b = o[d0][r + 1] * rli[r + 1];
            const float send = odd ? a : b; const float recv = __shfl_xor(send, 1);
            const unsigned w = odd ? cvtpk(recv, b) : cvtpk(a, recv);
            const int orow = crow(odd ? r + 1 : r, hi);
            *(unsigned*)(Ow + (long)orow * LDO + d0 * 32 + (r32 & ~1)) = w;
        }
    }
    __syncthreads();
#undef SLOAD
#undef SWRITE
#undef SWAIT
#undef RESC
}
}

#define XB_TMO      128
#define XB_XCNT(j)  (256  + 64 * (j))
#define XB_XSUB(j)  (1280 + 64 * (j))
#define XB_XGEN(j)  (2304 + 64 * (j))
#define XB_TOP      3328
#define XB_TOPGEN   3392
#define XCD_BAR_WORDS 3456
#define XB_SPIN_CAP (1u << 22)
__device__ __forceinline__ unsigned xb_ld(unsigned* p)              { return __hip_atomic_load(p, __ATOMIC_RELAXED, __HIP_MEMORY_SCOPE_AGENT); }
__device__ __forceinline__ unsigned xb_add(unsigned* p, unsigned v) { return __hip_atomic_fetch_add(p, v, __ATOMIC_RELAXED, __HIP_MEMORY_SCOPE_AGENT); }
__device__ __forceinline__ unsigned xb_xcc_id() { return (unsigned)__builtin_amdgcn_s_getreg((3 << 11) | 20) & 0xFu; }
#define XB_SPIN(cond, bar) do { unsigned _sp = 0; while (cond) { __builtin_amdgcn_s_sleep(1); \
    if ((++_sp & 255u) == 0u) { if (xb_ld(&(bar)[XB_TMO])) break; if (_sp > XB_SPIN_CAP) { atomicAdd(&(bar)[XB_TMO], 1u); break; } } } } while (0)
struct XcdBarrier { unsigned* bar; unsigned x; volatile LAS unsigned* st; };
__device__ __forceinline__ XcdBarrier xcd_barrier_post(unsigned* bar, volatile LAS unsigned* st) {
    XcdBarrier b; b.bar = bar; b.x = xb_xcc_id(); b.st = st;
    if (threadIdx.x == 0) (void)xb_add(&bar[XB_XCNT(b.x)], 1u);
    return b;
}
__device__ __forceinline__ void xcd_barrier_complete(unsigned* bar, unsigned x, unsigned& nloc, unsigned& nx) {
    const unsigned G = gridDim.x * gridDim.y * gridDim.z;
    unsigned sum, cnt, mine, sp = 0u;
    for (;;) {
        sum = 0u; cnt = 0u; mine = 0u;
#pragma unroll
        for (unsigned j = 0; j < 16; ++j) { const unsigned c = xb_ld(&bar[XB_XCNT(j)]); sum += c; cnt += (c > 0u) ? 1u : 0u; mine = (j == x) ? c : mine; }
        if (sum == G) break;
        __builtin_amdgcn_s_sleep(1);
        if ((++sp & 255u) == 0u) { if (xb_ld(&bar[XB_TMO])) break; if (sp > XB_SPIN_CAP) { atomicAdd(&bar[XB_TMO], 1u); break; } }
    }
    nloc = mine > 0u ? mine : 1u; nx = cnt > 0u ? cnt : 1u;
}
__device__ __forceinline__ void xcd_barrier(const XcdBarrier& b) {
    asm volatile("s_waitcnt vmcnt(0)" ::: "memory");
    __syncthreads();
    if (threadIdx.x == 0) {
        unsigned* bar = b.bar;
        __builtin_amdgcn_s_waitcnt(0);
        unsigned nloc = b.st[0], nx = b.st[1];
        if (nloc == 0u) { xcd_barrier_complete(bar, b.x, nloc, nx); b.st[0] = nloc; b.st[1] = nx; }
        const unsigned old = xb_add(&bar[XB_XSUB(b.x)], 1u);
        const unsigned gen = old / nloc;
        if (old + 1u == (gen + 1u) * nloc) {
            __builtin_amdgcn_fence(__ATOMIC_RELEASE, "agent");
            asm volatile("s_waitcnt vmcnt(0)" ::: "memory");
            const unsigned og = xb_add(&bar[XB_TOP], 1u);
            const unsigned tg = og / nx;
            if (og + 1u == (tg + 1u) * nx) xb_add(&bar[XB_TOPGEN], 1u);
            else XB_SPIN(xb_ld(&bar[XB_TOPGEN]) == tg, bar);
            __builtin_amdgcn_fence(__ATOMIC_ACQUIRE, "agent");
            xb_add(&bar[XB_XGEN(b.x)], 1u);
            asm volatile("s_waitcnt vmcnt(0)" ::: "memory");
        } else {
            XB_SPIN(xb_ld(&bar[XB_XGEN(b.x)]) == gen, bar);
            __builtin_amdgcn_fence(__ATOMIC_ACQUIRE, "agent");
            asm volatile("s_waitcnt vmcnt(0)" ::: "memory");
        }
    }
    __syncthreads();
}

struct Args { const float* in[21]; float* out; unsigned char* ws; int ph_lo, ph_hi; };
struct Frame {
    LAS unsigned char* lds; char* ldsg;
    int tid, lane, wave, vcu, G;
    float* out; unsigned char* ws;
};
#define IN_X 0
#define IN_META 1
#define IN_G1 2
#define IN_WIN 3
#define IN_QG 4
#define IN_KG 5
#define IN_CW 6
#define IN_CB 7
#define IN_WRG 8
#define IN_BRG 9
#define IN_WIG 10
#define IN_BIG 11
#define IN_LAM 12
#define IN_GA 13
#define IN_GL 14
#define IN_WOUT 15
#define IN_G2 16
#define IN_WQ 17
#define IN_SK 18
#define IN_U 19
#define IN_V 20

__device__ __forceinline__ void p0_transpose_item(const float* W, int K, int N, bf16_t* WT, const float* gk, LAS float* scr, int item, int lane) {
    const int nblk = N / 64, kb = item / nblk, nb = item % nblk, k0 = 64 * kb, n0 = 64 * nb;
    const int kq = lane >> 4, nq = lane & 15;
#pragma unroll 8
    for (int i = 0; i < 16; ++i) { const int kk = 4 * i + kq; f32x4 v = *(const f32x4*)(W + (size_t)(k0 + kk) * N + n0 + 4 * nq); if (gk) { const float g = gk[k0 + kk]; v.x *= g; v.y *= g; v.z *= g; v.w *= g; }
        LAS float* d = scr + kk * 65 + 4 * nq; d[0] = v.x; d[1] = v.y; d[2] = v.z; d[3] = v.w; }
    LDS_WAIT(); asm volatile("" ::: "memory");
    const int c = lane & 7;
#pragma unroll
    for (int j = 0; j < 8; ++j) { const int n = (lane >> 3) + 8 * j; const LAS float* sp = scr + (8 * c) * 65 + n;
        u32x4 o; o.x = pk2(sp[0 * 65], sp[1 * 65]); o.y = pk2(sp[2 * 65], sp[3 * 65]); o.z = pk2(sp[4 * 65], sp[5 * 65]); o.w = pk2(sp[6 * 65], sp[7 * 65]);
        *(u32x4*)(WT + (size_t)(n0 + n) * K + k0 + 8 * c) = o; }
    LDS_WAIT(); asm volatile("" ::: "memory");
}
__device__ __forceinline__ void p0_prologue(Frame& F, const Args& A) {
    LAS float* scr = (LAS float*)(F.lds + F.wave * 16640);
    const int gw = F.vcu * NWAVES + F.wave, NGW = F.G * NWAVES, lane = F.lane;
    bf16_t* WT1 = (bf16_t*)(F.ws + WS_WT1); bf16_t* WT2 = (bf16_t*)(F.ws + WS_WT2); bf16_t* WT3 = (bf16_t*)(F.ws + WS_WT3); bf16_t* WG = (bf16_t*)(F.ws + WS_WG);
    constexpr int I_1 = (DM / 64) * (INC / 64), I_2 = (DM / 64) * (DM / 64), I_3 = (DM / 64) * (2048 / 64), I_G = 64 * 4;
    constexpr int NITEMS = I_1 + I_2 + I_3 + I_G;
    for (int it = gw; it < NITEMS; it += NGW) {
        int r = it;
        if (r < I_1) { p0_transpose_item(A.in[IN_WIN], DM, INC, WT1, A.in[IN_G1], scr, r, lane); continue; } r -= I_1;
        if (r < I_2) { const int kb = r / (DM / 64); const float* gk = (kb < 32) ? A.in[IN_GA] : (A.in[IN_GL] - DATT); p0_transpose_item(A.in[IN_WOUT], DM, DM, WT2, gk, scr, r, lane); continue; } r -= I_2;
        if (r < I_3) { p0_transpose_item(A.in[IN_WQ], DM, 2048, WT3, A.in[IN_G2], scr, r, lane); continue; } r -= I_3;
        { const int mat = r >> 2, sub = r & 3; const int dirn = mat >> 1, gate = mat & 1;
          const float* W = (gate ? A.in[IN_WIG] : A.in[IN_WRG]) + (size_t)dirn * 128 * 128;
          p0_transpose_item(W, 128, 128, WG + (size_t)mat * 128 * 128, nullptr, scr, sub, lane); }
    }
    bf16_t* XN = (bf16_t*)(F.ws + WS_XN);
    { f32x4 vn[16];
      if (gw < MR + NMETA) { const f32x4* xr = (const f32x4*)((gw < MR) ? A.in[IN_X] + (size_t)gw * DM : A.in[IN_META] + (size_t)(gw - MR) * DM) + lane;
#pragma unroll
          for (int j = 0; j < 16; ++j) vn[j] = xr[64 * j]; }
      for (int m = gw; m < MR + NMETA; m += NGW) {
        f32x4 v[16]; float s = 0.f;
#pragma unroll
        for (int j = 0; j < 16; ++j) { v[j] = vn[j]; s += (v[j].x * v[j].x + v[j].y * v[j].y) + (v[j].z * v[j].z + v[j].w * v[j].w); }
        { const int mn = m + NGW;
          if (mn < MR + NMETA) { const f32x4* xr = (const f32x4*)((mn < MR) ? A.in[IN_X] + (size_t)mn * DM : A.in[IN_META] + (size_t)(mn - MR) * DM) + lane;
#pragma unroll
              for (int j = 0; j < 16; ++j) vn[j] = xr[64 * j]; } }
        const float rstd = 1.f / sqrtf(wave_sum(s) * (1.f / DM) + EPS);
        u32x2* o8 = (u32x2*)(XN + (size_t)m * DM) + lane;
#pragma unroll
        for (int j = 0; j < 16; ++j) { u32x2 w; w.x = pk2(v[j].x * rstd, v[j].y * rstd); w.y = pk2(v[j].z * rstd, v[j].w * rstd); o8[64 * j] = w; }
      } }
    { const float* sk = A.in[IN_SK]; bf16_t* SKB = (bf16_t*)(F.ws + WS_SKB);
      for (int i = gw * 64 + lane; i < PH * 2 * NKEYS * 128 / 4; i += NGW * 64) { const f32x4 v = ((const f32x4*)sk)[i]; u32x2 w; w.x = pk2(v.x, v.y); w.y = pk2(v.z, v.w); ((u32x2*)SKB)[i] = w; }
      f32x2* RT = (f32x2*)(F.ws + WS_ROPE);
      for (int i = gw * 64 + lane; i < 64 * 32; i += NGW * 64) { const int p = i >> 5, j = i & 31;
          const float inv = exp2f(-(float)j * (13.287712379549449f / 32.f)); const float ang = (float)p * inv;
          float rev = ang * 0.15915494309189535f; rev -= floorf(rev);
          f32x2 cs; cs.x = __builtin_amdgcn_cosf(rev); cs.y = __builtin_amdgcn_sinf(rev); RT[i] = cs; } }
}

__device__ __forceinline__ void p1_meta_gemm(Frame& F, const Args& A) {
    const bf16_t* XNm = (const bf16_t*)(F.ws + WS_XN) + (size_t)MR * DM; const bf16_t* WT1 = (const bf16_t*)(F.ws + WS_WT1); bf16_t* ZM = (bf16_t*)(F.ws + WS_ZM);
    LAS float* red = (LAS float*)F.lds;
    const int lane = F.lane, c16 = lane & 15, q = lane >> 4;
    for (int item = F.vcu; item < (OFF_Y - OFF_K) / 16; item += F.G) {
        const int n0 = OFF_K + 16 * item;
        f32x4 acc = {0.f, 0.f, 0.f, 0.f};
        const bf16_t* ap = XNm + (size_t)c16 * DM + F.wave * 512 + 8 * q; const bf16_t* bp = WT1 + (size_t)(n0 + c16) * DM + F.wave * 512 + 8 * q;
#pragma unroll
        for (int ks = 0; ks < 16; ++ks) { const bf16x8 a = *(const bf16x8*)(ap + 32 * ks), b = *(const bf16x8*)(bp + 32 * ks); acc = __builtin_amdgcn_mfma_f32_16x16x32_bf16(a, b, acc, 0, 0, 0); }
#pragma unroll
        for (int r = 0; r < 4; ++r) red[F.wave * 256 + (4 * q + r) * 16 + c16] = acc[r];
        __syncthreads();
        if (F.tid < 256) { float s = 0.f;
#pragma unroll
            for (int w = 0; w < 8; ++w) s += red[w * 256 + F.tid];
            ZM[(size_t)(F.tid >> 4) * INC + n0 + (F.tid & 15)] = (bf16_t)f2bf(s); }
        __syncthreads();
    }
}

template <int dir> __device__ __forceinline__ void scan_unit(Frame& F, const Args& A, int u) {
    const int half = (u >> 1) & 1, n = (u >> 2) & 15, b = u >> 6;
    const int tid = F.tid, lane = F.lane, wave = F.wave;
    const bf16_t* Z = (const bf16_t*)(F.ws + WS_Z); const bf16_t* ZM = (const bf16_t*)(F.ws + WS_ZM);
    bf16_t* HO = (bf16_t*)(F.ws + (dir ? WS_HB : WS_HF));
    LAS unsigned char* XR = F.lds;
    LAS unsigned char* XC = F.lds + 18432;
    LAS float* AS = (LAS float*)(F.lds + 35840);
    LAS float* BS = (LAS float*)(F.lds + 52224);
    LAS float* HS = (LAS float*)(F.lds + 68608);
    LAS float* SM = (LAS float*)(F.lds + 84992);
    LAS float* CR = (LAS float*)(F.lds + 89088);
    const int mt = wave & 3, dh = wave >> 2, r16 = lane & 15, q4 = lane >> 4;
    bf16x8 bw[4][4];
#pragma unroll
    for (int nt = 0; nt < 4; ++nt) { const int gate = nt >> 1, dcol = 64 * half + 32 * dh + 16 * (nt & 1) + r16;
        const bf16_t* wp = (const bf16_t*)(F.ws + WS_WG) + ((size_t)((dir * 16 + n) * 2 + gate) * 128 + dcol) * 128 + 8 * q4;
#pragma unroll
        for (int ks = 0; ks < 4; ++ks) bw[nt][ks] = *(const bf16x8*)(wp + 32 * ks); }
    float br[2], bi[2], sp8[2];
#pragma unroll
    for (int db = 0; db < 2; ++db) { const int che = 128 * n + 64 * half + 32 * dh + 16 * db + r16;
        br[db] = A.in[IN_BRG][dir * DRNN + che]; bi[db] = A.in[IN_BIG][dir * DRNN + che]; sp8[db] = 8.f * log1pf(__expf(-A.in[IN_LAM][dir * DRNN + che])); }
    const int cp = tid & 63, tg = tid >> 6;
    float cw[2][4], cb[2];
#pragma unroll
    for (int c = 0; c < 2; ++c) { const int ch = 128 * n + 2 * cp + c;
#pragma unroll
        for (int j = 0; j < 4; ++j) cw[c][j] = A.in[IN_CW][j * DRNN + ch];
        cb[c] = A.in[IN_CB][ch]; }
    const int ntile = dir ? 64 : 65;
    const int lr = tid >> 4, lc = tid & 15;
    u32x4 pf[3];
#define TILE_P0(it) (dir ? (NMETA + 64 * (63 - (it))) : ((it) == 0 ? -48 : NMETA + 64 * ((it) - 1)))
#define XR_PREFETCH(it) do { const int _p0 = TILE_P0(it); _Pragma("unroll") for (int _j = 0; _j < 3; ++_j) { const int _r = lr + 32 * _j; const int _p = _p0 - 2 + _r; u32x4 _v = {0u, 0u, 0u, 0u}; \
        if (_r < 67 && _p >= 0 && _p < LTOT) { const bf16_t* _row = (_p < NMETA) ? (ZM + (size_t)_p * INC) : (Z + (size_t)(b * SEQ + _p - NMETA) * INC); _v = *(const u32x4*)(_row + OFF_X + 128 * n + 8 * lc); } pf[_j] = _v; } } while (0)
    XR_PREFETCH(0);
    if (tid < 128) CR[tid] = 0.f;
    for (int it = 0; it < ntile; ++it) {
        const int p0 = TILE_P0(it);
#pragma unroll
        for (int j = 0; j < 3; ++j) { const int r = lr + 32 * j; if (r < 67) *(LAS u32x4*)(XR + r * 272 + lc * 16) = pf[j]; }
        __syncthreads();
        if (it + 1 < ntile) XR_PREFETCH(it + 1);
        { float x0[11], x1[11];
#pragma unroll
          for (int i = 0; i < 11; ++i) { const unsigned w = *(const LAS unsigned*)(XR + (8 * tg + i) * 272 + cp * 4); x0[i] = bflo(w); x1[i] = bfhi(w); }
#pragma unroll
          for (int i = 0; i < 8; ++i) { const float y0 = cw[0][0] * x0[i] + cw[0][1] * x0[i + 1] + cw[0][2] * x0[i + 2] + cw[0][3] * x0[i + 3] + cb[0];
              const float y1 = cw[1][0] * x1[i] + cw[1][1] * x1[i + 1] + cw[1][2] * x1[i + 2] + cw[1][3] * x1[i + 3] + cb[1];
              *(LAS unsigned*)(XC + (8 * tg + i) * 272 + cp * 4) = pk2(y0, y1); } }
        __syncthreads();
        { bf16x8 af[4];
#pragma unroll
          for (int ks = 0; ks < 4; ++ks) af[ks] = *(const LAS bf16x8*)(XC + (16 * mt + r16) * 272 + (32 * ks + 8 * q4) * 2);
          f32x4 acc[4];
#pragma unroll
          for (int nt = 0; nt < 4; ++nt) { acc[nt] = (f32x4){0.f, 0.f, 0.f, 0.f};
#pragma unroll
              for (int ks = 0; ks < 4; ++ks) acc[nt] = __builtin_amdgcn_mfma_f32_16x16x32_bf16(af[ks], bw[nt][ks], acc[nt], 0, 0, 0); }
#pragma unroll
          for (int db = 0; db < 2; ++db)
#pragma unroll
              for (int rg = 0; rg < 4; ++rg) { const int t = 16 * mt + 4 * q4 + rg, dloc = 32 * dh + 16 * db + r16;
                  const float gr = acc[db][rg] + br[db], gi = acc[2 + db][rg] + bi[db];
                  const float rr = __builtin_amdgcn_rcpf(1.f + __expf(-gr)), ii = __builtin_amdgcn_rcpf(1.f + __expf(-gi));
                  const float la = -sp8[db] * rr; float a = __expf(la);
                  const float x2 = 2.f * la;
                  const float ser = -x2 * (1.f + 0.5f * x2 * (1.f + (1.f / 3.f) * x2 * (1.f + 0.25f * x2 * (1.f + 0.2f * x2))));
                  const float om = (x2 > -0.125f) ? ser : (1.f - a * a);
                  const float xcv = bf2f(*(const LAS bf16_t*)(XC + t * 272 + (64 * half + dloc) * 2));
                  float bb = sqrtf(om) * (ii * xcv);
                  if (p0 + t < 0) { a = 1.f; bb = 0.f; }
                  AS[t * 64 + dloc] = a; BS[t * 64 + dloc] = bb; } }
        __syncthreads();
        float hl[8], pl[8];
        { float h = 0.f, pr = 1.f;
#pragma unroll
          for (int i = 0; i < 8; ++i) { const int j = 8 * wave + i, t = dir ? 63 - j : j; const float a = AS[t * 64 + lane], bq = BS[t * 64 + lane]; h = a * h + bq; pr *= a; hl[i] = h; pl[i] = pr; }
          SM[(wave * 64 + lane) * 2] = pr; SM[(wave * 64 + lane) * 2 + 1] = h; }
        __syncthreads();
        { float hin = CR[(it & 1) * 64 + lane];
          float sp_[7], sh_[7];
#pragma unroll
          for (int v = 0; v < 7; ++v) { sp_[v] = SM[(v * 64 + lane) * 2]; sh_[v] = SM[(v * 64 + lane) * 2 + 1]; }
#pragma unroll
          for (int v = 0; v < 7; ++v) hin = (v < wave) ? (sp_[v] * hin + sh_[v]) : hin;
#pragma unroll
          for (int i = 0; i < 8; ++i) { const int j = 8 * wave + i, t = dir ? 63 - j : j; const float h = hl[i] + pl[i] * hin; HS[t * 64 + lane] = h; if (i == 7 && wave == 7) CR[((it + 1) & 1) * 64 + lane] = h; } }
        __syncthreads();
        if (p0 >= NMETA) {
            const int c2 = (tid & 31) * 2;
#pragma unroll
            for (int ps = 0; ps < 4; ++ps) { const int t = (tid >> 5) + 16 * ps; const size_t m = (size_t)b * SEQ + (p0 + t - NMETA);
                *(unsigned*)(HO + m * DRNN + 128 * n + 64 * half + c2) = pk2(HS[t * 64 + c2], HS[t * 64 + c2 + 1]); }
        }
    }
    __syncthreads();
#undef TILE_P0
#undef XR_PREFETCH
}

__device__ __forceinline__ void normrope_rows(Frame& F, const Args& A) {
    const int gw = F.vcu * NWAVES + F.wave, NGW = F.G * NWAVES, lane = F.lane;
    bf16_t* Z = (bf16_t*)(F.ws + WS_Z); const bf16_t* ZM = (const bf16_t*)(F.ws + WS_ZM);
    bf16_t* KP = (bf16_t*)(F.ws + WS_KP); bf16_t* VP = (bf16_t*)(F.ws + WS_VP);
    const f32x2* RT = (const f32x2*)(F.ws + WS_ROPE);
    const int g = lane >> 4, i16 = lane & 15, j0 = 2 * i16;
    float gq[8], gk[8];
#pragma unroll
    for (int s = 0; s < 4; ++s) { gq[2 * s] = A.in[IN_QG][32 * s + j0]; gq[2 * s + 1] = A.in[IN_QG][32 * s + j0 + 1]; gk[2 * s] = A.in[IN_KG][32 * s + j0]; gk[2 * s + 1] = A.in[IN_KG][32 * s + j0 + 1]; }
    const int NIT = NB * KPAD;
    for (int it = gw; it < NIT; it += NGW) {
        const int b = it / KPAD, kidx = it - b * KPAD; const bool meta = (kidx >= SEQ) && (kidx < LTOT), pad = kidx >= LTOT;
        const bf16_t* row = meta ? (ZM + (size_t)(kidx - SEQ) * INC) : (Z + (size_t)(b * SEQ + (pad ? 0 : kidx)) * INC);
        if (pad) { const u32x4 z = {0u, 0u, 0u, 0u};
            *(u32x4*)(KP + ((size_t)(b * NKV + g) * KPAD + kidx) * HD + i16 * 8) = z; *(u32x4*)(VP + ((size_t)(b * NKV + g) * KPAD + kidx) * HD + i16 * 8) = z; continue; }
        f32x2 cr0 = {1.f, 0.f}, cr1 = {1.f, 0.f}, cc0 = {1.f, 0.f}, cc1 = {1.f, 0.f};
        if (!meta) { const int prow = kidx >> 6, pcol = kidx & 63; cr0 = RT[prow * 32 + j0]; cr1 = RT[prow * 32 + j0 + 1]; cc0 = RT[pcol * 32 + j0]; cc1 = RT[pcol * 32 + j0 + 1]; }
        { const bf16_t* base = row + OFF_K + g * HD;
          unsigned e[4];
#pragma unroll
          for (int sgm = 0; sgm < 4; ++sgm) e[sgm] = *(const unsigned*)(base + 32 * sgm + j0);
          float x[8]; float ss = 0.f;
#pragma unroll
          for (int sgm = 0; sgm < 4; ++sgm) { x[2 * sgm] = bflo(e[sgm]); x[2 * sgm + 1] = bfhi(e[sgm]); ss += x[2 * sgm] * x[2 * sgm] + x[2 * sgm + 1] * x[2 * sgm + 1]; }
          ss += __shfl_xor(ss, 1); ss += __shfl_xor(ss, 2); ss += __shfl_xor(ss, 4); ss += __shfl_xor(ss, 8);
          const float rstd = 1.f / sqrtf(ss * (1.f / HD) + EPS);
#pragma unroll
          for (int k = 0; k < 8; ++k) x[k] = x[k] * rstd * gk[k];
          float y[8];
          y[0] = x[0] * cr0.x - x[2] * cr0.y; y[2] = x[2] * cr0.x + x[0] * cr0.y;
          y[1] = x[1] * cr1.x - x[3] * cr1.y; y[3] = x[3] * cr1.x + x[1] * cr1.y;
          y[4] = x[4] * cc0.x - x[6] * cc0.y; y[6] = x[6] * cc0.x + x[4] * cc0.y;
          y[5] = x[5] * cc1.x - x[7] * cc1.y; y[7] = x[7] * cc1.x + x[5] * cc1.y;
          bf16_t* dst = KP + ((size_t)(b * NKV + g) * KPAD + kidx) * HD;
#pragma unroll
          for (int sgm = 0; sgm < 4; ++sgm) *(unsigned*)(dst + 32 * sgm + j0) = pk2(y[2 * sgm], y[2 * sgm + 1]); }
        { const u32x4 vv = *(const u32x4*)(row + OFF_V + lane * 8);
          *(u32x4*)(VP + ((size_t)(b * NKV + g) * KPAD + kidx) * HD + i16 * 8) = vv; }
    }
}

__device__ __forceinline__ void combine_rows(Frame& F, const Args& A) {
    const int gw = F.vcu * NWAVES + F.wave, NGW = F.G * NWAVES, lane = F.lane;
    bf16_t* MRG = (bf16_t*)(F.ws + WS_MRG); const bf16_t* HFp = (const bf16_t*)(F.ws + WS_HF); const bf16_t* HBp = (const bf16_t*)(F.ws + WS_HB); const bf16_t* Z = (const bf16_t*)(F.ws + WS_Z);
    for (int m = gw; m < MR; m += NGW) {
        u32x4* ap = (u32x4*)(MRG + (size_t)m * DM) + lane;
        u32x4 av[4]; float sa = 0.f;
#pragma unroll
        for (int j = 0; j < 4; ++j) { av[j] = ap[64 * j];
#pragma unroll
            for (int k = 0; k < 4; ++k) { const float lo = bflo(av[j][k]), hi = bfhi(av[j][k]); sa += lo * lo + hi * hi; } }
        const u32x4* fp = (const u32x4*)(HFp + (size_t)m * DRNN) + lane; const u32x4* bp = (const u32x4*)(HBp + (size_t)m * DRNN) + lane; const u32x4* yp = (const u32x4*)(Z + (size_t)m * INC + OFF_Y) + lane;
        float lv[32]; float sl = 0.f;
#pragma unroll
        for (int j = 0; j < 4; ++j) { const u32x4 f = fp[64 * j], bq = bp[64 * j], y = yp[64 * j];
#pragma unroll
            for (int k = 0; k < 4; ++k) { const float l0 = (bflo(f[k]) + bflo(bq[k])) * gelu_tanh(bflo(y[k])), l1 = (bfhi(f[k]) + bfhi(bq[k])) * gelu_tanh(bfhi(y[k]));
                lv[8 * j + 2 * k] = l0; lv[8 * j + 2 * k + 1] = l1; sl += l0 * l0 + l1 * l1; } }
        const float ra = 1.f / sqrtf(wave_sum(sa) * (1.f / DATT) + EPS), rl = 1.f / sqrtf(wave_sum(sl) * (1.f / DRNN) + EPS);
#pragma unroll
        for (int j = 0; j < 4; ++j) { u32x4 w;
#pragma unroll
            for (int k = 0; k < 4; ++k) w[k] = pk2(bflo(av[j][k]) * ra, bfhi(av[j][k]) * ra);
            ap[64 * j] = w; }
        u32x4* lp = (u32x4*)(MRG + (size_t)m * DM + DATT) + lane;
#pragma unroll
        for (int j = 0; j < 4; ++j) { u32x4 w;
#pragma unroll
            for (int k = 0; k < 4; ++k) w[k] = pk2(lv[8 * j + 2 * k] * rl, lv[8 * j + 2 * k + 1] * rl);
            lp[64 * j] = w; }
    }
}

constexpr int PIECE = 256;
__device__ __forceinline__ unsigned lane_xor1_u(unsigned v) { return (unsigned)__builtin_amdgcn_update_dpp(0, (int)v, 0xB1, 0xF, 0xF, false); }
__device__ __forceinline__ void convert_uv(Frame& F, const Args& A) {
    const int gw = F.vcu * NWAVES + F.wave, NGW = F.G * NWAVES, lane = F.lane;
    f32x4 vn[16];
    if (gw < 2 * NEXP) { const float* src = (gw < NEXP ? A.in[IN_U] + (size_t)gw * DM : A.in[IN_V] + (size_t)(gw - NEXP) * DM) + 4 * lane;
#pragma unroll
        for (int i = 0; i < 16; ++i) vn[i] = *(const f32x4*)(src + 256 * i); }
    for (int r = gw; r < 2 * NEXP; r += NGW) {
        const bool isu = r < NEXP; const int row = isu ? r : r - NEXP;
        f32x4 v[16]; float m = 0.f, ss = 0.f;
#pragma unroll
        for (int i = 0; i < 16; ++i) { const f32x4 x = vn[i]; v[i] = x;
            m = fmaxf(m, fmaxf(fmaxf(fabsf(x.x), fabsf(x.y)), fmaxf(fabsf(x.z), fabsf(x.w)))); ss += (x.x * x.x + x.y * x.y) + (x.z * x.z + x.w * x.w); }
        { const int rn = r + NGW;
          if (rn < 2 * NEXP) { const float* src = (rn < NEXP ? A.in[IN_U] + (size_t)rn * DM : A.in[IN_V] + (size_t)(rn - NEXP) * DM) + 4 * lane;
#pragma unroll
              for (int i = 0; i < 16; ++i) vn[i] = *(const f32x4*)(src + 256 * i); } }
        m = wave_max(m); ss = wave_sum(ss);
        const float rms = sqrtf(ss * (1.f / DM));
        const float step = isu ? fmaxf(fmaxf(0.49f * rms, m * (1.f / 12.f)), 1e-30f) : fmaxf(fmaxf(0.3352f * rms, m * (1.f / 15.f)), 1e-30f), inv = 1.f / step;
        unsigned char* tab = F.ws + (isu ? WS_UB : WS_VB);
        const bool odd = lane & 1;
#pragma unroll
        for (int i = 0; i < 16; ++i) {
            const float xs[4] = {v[i].x * inv, v[i].y * inv, v[i].z * inv, v[i].w * inv};
            unsigned w = 0;
            if (isu) {
#pragma unroll
                for (int k = 0; k < 4; ++k) { const float a = fabsf(xs[k]);
                    const unsigned c = (unsigned)(a > 0.25f) + (unsigned)(a > 0.75f) + (unsigned)(a > 1.25f) + (unsigned)(a > 1.75f) + (unsigned)(a > 2.5f) + (unsigned)(a > 3.5f) + (unsigned)(a > 5.f);
                    w |= (c | (xs[k] < 0.f ? 8u : 0u)) << (4 * k); }
                w = odd ? (w << 16) : w;
            } else {
#pragma unroll
                for (int k = 0; k < 4; ++k) { const unsigned n = (unsigned)min(max((int)floorf(xs[k]) + 8, 0), 15); w |= n << (8 * k); }
                w = odd ? ((w << 4) ^ 0x80808080u) : w;
            }
            w |= lane_xor1_u(w);
            if (!odd) *(unsigned*)(tab + ((size_t)(i >> 1) * NEXP + row) * PIECE + 128 * (i & 1) + 2 * lane) = w;
        }
        if (lane == 0) ((float*)(F.ws + (isu ? WS_SU : WS_SV)))[row] = step;
    }
}

__device__ __forceinline__ int lt_bit(float v, float mid) { return (int)(__float_as_uint(v - mid) >> 31); }
constexpr int CSTR = 17;
#define SKSWZ(row, colB) ((row) * 256 + ((colB) ^ (((row) & 7) << 4)))
__device__ __forceinline__ void topk_unit(Frame& F, const Args& A, int unit) {
    const int h = unit & 7, t0 = (unit >> 3) * 256 + F.wave * 32, lane = F.lane, j = lane & 31, hq = lane >> 5;
    const bf16_t* QP = (const bf16_t*)(F.ws + WS_QP); const bf16_t* SKB = (const bf16_t*)(F.ws + WS_SKB);
    LAS unsigned char* SKL = F.lds;
    LAS u32x2* CAND = (LAS u32x2*)(F.lds + 65536 + F.wave * (32 * 2 * CSTR * 8));
    __syncthreads();
    { const int row = F.tid >> 4, ch = F.tid & 15;
#pragma unroll
      for (int i = 0; i < 8; ++i) { const int rr = row + 32 * i;
          const u32x4 v = *(const u32x4*)(SKB + ((size_t)h * 256 + rr) * 128 + ch * 8);
          *(LAS u32x4*)(SKL + (rr >> 7) * 32768 + SKSWZ(rr & 127, ch * 16)) = v; } }
    __syncthreads();
    float rstd2;
    { const f32x4* sp = (const f32x4*)((const float*)(F.ws + WS_SSQ2) + (size_t)(t0 + j) * 64 + 32 * hq); float s = 0.f;
#pragma unroll
      for (int k = 0; k < 8; ++k) { const f32x4 v = sp[k]; s += (v.x + v.y) + (v.z + v.w); }
      s += __shfl_xor(s, 32);
      rstd2 = 1.f / sqrtf(s * (1.f / DM) + EPS);
      if (h == 0 && hq == 0) ((float*)(F.ws + WS_RSTD2))[t0 + j] = rstd2; }
#pragma nounroll
    for (int p = 0; p < 2; ++p) {
        f32x16 acc[4];
#pragma unroll
        for (int kt = 0; kt < 4; ++kt) acc[kt] = f32x16{};
        const bf16_t* qp = QP + (size_t)(t0 + j) * 2048 + h * 256 + p * 128 + 8 * hq;
        bf16x8 bq[8];
#pragma unroll
        for (int ks = 0; ks < 8; ++ks) bq[ks] = *(const bf16x8*)(qp + 16 * ks);
#pragma unroll
        for (int ks = 0; ks < 8; ++ks) {
#pragma unroll
            for (int kt = 0; kt < 4; ++kt) { const bf16x8 ak = *(const LAS bf16x8*)(SKL + p * 32768 + SKSWZ(32 * kt + j, (16 * ks + 8 * hq) * 2)); acc[kt] = __builtin_amdgcn_mfma_f32_32x32x16_bf16(ak, bq[ks], acc[kt], 0, 0, 0); } }
        float vmx = acc[0][0], vmn = acc[0][0];
#pragma unroll
        for (int kt = 0; kt < 4; ++kt)
#pragma unroll
            for (int r = 0; r < 16; ++r) { vmx = fmaxf(vmx, acc[kt][r]); vmn = fminf(vmn, acc[kt][r]); }
        vmx = fmaxf(vmx, __shfl_xor(vmx, 32)); vmn = fminf(vmn, __shfl_xor(vmn, 32));
        float lo = vmn, hi = vmx + 1.0f, T = vmn; int done = 0;
#pragma nounroll
        for (int iter = 0; iter < 64; ++iter) {
            if (!__any(done == 0)) break;
            const float mid = 0.5f * (lo + hi);
            int c4[4] = {0, 0, 0, 0};
#pragma unroll
            for (int kt = 0; kt < 4; ++kt)
#pragma unroll
                for (int r = 0; r < 16; ++r) c4[kt] += lt_bit(acc[kt][r], mid);
            int c = (c4[0] + c4[1]) + (c4[2] + c4[3]);
            c += __shfl_xor(c, 32); c = NKEYS - c;
            if (done == 0) {
                if (c == PTOPK) { T = mid; done = 1; }
                else if (mid <= lo || mid >= hi) { T = lo; done = 1; }
                else if (c > PTOPK) lo = mid; else hi = mid;
            }
        }
        if (done == 0) T = lo;
        int cm = 0;
#pragma unroll
        for (int kt = 0; kt < 4; ++kt)
#pragma unroll
            for (int r = 0; r < 16; ++r) cm += lt_bit(acc[kt][r], T);
        cm = 64 - cm;
        const int co = __shfl_xor(cm, 32);
        int slot = hq ? co : 0;
        f32x16 rowidx;
        { bf16x8 ac = {0, 0, 0, 0, 0, 0, 0, 0}, bc = {0, 0, 0, 0, 0, 0, 0, 0};
          if (hq == 0) { ac[0] = (short)f2bf((float)j); bc[0] = (short)0x3F80; }
          rowidx = __builtin_amdgcn_mfma_f32_32x32x16_bf16(ac, bc, f32x16{}, 0, 0, 0); }
        LAS u32x2* cb = CAND + (j * 2 + p) * CSTR;
#pragma unroll
        for (int kt = 0; kt < 4; ++kt)
#pragma unroll
            for (int r = 0; r < 16; ++r) { const float v = acc[kt][r];
                const int take = (1 - lt_bit(v, T)) & (int)((unsigned)(slot - PTOPK) >> 31);
                u32x2 w; w.x = __float_as_uint(v); w.y = (unsigned)(32 * kt + (int)rowidx[r]);
                cb[take ? slot : PTOPK] = w; slot += take; }
    }
    LDS_WAIT();
    float sv[16]; int si[16];
    { LAS u32x2* cb = CAND + (j * 2 + hq) * CSTR;
#pragma unroll
      for (int k = 0; k < 16; ++k) { const u32x2 w = cb[k]; sv[k] = __uint_as_float(w.x); si[k] = (int)w.y; } }
#pragma unroll
    for (int k = 2; k <= 16; k <<= 1)
#pragma unroll
        for (int jj = k >> 1; jj > 0; jj >>= 1)
#pragma unroll
            for (int i = 0; i < 16; ++i) { const int l = i ^ jj;
                if (l > i) { const bool desc = ((i & k) == 0); const bool sw = desc ? (sv[i] < sv[l]) : (sv[i] > sv[l]);
                    const float tv = sw ? sv[l] : sv[i], tw = sw ? sv[i] : sv[l]; const int ti = sw ? si[l] : si[i], tj = sw ? si[i] : si[l];
                    sv[i] = tv; sv[l] = tw; si[i] = ti; si[l] = tj; } }
    float s1[16], s2[16]; int i1[16], i2[16];
#pragma unroll
    for (int k = 0; k < 16; ++k) { const float ov = __shfl_xor(sv[k], 32); const int oi = __shfl_xor(si[k], 32);
        s1[k] = hq ? ov : sv[k]; s2[k] = hq ? sv[k] : ov; i1[k] = hq ? oi : si[k]; i2[k] = hq ? si[k] : oi; }
    float cs[50];
    { int q = 0;
#pragma unroll
      for (int a = 0; a < 16; ++a)
#pragma unroll
          for (int b2 = 0; b2 < 16; ++b2) if ((a + 1) * (b2 + 1) <= 16) { cs[q] = s1[a] + s2[b2]; ++q; } }
    float lo = fminf(s1[15] + s2[0], s1[0] + s2[15]), hi = s1[0] + s2[0] + 1.0f, T = lo; int done = 0;
#pragma nounroll
    for (int iter = 0; iter < 64; ++iter) {
        if (!__any(done == 0)) break;
        const float mid = 0.5f * (lo + hi);
        int c4[5] = {0, 0, 0, 0, 0};
#pragma unroll
        for (int q = 0; q < 50; ++q) c4[q % 5] += lt_bit(cs[q], mid);
        const int c = 50 - ((c4[0] + c4[1]) + (c4[2] + c4[3]) + c4[4]);
        if (done == 0) {
            if (c == PTOPK) { T = mid; done = 1; }
            else if (mid <= lo || mid >= hi) { T = lo; done = 1; }
            else if (c > PTOPK) lo = mid; else hi = mid;
        }
    }
    if (done == 0) T = lo;
    LAS u32x2* wb = CAND + (j * 2) * CSTR;
    if (hq == 0) { int slot = 0; int q = 0;
#pragma unroll
        for (int a = 0; a < 16; ++a)
#pragma unroll
            for (int b2 = 0; b2 < 16; ++b2) if ((a + 1) * (b2 + 1) <= 16) {
                const int take = (1 - lt_bit(cs[q], T)) & (int)((unsigned)(slot - PTOPK) >> 31);
                u32x2 w; w.x = __float_as_uint(cs[q]); w.y = (unsigned)(i1[a] * NKEYS + i2[b2]);
                wb[take ? slot : PTOPK] = w; slot += take; ++q; } }
    LDS_WAIT();
    float wv[16]; int wi[16]; float mx = -1e30f;
#pragma unroll
    for (int k = 0; k < 16; ++k) { const u32x2 w = wb[k]; wv[k] = __uint_as_float(w.x); wi[k] = (int)w.y; mx = fmaxf(mx, wv[k]); }
    float se = 0.f;
#pragma unroll
    for (int k = 0; k < 16; ++k) { wv[k] = __expf((wv[k] - mx) * rstd2); se += wv[k]; }
    const float inv = 1.f / se;
    int* IDX = (int*)(F.ws + WS_IDX) + (size_t)(t0 + j) * PE + h * PTOPK + 8 * hq; float* GT = (float*)(F.ws + WS_GATE) + (size_t)(t0 + j) * PE + h * PTOPK + 8 * hq;
    float* SUT = (float*)(F.ws + WS_SUT) + (size_t)(t0 + j) * PE + h * PTOPK + 8 * hq; float* GS = (float*)(F.ws + WS_GS) + (size_t)(t0 + j) * PE + h * PTOPK + 8 * hq;
#pragma unroll
    for (int k = 0; k < 8; ++k) { const int id = hq ? wi[8 + k] : wi[k]; const float gte = (hq ? wv[8 + k] : wv[k]) * inv;
        IDX[k] = id; GT[k] = gte; SUT[k] = ((const float*)(F.ws + WS_SU))[id]; GS[k] = gte * ((const float*)(F.ws + WS_SV))[id]; }
    LDS_WAIT();
}

__device__ __forceinline__ int row_sum16(int v) {
    v += __builtin_amdgcn_update_dpp(0, v, 0xB1, 0xF, 0xF, false);
    v += __builtin_amdgcn_update_dpp(0, v, 0x4E, 0xF, 0xF, false);
    v += __builtin_amdgcn_update_dpp(0, v, 0x141, 0xF, 0xF, false);
    v += __builtin_amdgcn_update_dpp(0, v, 0x128, 0xF, 0xF, false);
    return v;
}
typedef int i32x8 __attribute__((ext_vector_type(8)));
struct PeerUMeta { u32x4 hv; int id0, id1; float rstd2; };
__device__ __forceinline__ void peer_u_meta(Frame& F, int t, int x, PeerUMeta& M) {
    const int lane = F.lane;
    const bf16_t* H1B = (const bf16_t*)(F.ws + WS_XN);
    M.hv = *(const u32x4*)(H1B + (size_t)t * DM + 512 * x + 8 * lane);
    const int* IDX = (const int*)(F.ws + WS_IDX) + (size_t)t * PE;
    M.id0 = IDX[lane]; M.id1 = IDX[64 + lane]; M.rstd2 = ((const float*)(F.ws + WS_RSTD2))[t];
}
__device__ __forceinline__ int wave_sum_i(int v) { v = row_sum16(v); v += __shfl_xor(v, 16); v += __shfl_xor(v, 32); return v; }
__device__ __forceinline__ int row_max16i(int v) {
    v = max(v, __builtin_amdgcn_update_dpp(0, v, 0xB1, 0xF, 0xF, false)); v = max(v, __builtin_amdgcn_update_dpp(0, v, 0x4E, 0xF, 0xF, false));
    v = max(v, __builtin_amdgcn_update_dpp(0, v, 0x141, 0xF, 0xF, false)); v = max(v, __builtin_amdgcn_update_dpp(0, v, 0x128, 0xF, 0xF, false));
    return v;
}
__device__ __forceinline__ float quad_swap1(float v) { return __builtin_bit_cast(float, __builtin_amdgcn_update_dpp(0, __builtin_bit_cast(int, v), 0xB1, 0xF, 0xF, false)); }
#ifndef PROBE_MODE
#define PROBE_MODE 0
#endif
__device__ __forceinline__ float quad_swap2(float v) { return __builtin_bit_cast(float, __builtin_amdgcn_update_dpp(0, __builtin_bit_cast(int, v), 0x4E, 0xF, 0xF, false)); }
__device__ __forceinline__ float row_ror4(float v) { return __builtin_bit_cast(float, __builtin_amdgcn_update_dpp(0, __builtin_bit_cast(int, v), 0x124, 0xF, 0xF, false)); }
__device__ __forceinline__ void peer_u_issue(const unsigned char* UBs, int idv, int lane, u32x4 (&w)[16]) {
    const int ei = lane & 15, gk = lane >> 4, r4 = ei >> 2, quarter = ei & 3;
#pragma unroll
    for (int b = 0; b < 16; ++b) { const int row = __builtin_amdgcn_ds_bpermute((16 * r4 + b) * 4, idv);
        w[b] = *(const u32x4*)(UBs + (((unsigned)row << 8) + 64u * (unsigned)gk + 16u * (unsigned)quarter)); }
}
__device__ __forceinline__ float sel4(float a, float b, float c, float d, unsigned m0, unsigned m1, unsigned m2, unsigned m3) {
    return __builtin_bit_cast(float, (__builtin_bit_cast(unsigned, a) & m0) | (__builtin_bit_cast(unsigned, b) & m1) | (__builtin_bit_cast(unsigned, c) & m2) | (__builtin_bit_cast(unsigned, d) & m3)); }
__device__ __forceinline__ void peer_u_consume(const u32x4 (&w)[16], const i32x8& B, int lane, unsigned m0, unsigned m1, unsigned m2, unsigned m3, float& keep) {
    const int ei = lane & 15; const bool q1 = (lane >> 1) & 1, q2 = (lane >> 2) & 1;
#pragma unroll
    for (int b0 = 0; b0 < 16; b0 += 4) {
        f32x4 D[4];
#pragma unroll
        for (int k = 0; k < 4; ++k) { const f32x4 z = {0.f, 0.f, 0.f, 0.f};
            const i32x8 a = {(int)w[b0 + k].x, (int)w[b0 + k].y, (int)w[b0 + k].z, (int)w[b0 + k].w, 0, 0, 0, 0};
            D[k] = __builtin_amdgcn_mfma_scale_f32_16x16x128_f8f6f4(a, B, z, 4, 0, 0, 0x7f7f7f7f, 0, 0x7f7f7f7f); }
        __builtin_amdgcn_sched_barrier(0);
        float v[4];
#pragma unroll
        for (int k = 0; k < 4; ++k) { const float lo = q1 ? D[k].y : D[k].x, hi = q1 ? D[k].w : D[k].z; v[k] = q2 ? hi : lo; }
#pragma unroll
        for (int k = 0; k < 4; ++k) v[k] += quad_swap1(v[k]);
#pragma unroll
        for (int k = 0; k < 4; ++k) v[k] += quad_swap2(v[k]);
#pragma unroll
        for (int k = 0; k < 4; ++k) v[k] += row_ror4(v[k]);
#pragma unroll
        for (int k = 0; k < 4; ++k) keep = (ei == b0 + k) ? v[k] : keep;
    }
}
__device__ __forceinline__ float peer_u_xquant(Frame& F, const PeerUMeta& M, const float (&g2s)[8], i32x8& B) {
    const int lane = F.lane, ei = lane & 15, g = lane >> 4, qn = (ei >> 1) & 3;
    LAS unsigned char* XB = F.lds + F.wave * 1024;
    float xf[8];
    { const float rs = M.rstd2; const u32x4 hv = M.hv;
      xf[0] = bflo(hv.x) * rs * g2s[0]; xf[1] = bfhi(hv.x) * rs * g2s[1]; xf[2] = bflo(hv.y) * rs * g2s[2]; xf[3] = bfhi(hv.y) * rs * g2s[3];
      xf[4] = bflo(hv.z) * rs * g2s[4]; xf[5] = bfhi(hv.z) * rs * g2s[5]; xf[6] = bflo(hv.w) * rs * g2s[6]; xf[7] = bfhi(hv.w) * rs * g2s[7]; }
    float m = 0.f;
#pragma unroll
    for (int i = 0; i < 8; ++i) m = fmaxf(m, fabsf(xf[i]));
    int mi = row_max16i(__builtin_bit_cast(int, m)); mi = max(mi, __shfl_xor(mi, 16)); mi = max(mi, __shfl_xor(mi, 32));
    m = fmaxf(__builtin_bit_cast(float, mi), 1e-30f); const float sx = m * (1.f / 224.f), inv = 224.f * __builtin_amdgcn_rcpf(m);
    { u32x2 hi, lo;
#pragma unroll
      for (int d = 0; d < 2; ++d) { const float a0 = xf[4 * d] * inv, a1 = xf[4 * d + 1] * inv, a2 = xf[4 * d + 2] * inv, a3 = xf[4 * d + 3] * inv;
          int h = __builtin_amdgcn_cvt_pk_fp8_f32(a0, a1, 0, false); h = __builtin_amdgcn_cvt_pk_fp8_f32(a2, a3, h, true);
          const f32x2 b01 = __builtin_amdgcn_cvt_pk_f32_fp8(h, false), b23 = __builtin_amdgcn_cvt_pk_f32_fp8(h, true);
          int l = __builtin_amdgcn_cvt_pk_fp8_f32(a0 - b01.x, a1 - b01.y, 0, false); l = __builtin_amdgcn_cvt_pk_fp8_f32(a2 - b23.x, a3 - b23.y, l, true);
          hi[d] = (unsigned)h; lo[d] = (unsigned)l; }
      *(LAS u32x2*)(XB + 8 * lane) = hi; *(LAS u32x2*)(XB + 512 + 8 * lane) = lo; }
    LDS_WAIT();
    { LAS const unsigned char* p = XB + ((ei & 1) ? 512 : 0) + 128 * (g >> 1) + 32 * qn + 16 * (g & 1);
      const u32x4 b0 = *(LAS const u32x4*)p, b1 = *(LAS const u32x4*)(p + 256);
      B = i32x8{(int)b0.x, (int)b0.y, (int)b0.z, (int)b0.w, (int)b1.x, (int)b1.y, (int)b1.z, (int)b1.w}; }
    LDS_WAIT();
    return sx;
}
__device__ __forceinline__ void peer_u_meta_async(Frame& F, int t, int x, PeerUMeta& M) {
    const int lane = F.lane;
    const bf16_t* hp = (const bf16_t*)(F.ws + WS_XN) + (size_t)t * DM + 512 * x + 8 * lane;
    const int* ip = (const int*)(F.ws + WS_IDX) + (size_t)t * PE + lane; const float* rp = (const float*)(F.ws + WS_RSTD2) + t;
    asm volatile("global_load_dwordx4 %0, %1, off" : "=v"(M.hv) : "v"(hp) : "memory");
    asm volatile("global_load_dword %0, %1, off" : "=v"(M.id0) : "v"(ip) : "memory");
    asm volatile("global_load_dword %0, %1, off offset:256" : "=v"(M.id1) : "v"(ip) : "memory");
    asm volatile("global_load_dword %0, %1, off" : "=v"(M.rstd2) : "v"(rp) : "memory");
}
template <bool DRY> __device__ __forceinline__ void peer_u_loop(Frame& F, int x, int tb, int tstep, const float (&g2s)[8]) {
    const int lane = F.lane;
    const unsigned char* UBs = F.ws + WS_UB + (size_t)x * NEXP * PIECE;
    PeerUMeta M, Mn, Mn2;
    peer_u_meta(F, tb, x, M); peer_u_meta(F, tb + tstep, x, Mn); Mn2 = Mn;
    u32x4 wA[16], wB[16];
    peer_u_issue(UBs, M.id0, lane, wA);
    unsigned m0, m1, m2, m3; { const int qn = (lane >> 1) & 3; m0 = qn == 0 ? ~0u : 0u; m1 = qn == 1 ? ~0u : 0u; m2 = qn == 2 ? ~0u : 0u; m3 = qn == 3 ? ~0u : 0u; asm volatile("" : "+v"(m0), "+v"(m1), "+v"(m2), "+v"(m3)); }
    i32x8 B, Bn; float sx = peer_u_xquant(F, M, g2s, B), sxn = sx; Bn = B;
#pragma nounroll
    for (int t = tb; t < MR; t += tstep) {
        if (t + 2 * tstep < MR) peer_u_meta_async(F, t + 2 * tstep, x, Mn2);
        float keep0 = 0.f, keep1 = 0.f;
        peer_u_issue(UBs, M.id1, lane, wB);
        __builtin_amdgcn_sched_barrier(0);
        peer_u_consume(wA, B, lane, m0, m1, m2, m3, keep0);
        __builtin_amdgcn_sched_barrier(0);
        if (t + tstep < MR) { peer_u_issue(UBs, Mn.id0, lane, wA); __builtin_amdgcn_sched_barrier(0); sxn = peer_u_xquant(F, Mn, g2s, Bn); }
        __builtin_amdgcn_sched_barrier(0);
        peer_u_consume(wB, B, lane, m0, m1, m2, m3, keep1);
        __builtin_amdgcn_sched_barrier(0);
        if constexpr (!DRY) { float* pa = (float*)(F.ws + WS_PACT) + ((size_t)t * 8 + x) * PE;
            pa[lane] = keep0 * sx; pa[64 + lane] = keep1 * sx; }
        else asm volatile("" :: "v"(keep0), "v"(keep1));
        asm volatile("" : "+v"(Mn2.hv), "+v"(Mn2.id0), "+v"(Mn2.id1), "+v"(Mn2.rstd2));
        M = Mn; Mn = Mn2; B = Bn; sx = sxn;
    }
}
typedef int i32x4 __attribute__((ext_vector_type(4)));
struct PeerVRest { float pa0[8], pa1[8]; float su0, su1, gs0, gs1; u32x4 hv; };
struct PeerVIds { int id0, id1; };
__device__ __forceinline__ void peer_v_ids(Frame& F, int t, PeerVIds& I) { const int* IDX = (const int*)(F.ws + WS_IDX) + (size_t)t * PE; I.id0 = IDX[F.lane]; I.id1 = IDX[64 + F.lane]; }
__device__ __forceinline__ void peer_v_rest(Frame& F, int t, int x, PeerVRest& R) {
    const int lane = F.lane, r = lane >> 4, sp = lane & 15;
    const float* SUT = (const float*)(F.ws + WS_SUT) + (size_t)t * PE; const float* GS = (const float*)(F.ws + WS_GS) + (size_t)t * PE;
    R.su0 = SUT[lane]; R.su1 = SUT[64 + lane]; R.gs0 = GS[lane]; R.gs1 = GS[64 + lane];
    const float* pa = (const float*)(F.ws + WS_PACT) + (size_t)t * 8 * PE;
#pragma unroll
    for (int xx = 0; xx < 8; ++xx) { R.pa0[xx] = pa[xx * PE + lane]; R.pa1[xx] = pa[xx * PE + 64 + lane]; }
    R.hv = *(const u32x4*)((const bf16_t*)(F.ws + WS_XN) + (size_t)t * DM + 512 * x + 32 * sp + 8 * r);
}
__device__ __forceinline__ void peer_v_ids_async(Frame& F, int t, PeerVIds& I) {
    const int* ip = (const int*)(F.ws + WS_IDX) + (size_t)t * PE + F.lane;
    asm volatile("global_load_dword %0, %1, off" : "=v"(I.id0) : "v"(ip) : "memory");
    asm volatile("global_load_dword %0, %1, off offset:256" : "=v"(I.id1) : "v"(ip) : "memory");
}
__device__ __forceinline__ void peer_v_rest_async(Frame& F, int t, int x, PeerVRest& R) {
    const int lane = F.lane, r = lane >> 4, sp = lane & 15;
    const float* sp_ = (const float*)(F.ws + WS_SUT) + (size_t)t * PE + lane; const float* gp = (const float*)(F.ws + WS_GS) + (size_t)t * PE + lane;
    const float* pa = (const float*)(F.ws + WS_PACT) + (size_t)t * 8 * PE + lane;
    const bf16_t* hp = (const bf16_t*)(F.ws + WS_XN) + (size_t)t * DM + 512 * x + 32 * sp + 8 * r;
    asm volatile("global_load_dword %0, %1, off" : "=v"(R.su0) : "v"(sp_) : "memory");
    asm volatile("global_load_dword %0, %1, off offset:256" : "=v"(R.su1) : "v"(sp_) : "memory");
    asm volatile("global_load_dword %0, %1, off" : "=v"(R.gs0) : "v"(gp) : "memory");
    asm volatile("global_load_dword %0, %1, off offset:256" : "=v"(R.gs1) : "v"(gp) : "memory");
#define PA_LD(xx) asm volatile("global_load_dword %0, %2, off offset:%3\n\tglobal_load_dword %1, %2, off offset:%4" : "=&v"(R.pa0[xx]), "=&v"(R.pa1[xx]) : "v"(pa), "n"((xx) * 512), "n"((xx) * 512 + 256) : "memory")
    PA_LD(0); PA_LD(1); PA_LD(2); PA_LD(3); PA_LD(4); PA_LD(5); PA_LD(6); PA_LD(7);
#undef PA_LD
    asm volatile("global_load_dwordx4 %0, %1, off" : "=v"(R.hv) : "v"(hp) : "memory");
}
__device__ __forceinline__ void peer_v_pin(PeerVRest& R) {
    asm volatile("" : "+v"(R.su0), "+v"(R.su1), "+v"(R.gs0), "+v"(R.gs1), "+v"(R.hv));
#pragma unroll
    for (int xx = 0; xx < 8; ++xx) asm volatile("" : "+v"(R.pa0[xx]), "+v"(R.pa1[xx]));
}
__device__ __forceinline__ void peer_v_prologue(Frame& F, const PeerVRest& R, float& sw, int& qw) {
    const int lane = F.lane;
    LAS unsigned char* QW8 = F.lds + F.wave * 256;
    float a0 = 0.f, a1 = 0.f;
#pragma unroll
    for (int xx = 0; xx < 8; ++xx) { a0 += R.pa0[xx]; a1 += R.pa1[xx]; }
    const float w0 = R.gs0 * gelu_tanh(a0 * R.su0), w1 = R.gs1 * gelu_tanh(a1 * R.su1);
    int wmi = row_max16i(__builtin_bit_cast(int, fmaxf(fabsf(w0), fabsf(w1)))); wmi = max(wmi, __shfl_xor(wmi, 16)); wmi = max(wmi, __shfl_xor(wmi, 32));
    const float wm = fmaxf(__builtin_bit_cast(float, wmi), 1e-30f); sw = wm * (1.f / 127.f); const float winv = 127.f * __builtin_amdgcn_rcpf(wm);
    const int q0 = max(min((int)__builtin_rintf(w0 * winv), 127), -127), q1 = max(min((int)__builtin_rintf(w1 * winv), 127), -127);
    qw = wave_sum_i(q0 + q1);
    QW8[((lane >> 4) * 4 + (lane & 3)) * 4 + ((lane >> 2) & 3)] = (unsigned char)(q0 & 0xff);
    QW8[(((64 + lane) >> 4) * 4 + (lane & 3)) * 4 + ((lane >> 2) & 3)] = (unsigned char)(q1 & 0xff);
    LDS_WAIT();
}
template <bool DRY> __device__ __forceinline__ void peer_v_issue4(const unsigned char* VBs, int idv, int lane, int gg, u32x4 (&w)[16]) {
    const int r = lane >> 4, sp = lane & 15;
#pragma unroll
    for (int k = 0; k < 4; ++k) { const int q = 4 * gg + k; const int row = __builtin_amdgcn_ds_bpermute((4 * q + r) * 4, idv);
#if PROBE_MODE == 1
        if constexpr (DRY) { const unsigned ur = (unsigned)row + r; w[q] = u32x4{ur, ur * 3u, ur * 5u, ur * 7u}; } else
#endif
        w[q] = *(const u32x4*)(VBs + (((unsigned)row << 8) + 16u * (unsigned)sp)); }
}
template <bool DRY> __device__ __forceinline__ void peer_v_round(Frame& F, const unsigned char* VBs, u32x4 (&w)[16], int h, int idv_next, int lane, const unsigned (&sel)[4], i32x4 (&Dl)[4], i32x4 (&Dh)[4]) {
    const int r = lane >> 4;
    LAS const unsigned char* QW8 = F.lds + F.wave * 256;
#pragma unroll
    for (int gg = 0; gg < 4; ++gg) {
        i32x4 blo[4], bhi[4];
#pragma unroll
        for (int j = 0; j < 4; ++j) {
            blo[j] = i32x4{(int)(w[4 * gg][j] & 0x0F0F0F0Fu), (int)(w[4 * gg + 1][j] & 0x0F0F0F0Fu), (int)(w[4 * gg + 2][j] & 0x0F0F0F0Fu), (int)(w[4 * gg + 3][j] & 0x0F0F0F0Fu)};
            bhi[j] = i32x4{(int)(w[4 * gg][j] & 0xF0F0F0F0u), (int)(w[4 * gg + 1][j] & 0xF0F0F0F0u), (int)(w[4 * gg + 2][j] & 0xF0F0F0F0u), (int)(w[4 * gg + 3][j] & 0xF0F0F0F0u)}; }
        __builtin_amdgcn_sched_barrier(0);
        peer_v_issue4<DRY>(VBs, idv_next, lane, gg, w);
        __builtin_amdgcn_sched_barrier(0);
#if PROBE_MODE == 2
        if constexpr (DRY) { _Pragma("unroll") for (int j = 0; j < 4; ++j) { Dl[j].x ^= blo[j].x ^ blo[j].y ^ blo[j].z ^ blo[j].w; Dh[j].x ^= bhi[j].x ^ bhi[j].y ^ bhi[j].z ^ bhi[j].w; } continue; }
#endif
        const unsigned wpk = *(const LAS unsigned*)(QW8 + ((4 * h + gg) * 4 + r) * 4);
        const i32x4 a = {(int)__builtin_amdgcn_perm(wpk, wpk, sel[0]), (int)__builtin_amdgcn_perm(wpk, wpk, sel[1]), (int)__builtin_amdgcn_perm(wpk, wpk, sel[2]), (int)__builtin_amdgcn_perm(wpk, wpk, sel[3])};
#pragma unroll
        for (int j = 0; j < 4; ++j) { Dl[j] = __builtin_amdgcn_mfma_i32_16x16x64_i8(a, blo[j], Dl[j], 0, 0, 0); Dh[j] = __builtin_amdgcn_mfma_i32_16x16x64_i8(a, bhi[j], Dh[j], 0, 0, 0); }
        __builtin_amdgcn_sched_barrier(0);
    }
}
__device__ __forceinline__ int sel4i(int a, int b, int c, int d, unsigned m0, unsigned m1, unsigned m2, unsigned m3) { return (int)(((unsigned)a & m0) | ((unsigned)b & m1) | ((unsigned)c & m2) | ((unsigned)d & m3)); }
template <bool DRY> __device__ __forceinline__ void peer_v_loop(Frame& F, int x, int tb, int tstep) {
    const int lane = F.lane, r = lane >> 4, sp = lane & 15;
    const unsigned char* VBs = F.ws + WS_VB + (size_t)x * NEXP * PIECE;
    unsigned sel[4];
#pragma unroll
    for (int e = 0; e < 4; ++e) sel[e] = (0x0C0C0C0Cu & ~(0xFFu << (8 * (lane & 3)))) | ((unsigned)e << (8 * (lane & 3)));
    unsigned m0 = r == 0 ? ~0u : 0u, m1 = r == 1 ? ~0u : 0u, m2 = r == 2 ? ~0u : 0u, m3 = r == 3 ? ~0u : 0u;
    asm volatile("" : "+v"(m0), "+v"(m1), "+v"(m2), "+v"(m3));
    PeerVIds I, In, I2; PeerVRest R, Rn;
    peer_v_ids(F, tb, I); peer_v_ids(F, tb + tstep, In); I2 = In;
    peer_v_rest(F, tb, x, R); Rn = R;
    u32x4 w[16];
#pragma unroll
    for (int gg = 0; gg < 4; ++gg) peer_v_issue4<DRY>(VBs, I.id0, lane, gg, w);
    float sw; int qw; u32x4 hv = R.hv;
    peer_v_prologue(F, R, sw, qw);
#pragma nounroll
    for (int t = tb; t < MR; t += tstep) {
        const bool more = t + tstep < MR;
        if (more) peer_v_rest_async(F, t + tstep, x, Rn);
        if (t + 2 * tstep < MR) peer_v_ids_async(F, t + 2 * tstep, I2);
        i32x4 Dl[4], Dh[4];
#pragma unroll
        for (int j = 0; j < 4; ++j) { Dl[j] = i32x4{0, 0, 0, 0}; Dh[j] = i32x4{0, 0, 0, 0}; }
        peer_v_round<DRY>(F, VBs, w, 0, I.id1, lane, sel, Dl, Dh);
        peer_v_round<DRY>(F, VBs, w, 1, In.id0, lane, sel, Dl, Dh);
        if constexpr (!DRY) {
            int a8[8];
            a8[0] = sel4i(Dl[0].x, Dl[1].x, Dl[2].x, Dl[3].x, m0, m1, m2, m3); a8[1] = sel4i(Dl[0].y, Dl[1].y, Dl[2].y, Dl[3].y, m0, m1, m2, m3);
            a8[2] = sel4i(Dl[0].z, Dl[1].z, Dl[2].z, Dl[3].z, m0, m1, m2, m3); a8[3] = sel4i(Dl[0].w, Dl[1].w, Dl[2].w, Dl[3].w, m0, m1, m2, m3);
            a8[4] = sel4i(Dh[0].x, Dh[1].x, Dh[2].x, Dh[3].x, m0, m1, m2, m3); a8[5] = sel4i(Dh[0].y, Dh[1].y, Dh[2].y, Dh[3].y, m0, m1, m2, m3);
            a8[6] = sel4i(Dh[0].z, Dh[1].z, Dh[2].z, Dh[3].z, m0, m1, m2, m3); a8[7] = sel4i(Dh[0].w, Dh[1].w, Dh[2].w, Dh[3].w, m0, m1, m2, m3);
            const float c75 = 7.5f * (float)qw, c05 = 0.5f * (float)qw;
            f32x4 o0, o1;
            o0.x = bflo(hv.x) + sw * ((float)a8[0] - c75); o0.y = bfhi(hv.x) + sw * ((float)a8[1] - c75); o0.z = bflo(hv.y) + sw * ((float)a8[2] - c75); o0.w = bfhi(hv.y) + sw * ((float)a8[3] - c75);
            o1.x = bflo(hv.z) + sw * ((float)(a8[4] >> 4) + c05); o1.y = bfhi(hv.z) + sw * ((float)(a8[5] >> 4) + c05); o1.z = bflo(hv.w) + sw * ((float)(a8[6] >> 4) + c05); o1.w = bfhi(hv.w) + sw * ((float)(a8[7] >> 4) + c05);
            float* op = F.out + (size_t)t * DM + 512 * x + 32 * sp + 8 * r;
            __builtin_nontemporal_store(o0, (f32x4*)op); __builtin_nontemporal_store(o1, (f32x4*)(op + 4));
        } else { _Pragma("unroll") for (int j = 0; j < 4; ++j) asm volatile("" :: "v"(Dl[j]), "v"(Dh[j])); }
        if (more) { peer_v_pin(Rn); hv = Rn.hv; peer_v_prologue(F, Rn, sw, qw); }
        asm volatile("" : "+v"(I2.id0), "+v"(I2.id1));
        I = In; In = I2;
    }
}

template <int ONLY> __global__ void __launch_bounds__(NWAVES * 64, 2) mega(Args args) {
    extern __shared__ __attribute__((aligned(16))) unsigned char lds[];
    Frame F;
    F.lds = (LAS unsigned char*)lds; F.ldsg = (char*)lds;
    F.tid = threadIdx.x; F.lane = F.tid & 63; F.wave = __builtin_amdgcn_readfirstlane(F.tid >> 6);
    F.G = gridDim.x; { const int bx = blockIdx.x; F.vcu = (F.G % 8 == 0) ? (bx % 8) * (F.G / 8) + bx / 8 : bx; }
    F.out = args.out; F.ws = args.ws;
    const int lo = args.ph_lo, hi = args.ph_hi;
#define IN(k) ((ONLY < 0 || ONLY == (k)) && lo <= (k) && (k) < hi)
    XcdBarrier bar; bar.bar = nullptr; bar.x = 0; bar.st = nullptr;
    if constexpr (ONLY < 0) {
        volatile LAS unsigned* MISC = (volatile LAS unsigned*)(F.lds + LDS_MISC);
        if (F.tid < 64) MISC[F.tid] = 0u;
        __syncthreads();
        bar = xcd_barrier_post((unsigned*)(F.ws + WS_CTL) + 4096, MISC + 8);
    }
#ifndef PROBE_REPEAT
#define PROBE_REPEAT 0
#endif
#define NREP(k) (((PROBE_REPEAT >> (k)) & 1) ? 2 : 1)
#define SEAM(k) do { if constexpr (ONLY < 0) { if (IN(k) && IN((k) + 1)) xcd_barrier(bar); } } while (0)

    if (IN(0)) { for (int rep = 0; rep < NREP(0); ++rep) { p0_prologue(F, args); if (rep + 1 < NREP(0)) xcd_barrier(bar); } }
    SEAM(0);
    if (IN(1)) for (int rep = 0; rep < NREP(1); ++rep) {
        if (rep) xcd_barrier(bar);
        p1_meta_gemm(F, args);
        pg8::Gemm g{(const bf16_t*)(F.ws + WS_XN), (const bf16_t*)(F.ws + WS_WT1), MR, INC, DM}; pg8::StaticOrder S; S.init(MR, INC, F.G, (int)blockIdx.x);
        pg8::EpiBf16 E{(bf16_t*)(F.ws + WS_Z), INC};
        pg8::gemm_phase<pg8::EpiBf16>(F.lds, g, S, E);
    }
    SEAM(1);
    if (IN(2)) {
        for (int rep = 0; rep < NREP(2); ++rep) { if (rep) xcd_barrier(bar); for (int u = F.vcu; u < 256; u += F.G) { if (u & 1) scan_unit<1>(F, args, u); else scan_unit<0>(F, args, u); } }
        normrope_rows(F, args);
    }
    SEAM(2);
    if (IN(3)) for (int rep = 0; rep < NREP(3); ++rep) {
        if (rep) xcd_barrier(bar);
        const bf16_t* Z = (const bf16_t*)(F.ws + WS_Z); const bf16_t* KP = (const bf16_t*)(F.ws + WS_KP); const bf16_t* VP = (const bf16_t*)(F.ws + WS_VP); bf16_t* MRG = (bf16_t*)(F.ws + WS_MRG);
        for (int u = F.vcu; u < NB * NQ * (SEQ / 256); u += F.G) {
            const int grp = u >> 6, within = u & 63, b = grp >> 2, kvh = grp & 3, hq = within >> 4, qb = within & 15, h = kvh * 4 + hq;
            att::attn_unit(Z + (size_t)(b * SEQ + qb * 256) * INC + h * HD, KP + (size_t)(b * NKV + kvh) * KPAD * HD, VP + (size_t)(b * NKV + kvh) * KPAD * HD,
                           MRG + (size_t)(b * SEQ + qb * 256) * DM + h * HD, F.ldsg, qb * 256, args.in[IN_QG], (const f32x2*)(F.ws + WS_ROPE));
        }
    }
    SEAM(3);
    if (IN(4)) { combine_rows(F, args); }
    SEAM(4);
    if (IN(5)) for (int rep = 0; rep < NREP(5); ++rep) {
        if (rep) xcd_barrier(bar);
        pg8::Gemm g{(const bf16_t*)(F.ws + WS_MRG), (const bf16_t*)(F.ws + WS_WT2), MR, DM, DM}; pg8::StaticOrder S; S.init(MR, DM, F.G, (int)blockIdx.x);
        pg8::EpiResid E{args.in[IN_X], F.out, (bf16_t*)(F.ws + WS_XN), (float*)(F.ws + WS_SSQ2), DM};
        pg8::gemm_phase<pg8::EpiResid>(F.lds, g, S, E);
    }
    SEAM(5);
    if (IN(6)) for (int rep = 0; rep < NREP(6); ++rep) {
        if (rep) xcd_barrier(bar);
        convert_uv(F, args);
        pg8::Gemm g{(const bf16_t*)(F.ws + WS_XN), (const bf16_t*)(F.ws + WS_WT3), MR, 2048, DM}; pg8::StaticOrder S; S.init(MR, 2048, F.G, (int)blockIdx.x);
        pg8::EpiBf16 E{(bf16_t*)(F.ws + WS_QP), 2048};
        pg8::gemm_phase<pg8::EpiBf16>(F.lds, g, S, E);
    }
    SEAM(6);
    if (IN(7)) { for (int rep = 0; rep < NREP(7); ++rep) { if (rep) xcd_barrier(bar); for (int u = F.vcu; u < MR / 32; u += F.G) topk_unit(F, args, u); } }
    SEAM(7);
    if (IN(8)) {
        const int x = (int)blockIdx.x & 7, y = (int)blockIdx.x >> 3, ny = F.G >> 3;
        float g2s[8];
#pragma unroll
        for (int i = 0; i < 8; ++i) g2s[i] = args.in[IN_G2][512 * x + 8 * F.lane + i];
        const int tstep = ny * NWAVES;
        if (NREP(8) == 2) { peer_u_loop<true>(F, x, y * NWAVES + F.wave, tstep, g2s); xcd_barrier(bar); }
        peer_u_loop<false>(F, x, y * NWAVES + F.wave, tstep, g2s);
    }
    SEAM(8);
    if (IN(9)) {
        const int x = (int)blockIdx.x & 7, y = (int)blockIdx.x >> 3, ny = F.G >> 3; const int tstep = ny * NWAVES;
        if (NREP(9) == 2) { peer_v_loop<true>(F, x, y * NWAVES + F.wave, tstep); xcd_barrier(bar); }
        peer_v_loop<false>(F, x, y * NWAVES + F.wave, tstep);
    }
#undef IN
#undef SEAM
}

template <int P> static void launch_phase(int grid, hipStream_t stream, Args a) {
    static bool attr = false;
    if (!attr) { if (hipFuncSetAttribute((const void*)mega<P>, hipFuncAttributeMaxDynamicSharedMemorySize, LDS_BYTES) != hipSuccess) fprintf(stderr, "hipFuncSetAttribute failed (phase %d)\n", P); attr = true; }
    a.ph_lo = P; a.ph_hi = P + 1;
    hipLaunchKernelGGL(mega<P>, dim3(grid), dim3(NWAVES * 64), LDS_BYTES, stream, a);
}
extern "C" void kernel_launch(void* const* d_in, const int* in_sizes, int n_in, void* d_out, int out_size, void* d_ws, size_t ws_size, hipStream_t stream) {
    static int grid = 0;
    if (grid == 0) {
        if (n_in != 21 || out_size != MR * DM || ws_size < WS_END) { fprintf(stderr, "kernel_launch: unexpected shapes n_in %d out %d ws %zu\n", n_in, out_size, ws_size); grid = -1; return; }
        int dev = 0, cus = 0;
        (void)hipGetDevice(&dev); (void)hipDeviceGetAttribute(&cus, hipDeviceAttributeMultiprocessorCount, dev);
        grid = (cus / 8) * 8;
        if (grid < 8) { fprintf(stderr, "kernel_launch: device with %d CUs not supported\n", cus); grid = -1; return; }
#if N_LAUNCH_MODE == 1
        int per_cu = 0;
        if (hipFuncSetAttribute((const void*)mega<-1>, hipFuncAttributeMaxDynamicSharedMemorySize, LDS_BYTES) != hipSuccess) { fprintf(stderr, "kernel_launch: hipFuncSetAttribute failed\n"); grid = -1; return; }
        if (hipOccupancyMaxActiveBlocksPerMultiprocessor(&per_cu, (const void*)mega<-1>, NWAVES * 64, LDS_BYTES) != hipSuccess || per_cu < 1) { fprintf(stderr, "kernel_launch: occupancy query %d\n", per_cu); grid = -1; return; }
        (void)hipGetLastError();
#endif
    }
    if (grid < 0) return;
    Args a{};
    for (int i = 0; i < 21; ++i) a.in[i] = (const float*)d_in[i];
    a.out = (float*)d_out; a.ws = (unsigned char*)d_ws;
#if N_LAUNCH_MODE == 0
    launch_phase<0>(grid, stream, a); launch_phase<1>(grid, stream, a); launch_phase<2>(grid, stream, a); launch_phase<3>(grid, stream, a); launch_phase<4>(grid, stream, a);
    launch_phase<5>(grid, stream, a); launch_phase<6>(grid, stream, a); launch_phase<7>(grid, stream, a); launch_phase<8>(grid, stream, a); launch_phase<9>(grid, stream, a);
#else
    if (hipMemsetAsync((char*)d_ws + WS_CTL, 0, 65536, stream) != hipSuccess) { fprintf(stderr, "kernel_launch: memset failed\n"); return; }
    a.ph_lo = 0; a.ph_hi = NPHASE;
    void* kargs[] = {&a};
    hipError_t e = hipLaunchCooperativeKernel((const void*)mega<-1>, dim3(grid), dim3(NWAVES * 64), kargs, LDS_BYTES, stream);
    if (e != hipSuccess) fprintf(stderr, "cooperative launch failed: %s (grid %d)\n", hipGetErrorString(e), grid);
#endif
    const hipError_t le = hipPeekAtLastError();
    if (le != hipSuccess) fprintf(stderr, "kernel_launch: launch failed: %s\n", hipGetErrorName(le));
}
```

```cpp
#include <hip/hip_runtime.h>
#include <hip/hip_cooperative_groups.h>
#include <cstdio>
#include <cstdint>
namespace cg = cooperative_groups;

#ifndef N_LAUNCH_MODE
#define N_LAUNCH_MODE 1
#endif

#define GAS __attribute__((address_space(1)))
#define LAS __attribute__((address_space(3)))
typedef unsigned short bf16_t;
typedef short bf16x8 __attribute__((ext_vector_type(8)));
typedef short s16x4 __attribute__((ext_vector_type(4)));
typedef float f32x2 __attribute__((ext_vector_type(2)));
typedef float f32x4 __attribute__((ext_vector_type(4)));
typedef float f32x16 __attribute__((ext_vector_type(16)));
typedef unsigned u32x2 __attribute__((ext_vector_type(2)));
typedef unsigned u32x4 __attribute__((ext_vector_type(4)));
typedef __bf16 bf16x2 __attribute__((ext_vector_type(2)));

constexpr int DM = 4096, NB = 4, SEQ = 4096, NMETA = 16, LTOT = SEQ + NMETA;
constexpr int MR = NB * SEQ;
constexpr int INC = 7168, OFF_K = 2048, OFF_V = 2560, OFF_X = 3072, OFF_Y = 5120;
constexpr int HD = 128, NQ = 16, NKV = 4, DATT = 2048, DRNN = 2048;
constexpr int KPAD = 4224;
constexpr int NT_REAL = 64;
constexpr int PH = 8, NKEYS = 128, PDQ = 256, PTOPK = 16, PE = 128, NEXP = 16384;
constexpr float EPS = 1e-6f;

constexpr size_t MiB = 1u << 20;
constexpr size_t WS_CTL = 0;
constexpr size_t WS_ROPE = 1 * MiB;
constexpr size_t WS_RSTD2 = 1 * MiB + 65536;
constexpr size_t WS_SU = 1 * MiB + 131072;
constexpr size_t WS_SV = 1 * MiB + 196608;
constexpr size_t WS_SKB = 2 * MiB;
constexpr size_t WS_ZM = 2 * MiB + 524288;
constexpr size_t WS_WG = 3 * MiB;
constexpr size_t WS_WT1 = 5 * MiB;
constexpr size_t WS_WT2 = 61 * MiB;
constexpr size_t WS_WT3 = 93 * MiB;
constexpr size_t WS_XN = 109 * MiB;
constexpr size_t WS_KP = 238 * MiB;
constexpr size_t WS_VP = 255 * MiB;
constexpr size_t WS_MRG = 272 * MiB;
constexpr size_t WS_SSQ2 = 400 * MiB;
constexpr size_t WS_IDX = 404 * MiB;
constexpr size_t WS_GATE = 412 * MiB;
constexpr size_t WS_QP = 420 * MiB;
constexpr size_t WS_Z = 484 * MiB;
constexpr size_t WS_HF = 708 * MiB;
constexpr size_t WS_HB = 772 * MiB;
constexpr size_t WS_UB = 484 * MiB;
constexpr size_t WS_VB = 516 * MiB;
constexpr size_t WS_SUT = 336 * MiB;
constexpr size_t WS_GS = 344 * MiB;
constexpr size_t WS_PACT = 272 * MiB;
constexpr size_t WS_WQ = 352 * MiB;
constexpr size_t WS_SWQ = 354 * MiB;
constexpr size_t WS_END = 836 * MiB;

constexpr int LDS_BYTES = 147456; constexpr int LDS_MISC = 147456 - 256;
constexpr int NWAVES = 8;
constexpr int NPHASE = 11;

__device__ __forceinline__ unsigned f2bf(float f) { unsigned u = __builtin_bit_cast(unsigned, f); return (u + 0x7fffu + ((u >> 16) & 1u)) >> 16; }
__device__ __forceinline__ unsigned pk2(float lo, float hi) { return f2bf(lo) | (f2bf(hi) << 16); }
__device__ __forceinline__ float bflo(unsigned w) { return __builtin_bit_cast(float, w << 16); }
__device__ __forceinline__ float bfhi(unsigned w) { return __builtin_bit_cast(float, w & 0xffff0000u); }
__device__ __forceinline__ float bf2f(bf16_t b) { return __builtin_bit_cast(float, ((unsigned)b) << 16); }
__device__ __forceinline__ unsigned cvt_pk_bf16(float lo, float hi) { unsigned r; asm volatile("v_cvt_pk_bf16_f32 %0, %1, %2" : "=v"(r) : "v"(lo), "v"(hi)); return r; }
__device__ __forceinline__ float wave_sum(float v) {
#pragma unroll
    for (int o = 1; o < 64; o <<= 1) v += __shfl_xor(v, o);
    return v;
}
__device__ __forceinline__ float gelu_tanh(float x) {
    const float y = 0.7978845608028654f * (x + 0.044715f * x * x * x);
    const float e = __expf(2.f * y);
    const float th = 1.f - 2.f / (1.f + e);
    return 0.5f * x * (1.f + th);
}
__device__ __forceinline__ float sigmoidf_(float x) { return 1.f / (1.f + __expf(-x)); }
__device__ __forceinline__ float dot2bf(unsigned w, unsigned x, float acc) { return __builtin_amdgcn_fdot2_f32_bf16(__builtin_bit_cast(bf16x2, w), __builtin_bit_cast(bf16x2, x), acc, false); }
__device__ __forceinline__ float ub0(unsigned x) { float r; asm("v_cvt_f32_ubyte0 %0, %1" : "=v"(r) : "v"(x)); return r; }
__device__ __forceinline__ float ub1(unsigned x) { float r; asm("v_cvt_f32_ubyte1 %0, %1" : "=v"(r) : "v"(x)); return r; }
__device__ __forceinline__ float ub2(unsigned x) { float r; asm("v_cvt_f32_ubyte2 %0, %1" : "=v"(r) : "v"(x)); return r; }
__device__ __forceinline__ float ub3(unsigned x) { float r; asm("v_cvt_f32_ubyte3 %0, %1" : "=v"(r) : "v"(x)); return r; }
__device__ __forceinline__ float wave_max(float v) {
#pragma unroll
    for (int o = 1; o < 64; o <<= 1) v = fmaxf(v, __shfl_xor(v, o));
    return v;
}
__device__ __forceinline__ unsigned pack_i8x4(float a, float b, float c, float d, int bias) {
    const int ia = (int)__builtin_rintf(a) + bias, ib = (int)__builtin_rintf(b) + bias, ic = (int)__builtin_rintf(c) + bias, id = (int)__builtin_rintf(d) + bias;
    return (unsigned)(ia & 0xff) | ((unsigned)(ib & 0xff) << 8) | ((unsigned)(ic & 0xff) << 16) | ((unsigned)id << 24);
}
#define LDS_WAIT() asm volatile("s_waitcnt lgkmcnt(0)" ::: "memory")

namespace pg8 {
constexpr int BM = 256, BK = 64, HALF = 128, HTB = HALF * BK * 2, STAGE_BYTES = 8 * HTB, NXCD = 8, WGM = 8;
__host__ __device__ __forceinline__ int lds_byte(int r, int c) { const int st = (r >> 4) * 2 + (c >> 5), rr = r & 15, cc = c & 31, ob = rr * 64 + cc * 2; return st * 1024 + (ob ^ (((ob >> 9) & 1) << 5)); }
__host__ __device__ __forceinline__ void stage_rc(int b, int& R, int& C) { const int st = b / 1024, sb = b % 1024, swz = sb ^ (((sb >> 9) & 1) << 5); R = (st >> 1) * 16 + swz / 64; C = (st & 1) * 32 + (swz % 64) / 2; }
__host__ __device__ __forceinline__ int perm32(int rho) { const int n = rho >> 4, i = rho & 15; return 8 * (i >> 2) + 4 * n + (i & 3); }
struct Unit { int pm, pn; };
struct Gemm { const bf16_t* A; const bf16_t* Bt; int M, N, K; };
struct StaticOrder {
    int nM, nN, nwg, G, c;
    __host__ __device__ void init(int M, int N, int G_, int c_) { nM = M / BM; nN = N / BM; nwg = nM * nN; G = G_; c = c_; }
    __host__ __device__ bool next(int i, Unit& u) const {
        const long L = (long)i * G + c; if (L >= nwg) return false;
        int wgid = (int)L; { const int q = nwg / NXCD, r = nwg % NXCD, xcd = wgid % NXCD, off = wgid / NXCD; wgid = (xcd < r ? xcd * (q + 1) : r * (q + 1) + (xcd - r) * q) + off; }
        const int nig = WGM * nN, gid = wgid / nig, fm = gid * WGM, gsz = (nM - fm) < WGM ? (nM - fm) : WGM;
        u.pm = fm + ((wgid % nig) % gsz); u.pn = (wgid % nig) / gsz; return true;
    }
};
struct EpiBf16 {
    bf16_t* O; int ldc;
    __device__ __forceinline__ void operator()(const f32x4 (&acc)[2][2][4][2], const Unit& u, int wr, int wc, int fr, int fq) const {
        const int row0 = u.pm * BM + wr * 64 + fr; const int col0 = u.pn * BM + wc * 32 + 8 * fq;
#pragma unroll
        for (int ai = 0; ai < 2; ++ai)
#pragma unroll
            for (int m = 0; m < 4; ++m) { bf16_t* rowp = O + (size_t)(row0 + ai * HALF + m * 16) * ldc + col0;
#pragma unroll
                for (int bj = 0; bj < 2; ++bj) { const f32x4 v0 = acc[ai][bj][m][0], v1 = acc[ai][bj][m][1];
                    u32x4 w; w.x = cvt_pk_bf16(v0[0], v0[1]); w.y = cvt_pk_bf16(v0[2], v0[3]); w.z = cvt_pk_bf16(v1[0], v1[1]); w.w = cvt_pk_bf16(v1[2], v1[3]);
                    *(u32x4*)(rowp + bj * HALF) = w; } }
    }
};
struct EpiResid {
    const float* X; float* OUT; bf16_t* HB; float* SSQ; int ldc;
    __device__ __forceinline__ void operator()(const f32x4 (&acc)[2][2][4][2], const Unit& u, int wr, int wc, int fr, int fq) const {
        const int row0 = u.pm * BM + wr * 64 + fr; const int col0 = u.pn * BM + wc * 32 + 8 * fq;
#pragma unroll
        for (int ai = 0; ai < 2; ++ai)
#pragma unroll
            for (int m = 0; m < 4; ++m) { const int row = row0 + ai * HALF + m * 16; const size_t off = (size_t)row * ldc + col0; float ss = 0.f;
#pragma unroll
                for (int bj = 0; bj < 2; ++bj) {
                    const f32x4 x0 = *(const f32x4*)(X + off + bj * HALF), x1 = *(const f32x4*)(X + off + bj * HALF + 4);
                    const f32x4 v0 = acc[ai][bj][m][0] + x0, v1 = acc[ai][bj][m][1] + x1;
                    u32x4 w; w.x = cvt_pk_bf16(v0[0], v0[1]); w.y = cvt_pk_bf16(v0[2], v0[3]); w.z = cvt_pk_bf16(v1[0], v1[1]); w.w = cvt_pk_bf16(v1[2], v1[3]);
                    *(u32x4*)(HB + off + bj * HALF) = w;
                    ss += (v0[0] * v0[0] + v0[1] * v0[1]) + (v0[2] * v0[2] + v0[3] * v0[3]) + (v1[0] * v1[0] + v1[1] * v1[1]) + (v1[2] * v1[2] + v1[3] * v1[3]); }
                ss += __shfl_xor(ss, 16); ss += __shfl_xor(ss, 32);
                if (fq == 0) SSQ[(size_t)row * 64 + u.pn * 4 + wc] = ss; }
    }
};

template <class Epi>
__device__ __forceinline__ void gemm_phase(LAS unsigned char* lds, const Gemm g, const StaticOrder& S, const Epi& E) {
    const int tid = threadIdx.x, wid = __builtin_amdgcn_readfirstlane(tid >> 6), lane = tid & 63, wr = wid >> 2, wc = wid & 3, fr = lane & 15, fq = lane >> 4;
    const int K = g.K, nt = K / BK;
    unsigned voffA[2], voffB[2];
#pragma unroll
    for (int i = 0; i < 2; ++i) { int R, C; stage_rc(tid * 16 + i * 8192, R, C); const int Rb = (R & ~31) + perm32(R & 31);
        voffA[i] = (unsigned)(R * K + C) * 2u; voffB[i] = (unsigned)(Rb * K + C) * 2u; }
    const size_t kstep = (size_t)(BK * 2);
    const size_t hstep = (size_t)HALF * K * 2;
    const size_t tstep = 2 * hstep;
    const unsigned ldsw = (unsigned)wid * 1024u;
    const int aoff = lds_byte(wr * 64 + fr, fq * 8), boff = lds_byte(wc * 32 + fr, fq * 8);
#define PG8_SA(b, h) (((b) * 2 + (h)) * HTB)
#define PG8_SB(b, h) ((4 + (b) * 2 + (h)) * HTB)
#define PG8_STAGE(bufoff, gbase, voff) do { _Pragma("unroll") for (int _i = 0; _i < 2; ++_i) \
        __builtin_amdgcn_global_load_lds((const unsigned*)((const char*)(gbase) + (voff)[_i]), (LAS unsigned*)(lds + (bufoff) + ldsw + _i * 8192), 16, 0, 0); } while (0)
#define PG8_LDA(dst, b, h) do { _Pragma("unroll") for (int m = 0; m < 4; ++m) _Pragma("unroll") for (int k = 0; k < 2; ++k) dst[m][k] = *(const LAS bf16x8*)(lds + PG8_SA(b, h) + aoff + m * 2048 + k * 1024); } while (0)
#define PG8_LDB(dst, b, h) do { _Pragma("unroll") for (int n = 0; n < 2; ++n) _Pragma("unroll") for (int k = 0; k < 2; ++k) dst[n][k] = *(const LAS bf16x8*)(lds + PG8_SB(b, h) + boff + n * 2048 + k * 1024); } while (0)
#define PG8_MMA(ai, bj, At, Bt) do { __builtin_amdgcn_s_setprio(1); _Pragma("unroll") for (int m = 0; m < 4; ++m) _Pragma("unroll") for (int n = 0; n < 2; ++n) _Pragma("unroll") for (int k = 0; k < 2; ++k) \
        acc[ai][bj][m][n] = __builtin_amdgcn_mfma_f32_16x16x32_bf16(Bt[n][k], At[m][k], acc[ai][bj][m][n], 0, 0, 0); __builtin_amdgcn_s_setprio(0); } while (0)
#define PG8_WAIT_V(n) asm volatile("s_waitcnt vmcnt(" #n ")" ::: "memory")
#define PG8_WAIT_L(n) asm volatile("s_waitcnt lgkmcnt(" #n ")" ::: "memory")
#define PG8_BAR __builtin_amdgcn_s_barrier()
#define PG8_SCHED __builtin_amdgcn_sched_barrier(0)
    Unit cur, nxt; int ui = 0;
    if (!S.next(0, cur)) return;
    f32x4 acc[2][2][4][2];
#pragma unroll
    for (int a = 0; a < 2; ++a)
#pragma unroll
        for (int b = 0; b < 2; ++b)
#pragma unroll
            for (int m = 0; m < 4; ++m)
#pragma unroll
                for (int n = 0; n < 2; ++n) acc[a][b][m][n] = (f32x4){0.f, 0.f, 0.f, 0.f};
    bf16x8 At[4][2], B0[2][2], B1[2][2];
    const char* cA = (const char*)g.A + (size_t)cur.pm * tstep; const char* cB = (const char*)g.Bt + (size_t)cur.pn * tstep;
    PG8_STAGE(PG8_SB(0, 0), cB, voffB); PG8_STAGE(PG8_SB(0, 1), cB + hstep, voffB); PG8_STAGE(PG8_SA(0, 0), cA, voffA); PG8_STAGE(PG8_SA(0, 1), cA + hstep, voffA);
    if (wr == 1) PG8_BAR;
    PG8_WAIT_V(2); PG8_BAR;
    PG8_STAGE(PG8_SB(1, 0), cB + kstep, voffB); PG8_STAGE(PG8_SA(1, 0), cA + kstep, voffA); PG8_STAGE(PG8_SB(1, 1), cB + hstep + kstep, voffB);
    PG8_WAIT_V(6); PG8_BAR;
    for (;;) {
        const bool has_next = S.next(ui + 1, nxt);
        const char* nA = has_next ? (const char*)g.A + (size_t)nxt.pm * tstep : cA; const char* nB = has_next ? (const char*)g.Bt + (size_t)nxt.pn * tstep : cB;
        for (int t = 0; t < nt; t += 2) {
            const bool last = (t == nt - 2);
            const char* a1 = cA + (size_t)(t + 1) * kstep;
            const char* a2 = last ? nA : cA + (size_t)(t + 2) * kstep; const char* b2 = last ? nB : cB + (size_t)(t + 2) * kstep;
            const char* a3 = a2 + kstep; const char* b3 = b2 + kstep;
            PG8_LDB(B0, 0, 0); PG8_LDB(B1, 0, 1); PG8_SCHED; PG8_LDA(At, 0, 0); PG8_STAGE(PG8_SA(1, 1), a1 + hstep, voffA);
            PG8_WAIT_V(8); PG8_WAIT_L(0); PG8_BAR; PG8_MMA(0, 0, At, B0); PG8_MMA(0, 1, At, B1); PG8_BAR; PG8_SCHED;
            PG8_LDA(At, 0, 1); PG8_STAGE(PG8_SB(0, 0), b2, voffB); PG8_STAGE(PG8_SB(0, 1), b2 + hstep, voffB); PG8_STAGE(PG8_SA(0, 0), a2, voffA);
            PG8_WAIT_V(8); PG8_WAIT_L(0); PG8_BAR; PG8_MMA(1, 0, At, B0); PG8_MMA(1, 1, At, B1); PG8_BAR; PG8_SCHED;
            PG8_LDB(B0, 1, 0); PG8_LDB(B1, 1, 1); PG8_SCHED; PG8_LDA(At, 1, 0); PG8_STAGE(PG8_SA(0, 1), a2 + hstep, voffA);
            PG8_WAIT_V(8); PG8_WAIT_L(0); PG8_BAR; PG8_MMA(0, 0, At, B0); PG8_MMA(0, 1, At, B1); PG8_BAR; PG8_SCHED;
            PG8_LDA(At, 1, 1); PG8_STAGE(PG8_SB(1, 0), b3, voffB); PG8_STAGE(PG8_SB(1, 1), b3 + hstep, voffB); PG8_STAGE(PG8_SA(1, 0), a3, voffA);
            PG8_WAIT_V(8); PG8_WAIT_L(0); PG8_BAR; PG8_MMA(1, 0, At, B0); PG8_MMA(1, 1, At, B1); PG8_BAR; PG8_SCHED;
        }
        if (wr == 0) PG8_BAR;
        E(acc, cur, wr, wc, fr, fq);
        if (!has_next) break;
#pragma unroll
        for (int a = 0; a < 2; ++a)
#pragma unroll
            for (int b = 0; b < 2; ++b)
#pragma unroll
                for (int m = 0; m < 4; ++m)
#pragma unroll
                    for (int n = 0; n < 2; ++n) acc[a][b][m][n] = (f32x4){0.f, 0.f, 0.f, 0.f};
        cur = nxt; cA = nA; cB = nB; ++ui;
        if (wr == 1) PG8_BAR;
    }
    PG8_WAIT_V(0);
    PG8_BAR;
#undef PG8_SA
#undef PG8_SB
#undef PG8_STAGE
#undef PG8_LDA
#undef PG8_LDB
#undef PG8_MMA
#undef PG8_WAIT_V
#undef PG8_WAIT_L
#undef PG8_BAR
#undef PG8_SCHED
}
}

namespace att {
constexpr int D = 128, NW = 8, QBLK = 32, KVBLK = 64;
constexpr float SCALE = 0.088388347648318440f;
constexpr float THR = 8.f;
constexpr int LDQ = INC, LDK = HD, LDO = DM;
constexpr size_t SHM_V = KVBLK * D * 2, SHM_K = KVBLK * D * 2, SHM_ATTN = 2 * SHM_V + 2 * SHM_K + NW * 64 * 4;
#define KSWZ(row, colB) ((row) * 256 + ((colB) ^ (((row) & 7) << 4)))
#define SBAR() __builtin_amdgcn_sched_barrier(0)
__device__ __forceinline__ int crow(int r, int hi) { return (r & 3) + 8 * (r >> 2) + 4 * hi; }
__device__ __forceinline__ unsigned cvtpk(float lo, float hi) { unsigned r; asm volatile("v_cvt_pk_bf16_f32 %0, %1, %2" : "=v"(r) : "v"(lo), "v"(hi)); return r; }
template <int NV> __device__ __forceinline__ void partialSM(f32x16& p0, f32x16& p1, float& m_reg, float& mn, float& alpha) {
    constexpr float C = SCALE * 1.4426950408889634f;
    float pmax = p0[0];
#pragma unroll
    for (int r = 1; r < 16; ++r) pmax = fmaxf(pmax, p0[r]);
#pragma unroll
    for (int r = 0; r < 16; ++r) pmax = fmaxf(pmax, p1[r]);
    { auto rr = __builtin_amdgcn_permlane32_swap(__float_as_uint(pmax), __float_as_uint(pmax), false, false);
      pmax = fmaxf(__uint_as_float(rr[0]), __uint_as_float(rr[1])); }
    if (__builtin_expect(__all(pmax - m_reg <= THR / SCALE), 1)) { mn = m_reg; alpha = 1.f; }
    else { mn = fmaxf(m_reg, pmax); alpha = __builtin_amdgcn_exp2f((m_reg - mn) * C); m_reg = mn; }
    float mnC = -mn * C;
#pragma unroll
    for (int r = 0; r < 16; ++r) p0[r] = fmaf(p0[r], C, mnC);
#pragma unroll
    for (int r = 0; r < 16; ++r) p1[r] = fmaf(p1[r], C, mnC);
#pragma unroll
    for (int r = 0; r < 16; ++r) p0[r] = __builtin_amdgcn_exp2f(p0[r]);
}
__device__ __forceinline__ void finishSM(f32x16& p0, f32x16& p1, float alpha, float& l_reg, bf16x8& pa0, bf16x8& pa1, bf16x8& pa2, bf16x8& pa3) {
#pragma unroll
    for (int r = 0; r < 16; ++r) p1[r] = __builtin_amdgcn_exp2f(p1[r]);
    float ps = 0;
#pragma unroll
    for (int r = 0; r < 16; ++r) ps += p0[r];
#pragma unroll
    for (int r = 0; r < 16; ++r) ps += p1[r];
    { auto rr = __builtin_amdgcn_permlane32_swap(__float_as_uint(ps), __float_as_uint(ps), false, false);
      ps = __uint_as_float(rr[0]) + __uint_as_float(rr[1]); }
    l_reg = l_reg * alpha + ps;
#define PK4(P, BASE, OUT) do { unsigned a0 = cvtpk(P[BASE + 0], P[BASE + 1]), a1 = cvtpk(P[BASE + 2], P[BASE + 3]);   \
    unsigned b0 = cvtpk(P[BASE + 4], P[BASE + 5]), b1 = cvtpk(P[BASE + 6], P[BASE + 7]);                              \
    auto r0 = __builtin_amdgcn_permlane32_swap(a0, b0, false, false); auto r1 = __builtin_amdgcn_permlane32_swap(a1, b1, false, false); \
    u32x4 w = {r0[0], r1[0], r0[1], r1[1]}; OUT = *reinterpret_cast<bf16x8*>(&w); } while (0)
    PK4(p0, 0, pa0); PK4(p0, 8, pa1); PK4(p1, 0, pa2); PK4(p1, 8, pa3);
#undef PK4
}
__device__ __forceinline__ void qkt(f32x16& p0, f32x16& p1, const bf16_t* Ks, const bf16x8* qr, int r32, int hi) {
    p0 = f32x16{}; p1 = f32x16{};
#pragma unroll
    for (int d0 = 0; d0 < 8; ++d0) { int cb = (d0 * 16 + hi * 8) * 2;
        bf16x8 b0 = *reinterpret_cast<const bf16x8*>((const char*)Ks + KSWZ(r32, cb));
        bf16x8 b1 = *reinterpret_cast<const bf16x8*>((const char*)Ks + KSWZ(32 + r32, cb));
        p0 = __builtin_amdgcn_mfma_f32_32x32x16_bf16(b0, qr[d0], p0, 0, 0, 0);
        p1 = __builtin_amdgcn_mfma_f32_32x32x16_bf16(b1, qr[d0], p1, 0, 0, 0); }
}
__device__ __forceinline__ int v_st(int k, int c) { const int kk = (k & ~0xC) | ((k & 4) << 1) | ((k & 8) >> 1); return ((kk >> 3) * 4 + (c >> 5)) * 512 + ((kk & 7) * 32 + (c & 31)) * 2; }
__device__ __forceinline__ int v_rd_base(int lane) { return ((lane & 3) << 3) | (((lane >> 2) & 3) << 6) | (((lane >> 4) & 1) << 5) | (((lane >> 5) & 1) << 8); }
constexpr int v_rd_off(int d0, int ks, int half) { return d0 * 512 + ks * 4096 + half * 2048; }
template <int OFF> __device__ __forceinline__ s16x4 tr_read(int vb) {
    s16x4 r; asm volatile("ds_read_b64_tr_b16 %0, %1 offset:%2" : "=&v"(r) : "v"(vb), "i"(OFF) : "memory"); return r;
}
template <int D0> __device__ __forceinline__ void pv_one(f32x16& od, int vb, bf16x8 pa0, bf16x8 pa1, bf16x8 pa2, bf16x8 pa3) {
    const s16x4 l0 = tr_read<v_rd_off(D0, 0, 0)>(vb), h0 = tr_read<v_rd_off(D0, 0, 1)>(vb), l1 = tr_read<v_rd_off(D0, 1, 0)>(vb), h1 = tr_read<v_rd_off(D0, 1, 1)>(vb);
    const s16x4 l2 = tr_read<v_rd_off(D0, 2, 0)>(vb), h2 = tr_read<v_rd_off(D0, 2, 1)>(vb), l3 = tr_read<v_rd_off(D0, 3, 0)>(vb), h3 = tr_read<v_rd_off(D0, 3, 1)>(vb);
    asm volatile("s_waitcnt lgkmcnt(0)" ::: "memory"); SBAR();
#define PK(L, H) (bf16x8){L[0], L[1], L[2], L[3], H[0], H[1], H[2], H[3]}
    od = __builtin_amdgcn_mfma_f32_32x32x16_bf16(pa0, PK(l0, h0), od, 0, 0, 0);
    od = __builtin_amdgcn_mfma_f32_32x32x16_bf16(pa1, PK(l1, h1), od, 0, 0, 0);
    od = __builtin_amdgcn_mfma_f32_32x32x16_bf16(pa2, PK(l2, h2), od, 0, 0, 0);
    od = __builtin_amdgcn_mfma_f32_32x32x16_bf16(pa3, PK(l3, h3), od, 0, 0, 0);
#undef PK
}
__device__ __forceinline__ void pv_d0(f32x16* o, int vb, bf16x8 pa0, bf16x8 pa1, bf16x8 pa2, bf16x8 pa3) {
    pv_one<0>(o[0], vb, pa0, pa1, pa2, pa3); pv_one<1>(o[1], vb, pa0, pa1, pa2, pa3); pv_one<2>(o[2], vb, pa0, pa1, pa2, pa3); pv_one<3>(o[3], vb, pa0, pa1, pa2, pa3);
}

__device__ __forceinline__ void attn_unit(const bf16_t* __restrict__ Qb, const bf16_t* __restrict__ Kh, const bf16_t* __restrict__ Vh, bf16_t* __restrict__ Ob, char* lds,
                                          const int s0, const float* __restrict__ gq, const f32x2* __restrict__ RT) {
    const int tid = threadIdx.x, wid = tid >> 6, lane = tid & 63, r32 = lane & 31, hi = lane >> 5;
    bf16_t* V_lds = (bf16_t*)lds; bf16_t* K_lds = (bf16_t*)(lds + 2 * SHM_V);
    float* ws = (float*)(lds + 2 * SHM_V + 2 * SHM_K) + wid * 64; float* li_l = ws; float* al_l = ws + 32;
    float m_reg = -1e30f, l_reg = 0; bf16x8 qr[8];
    const bf16_t* Qw = Qb + (long)(wid * QBLK + r32) * LDQ + hi * 8;
#pragma unroll
    for (int d0 = 0; d0 < 8; ++d0) qr[d0] = *reinterpret_cast<const bf16x8*>(Qw + d0 * 16);
    { float ss = 0.f;
#pragma unroll
      for (int d0 = 0; d0 < 8; ++d0)
#pragma unroll
          for (int j = 0; j < 8; ++j) { const float x = bf2f((bf16_t)qr[d0][j]); ss += x * x; }
      ss += __shfl_xor(ss, 32);
      const float rstd = 1.f / sqrtf(ss * (1.f / HD) + EPS);
      const int sq = s0 + wid * QBLK + r32, prow = sq >> 6, pcol = sq & 63;
#pragma unroll
      for (int pr = 0; pr < 4; ++pr) { const int da = (pr & 1) + 4 * (pr >> 1), db = da + 2; const int pos = (pr < 2) ? prow : pcol;
          const f32x4* cs4 = (const f32x4*)(RT + pos * 32 + (da & 1) * 16 + hi * 8);
          const f32x4* ga4 = (const f32x4*)(gq + da * 16 + hi * 8); const f32x4* gb4 = (const f32x4*)(gq + db * 16 + hi * 8);
          unsigned wa[4], wb[4];
#pragma unroll
          for (int jj = 0; jj < 4; ++jj) { const f32x4 cs = cs4[jj]; const f32x4 ga = ga4[jj >> 1], gb = gb4[jj >> 1];
              const int j = 2 * jj; const float g0a = (jj & 1) ? ga.z : ga.x, g1a = (jj & 1) ? ga.w : ga.y, g0b = (jj & 1) ? gb.z : gb.x, g1b = (jj & 1) ? gb.w : gb.y;
              const float xa0 = bf2f((bf16_t)qr[da][j]) * rstd * g0a, xa1 = bf2f((bf16_t)qr[da][j + 1]) * rstd * g1a;
              const float xb0 = bf2f((bf16_t)qr[db][j]) * rstd * g0b, xb1 = bf2f((bf16_t)qr[db][j + 1]) * rstd * g1b;
              wa[jj] = cvtpk(xa0 * cs.x - xb0 * cs.y, xa1 * cs.z - xb1 * cs.w);
              wb[jj] = cvtpk(xb0 * cs.x + xa0 * cs.y, xb1 * cs.z + xa1 * cs.w); }
          const u32x4 va = {wa[0], wa[1], wa[2], wa[3]}, vb = {wb[0], wb[1], wb[2], wb[3]};
          qr[da] = *reinterpret_cast<const bf16x8*>(&va); qr[db] = *reinterpret_cast<const bf16x8*>(&vb); } }
    f32x16 o[4] = {};
    const int sr = tid >> 4, sc = (tid & 15) * 8, vst0 = v_st(sr, sc), vst1 = v_st(32 + sr, sc);
    const int vb0 = (int)(uintptr_t)V_lds + v_rd_base(lane);
    struct { bf16x8 vs0, vs1, ks0, ks1; } sr_[2];
    const unsigned toff = (unsigned)(sr * LDK + sc) * 2u;
#define SLOAD(i, k0) do { const char* _kb = (const char*)Kh + (size_t)(k0) * (LDK * 2); const char* _vb = (const char*)Vh + (size_t)(k0) * (LDK * 2); \
    sr_[i].vs0 = *reinterpret_cast<const bf16x8*>(_vb + toff); sr_[i].vs1 = *reinterpret_cast<const bf16x8*>(_vb + 32 * LDK * 2 + toff); \
    sr_[i].ks0 = *reinterpret_cast<const bf16x8*>(_kb + toff); sr_[i].ks1 = *reinterpret_cast<const bf16x8*>(_kb + 32 * LDK * 2 + toff); } while (0)
#define SWRITE(b, i) do { *(bf16x8*)((char*)V_lds + (b) * SHM_V + vst0) = sr_[i].vs0;          \
    *(bf16x8*)((char*)V_lds + (b) * SHM_V + vst1) = sr_[i].vs1; int kc = sc * 2;               \
    *(bf16x8*)((char*)K_lds + (b) * SHM_K + KSWZ(sr, kc)) = sr_[i].ks0;                       \
    *(bf16x8*)((char*)K_lds + (b) * SHM_K + KSWZ(32 + sr, kc)) = sr_[i].ks1; } while (0)
#define SWAIT() asm volatile("s_waitcnt vmcnt(4)" ::: "memory")
#define RESC(a) do { if (__any((a) < 1.f)) { if (hi == 0) al_l[r32] = (a); asm volatile("s_waitcnt lgkmcnt(0)" ::: "memory"); \
    _Pragma("unroll") for (int d = 0; d < 4; ++d) _Pragma("unroll") for (int r = 0; r < 16; ++r) o[d][r] *= al_l[crow(r, hi)]; } } while (0)
    f32x16 pA0, pA1, pB0, pB1; float mnA, mnB, alA, alB; bf16x8 pa0, pa1, pa2, pa3; constexpr int NT = KPAD / KVBLK; static_assert(NT == NT_REAL + 2, "tile count");
    constexpr int SE = 0, SO = 1;
    SLOAD(SE, 0); asm volatile("s_waitcnt vmcnt(0)" ::: "memory"); SWRITE(0, SE); __syncthreads();
    qkt(pA0, pA1, K_lds, qr, r32, hi); partialSM<64>(pA0, pA1, m_reg, mnA, alA);
    SLOAD(SO, KVBLK); SLOAD(SE, 2 * KVBLK);
    SWAIT(); SWRITE(1, SO); __syncthreads();
    for (int j = 1; j + 1 < NT; j += 2) {
        SBAR(); qkt(pB0, pB1, (bf16_t*)((char*)K_lds + SHM_K), qr, r32, hi);
        finishSM(pA0, pA1, alA, l_reg, pa0, pa1, pa2, pa3); SBAR();
        SLOAD(SO, (j + 2) * KVBLK); SBAR();
        pv_d0(o, vb0, pa0, pa1, pa2, pa3); partialSM<64>(pB0, pB1, m_reg, mnB, alB);
        __syncthreads(); SWAIT(); SWRITE(0, SE);
        RESC(alB); __syncthreads();
        SBAR(); qkt(pA0, pA1, K_lds, qr, r32, hi);
        finishSM(pB0, pB1, alB, l_reg, pa0, pa1, pa2, pa3); SBAR();
        if (j + 3 < NT) SLOAD(SE, (j + 3) * KVBLK); SBAR();
        pv_d0(o, vb0 + (int)SHM_V, pa0, pa1, pa2, pa3); partialSM<64>(pA0, pA1, m_reg, mnA, alA);
        __syncthreads(); SWAIT(); SWRITE(1, SO);
        RESC(alA); __syncthreads();
    }
    SBAR(); qkt(pB0, pB1, (bf16_t*)((char*)K_lds + SHM_K), qr, r32, hi);
    finishSM(pA0, pA1, alA, l_reg, pa0, pa1, pa2, pa3); SBAR();
    pv_d0(o, vb0, pa0, pa1, pa2, pa3); partialSM<64>(pB0, pB1, m_reg, mnB, alB);
    __syncthreads(); RESC(alB);
    finishSM(pB0, pB1, alB, l_reg, pa0, pa1, pa2, pa3); SBAR();
    pv_d0(o, vb0 + (int)SHM_V, pa0, pa1, pa2, pa3);
    l_reg -= (float)(KPAD - LTOT) * __builtin_amdgcn_exp2f(-m_reg * (SCALE * 1.4426950408889634f));
    if (hi == 0) li_l[r32] = l_reg; asm volatile("s_waitcnt lgkmcnt(0)" ::: "memory");
    float rli[16];
#pragma unroll
    for (int r = 0; r < 16; ++r) rli[r] = __builtin_amdgcn_rcpf(li_l[crow(r, hi)]);
    bf16_t* Ow = Ob + (long)(wid * QBLK) * LDO;
    const int odd = lane & 1;
#pragma unroll
    for (int r = 0; r < 16; r += 2) {
#pragma unroll
        for (int d0 = 0; d0 < 4; ++d0) {
            const float a = o[d0][r] * rli[r], b = o[d0][r + 1] * rli[r + 1];
            const float send = odd ? a : b;
            const float recv = __builtin_bit_cast(float, __builtin_amdgcn_update_dpp(0, __builtin_bit_cast(int, send), 0xB1, 0xF, 0xF, false));
            const float plo = odd ? recv : a, phi = odd ? b : recv;
            const unsigned w = cvtpk(plo, phi);
            const int orow = crow(odd ? r + 1 : r, hi);
            *(unsigned*)(Ow + (long)orow * LDO + d0 * 32 + (r32 & ~1)) = w;
        }
    }
    __syncthreads();
#undef SLOAD
#undef SWRITE
#undef SWAIT
#undef RESC
}
}

#define XB_TMO      128
#define XB_XCNT(j)  (256  + 64 * (j))
#define XB_XSUB(j)  (1280 + 64 * (j))
#define XB_XGEN(j)  (2304 + 64 * (j))
#define XB_TOP      3328
#define XB_TOPGEN   3392
#define XCD_BAR_WORDS 3456
#define XB_SPIN_CAP (1u << 22)
__device__ __forceinline__ unsigned xb_ld(unsigned* p)              { return __hip_atomic_load(p, __ATOMIC_RELAXED, __HIP_MEMORY_SCOPE_AGENT); }
__device__ __forceinline__ unsigned xb_add(unsigned* p, unsigned v) { return __hip_atomic_fetch_add(p, v, __ATOMIC_RELAXED, __HIP_MEMORY_SCOPE_AGENT); }
__device__ __forceinline__ unsigned xb_xcc_id() { return (unsigned)__builtin_amdgcn_s_getreg((3 << 11) | 20) & 0xFu; }
#define XB_SPIN(cond, bar) do { unsigned _sp = 0; while (cond) { __builtin_amdgcn_s_sleep(1); \
    if ((++_sp & 255u) == 0u) { if (xb_ld(&(bar)[XB_TMO])) break; if (_sp > XB_SPIN_CAP) { atomicAdd(&(bar)[XB_TMO], 1u); break; } } } } while (0)
struct XcdBarrier { unsigned* bar; unsigned x; volatile LAS unsigned* st; };
__device__ __forceinline__ XcdBarrier xcd_barrier_post(unsigned* bar, volatile LAS unsigned* st) {
    XcdBarrier b; b.bar = bar; b.x = xb_xcc_id(); b.st = st;
    if (threadIdx.x == 0) (void)xb_add(&bar[XB_XCNT(b.x)], 1u);
    return b;
}
__device__ __forceinline__ void xcd_barrier_complete(unsigned* bar, unsigned x, unsigned& nloc, unsigned& nx) {
    const unsigned G = gridDim.x * gridDim.y * gridDim.z;
    unsigned sum, cnt, mine, sp = 0u;
    for (;;) {
        sum = 0u; cnt = 0u; mine = 0u;
#pragma unroll
        for (unsigned j = 0; j < 16; ++j) { const unsigned c = xb_ld(&bar[XB_XCNT(j)]); sum += c; cnt += (c > 0u) ? 1u : 0u; mine = (j == x) ? c : mine; }
        if (sum == G) break;
        __builtin_amdgcn_s_sleep(1);
        if ((++sp & 255u) == 0u) { if (xb_ld(&bar[XB_TMO])) break; if (sp > XB_SPIN_CAP) { atomicAdd(&bar[XB_TMO], 1u); break; } }
    }
    nloc = mine > 0u ? mine : 1u; nx = cnt > 0u ? cnt : 1u;
}
__device__ __forceinline__ void xcd_barrier(const XcdBarrier& b) {
    asm volatile("s_waitcnt vmcnt(0)" ::: "memory");
    __syncthreads();
    if (threadIdx.x == 0) {
        unsigned* bar = b.bar;
        __builtin_amdgcn_s_waitcnt(0);
        unsigned nloc = b.st[0], nx = b.st[1];
        if (nloc == 0u) { xcd_barrier_complete(bar, b.x, nloc, nx); b.st[0] = nloc; b.st[1] = nx; }
        const unsigned old = xb_add(&bar[XB_XSUB(b.x)], 1u);
        const unsigned gen = old / nloc;
        if (old + 1u == (gen + 1u) * nloc) {
            __builtin_amdgcn_fence(__ATOMIC_RELEASE, "agent");
            asm volatile("s_waitcnt vmcnt(0)" ::: "memory");
            const unsigned og = xb_add(&bar[XB_TOP], 1u);
            const unsigned tg = og / nx;
            if (og + 1u == (tg + 1u) * nx) xb_add(&bar[XB_TOPGEN], 1u);
            else XB_SPIN(xb_ld(&bar[XB_TOPGEN]) == tg, bar);
            __builtin_amdgcn_fence(__ATOMIC_ACQUIRE, "agent");
            xb_add(&bar[XB_XGEN(b.x)], 1u);
            asm volatile("s_waitcnt vmcnt(0)" ::: "memory");
        } else {
            XB_SPIN(xb_ld(&bar[XB_XGEN(b.x)]) == gen, bar);
            __builtin_amdgcn_fence(__ATOMIC_ACQUIRE, "agent");
            asm volatile("s_waitcnt vmcnt(0)" ::: "memory");
        }
    }
    __syncthreads();
}

struct Args { const float* in[21]; float* out; unsigned char* ws; int ph_lo, ph_hi; };
struct Frame {
    LAS unsigned char* lds; char* ldsg;
    int tid, lane, wave, vcu, G;
    float* out; unsigned char* ws;
};
#define IN_X 0
#define IN_META 1
#define IN_G1 2
#define IN_WIN 3
#define IN_QG 4
#define IN_KG 5
#define IN_CW 6
#define IN_CB 7
#define IN_WRG 8
#define IN_BRG 9
#define IN_WIG 10
#define IN_BIG 11
#define IN_LAM 12
#define IN_GA 13
#define IN_GL 14
#define IN_WOUT 15
#define IN_G2 16
#define IN_WQ 17
#define IN_SK 18
#define IN_U 19
#define IN_V 20

struct TItem { const float* W; const float* gk; bf16_t* WT; int N, K, k0, n0; };
__device__ __forceinline__ void p0_item_load(const TItem& T, int lane, f32x4 (&v)[16], float (&g)[16]) {
    const int kq = lane >> 4, nq = lane & 15;
#pragma unroll
    for (int i = 0; i < 16; ++i) { const int kk = 4 * i + kq; v[i] = *(const f32x4*)(T.W + (size_t)(T.k0 + kk) * T.N + T.n0 + 4 * nq); g[i] = T.gk ? T.gk[T.k0 + kk] : 1.f; }
}
__device__ __forceinline__ void p0_item_store(const TItem& T, int lane, const f32x4 (&v)[16], const float (&g)[16], LAS float* scr) {
    const int kq = lane >> 4, nq = lane & 15;
#pragma unroll
    for (int i = 0; i < 16; ++i) { const int kk = 4 * i + kq; LAS float* d = scr + kk * 65 + 4 * nq; d[0] = v[i].x * g[i]; d[1] = v[i].y * g[i]; d[2] = v[i].z * g[i]; d[3] = v[i].w * g[i]; }
    LDS_WAIT(); asm volatile("" ::: "memory");
    const int c = lane & 7;
#pragma unroll
    for (int j = 0; j < 8; ++j) { const int n = (lane >> 3) + 8 * j; const LAS float* sp = scr + (8 * c) * 65 + n;
        u32x4 o; o.x = pk2(sp[0 * 65], sp[1 * 65]); o.y = pk2(sp[2 * 65], sp[3 * 65]); o.z = pk2(sp[4 * 65], sp[5 * 65]); o.w = pk2(sp[6 * 65], sp[7 * 65]);
        *(u32x4*)(T.WT + (size_t)(T.n0 + n) * T.K + T.k0 + 8 * c) = o; }
    LDS_WAIT(); asm volatile("" ::: "memory");
}
__device__ __forceinline__ TItem p0_item_decode(Frame& F, const Args& A, int it) {
    constexpr int I_1 = (DM / 64) * (INC / 64), I_2 = (DM / 64) * (DM / 64), I_3 = (DM / 64) * (2048 / 64);
    TItem T; int r = it;
    if (r < I_1) { T.W = A.in[IN_WIN]; T.gk = A.in[IN_G1]; T.WT = (bf16_t*)(F.ws + WS_WT1); T.N = INC; T.K = DM; }
    else if ((r -= I_1) < I_2) { const int kb = r / (DM / 64); T.W = A.in[IN_WOUT]; T.gk = (kb < 32) ? A.in[IN_GA] : (A.in[IN_GL] - DATT); T.WT = (bf16_t*)(F.ws + WS_WT2); T.N = DM; T.K = DM; }
    else if ((r -= I_2) < I_3) { T.W = A.in[IN_WQ]; T.gk = A.in[IN_G2]; T.WT = (bf16_t*)(F.ws + WS_WT3); T.N = 2048; T.K = DM; }
    else { r -= I_3; const int mat = r >> 2; const int dirn = mat >> 1, gate = mat & 1;
        T.W = (gate ? A.in[IN_WIG] : A.in[IN_WRG]) + (size_t)dirn * 128 * 128; T.gk = nullptr; T.WT = (bf16_t*)(F.ws + WS_WG) + (size_t)mat * 128 * 128; T.N = 128; T.K = 128; r &= 3; }
    const int nblk = T.N / 64; T.k0 = 64 * (r / nblk); T.n0 = 64 * (r % nblk);
    return T;
}
__device__ __forceinline__ void p0_prologue(Frame& F, const Args& A) {
    LAS float* scr = (LAS float*)(F.lds + F.wave * 16640);
    const int gw = F.vcu * NWAVES + F.wave, NGW = F.G * NWAVES, lane = F.lane;
    constexpr int NITEMS = (DM / 64) * (INC / 64) + (DM / 64) * (DM / 64) + (DM / 64) * (2048 / 64) + 64 * 4;
    if (gw < NITEMS) {
        TItem T = p0_item_decode(F, A, gw); f32x4 v[16]; float g[16];
        p0_item_load(T, lane, v, g);
        for (int it = gw; it < NITEMS; it += NGW) {
            TItem Tn = T; f32x4 vn[16]; float gn[16];
            const bool more = it + NGW < NITEMS;
            if (more) { Tn = p0_item_decode(F, A, it + NGW); p0_item_load(Tn, lane, vn, gn); }
            p0_item_store(T, lane, v, g, scr);
            if (more) { T = Tn;
#pragma unroll
                for (int i = 0; i < 16; ++i) { v[i] = vn[i]; g[i] = gn[i]; } }
        }
    }
    bf16_t* XN = (bf16_t*)(F.ws + WS_XN);
    { f32x4 vn[16];
      if (gw < MR + NMETA) { const f32x4* xr = (const f32x4*)((gw < MR) ? A.in[IN_X] + (size_t)gw * DM : A.in[IN_META] + (size_t)(gw - MR) * DM) + lane;
#pragma unroll
          for (int j = 0; j < 16; ++j) vn[j] = xr[64 * j]; }
      for (int m = gw; m < MR + NMETA; m += NGW) {
        f32x4 v[16]; float s = 0.f;
#pragma unroll
        for (int j = 0; j < 16; ++j) { v[j] = vn[j]; s += (v[j].x * v[j].x + v[j].y * v[j].y) + (v[j].z * v[j].z + v[j].w * v[j].w); }
        { const int mn = m + NGW;
          if (mn < MR + NMETA) { const f32x4* xr = (const f32x4*)((mn < MR) ? A.in[IN_X] + (size_t)mn * DM : A.in[IN_META] + (size_t)(mn - MR) * DM) + lane;
#pragma unroll
              for (int j = 0; j < 16; ++j) vn[j] = xr[64 * j]; } }
        const float rstd = 1.f / sqrtf(wave_sum(s) * (1.f / DM) + EPS);
        u32x2* o8 = (u32x2*)(XN + (size_t)m * DM) + lane;
#pragma unroll
        for (int j = 0; j < 16; ++j) { u32x2 w; w.x = pk2(v[j].x * rstd, v[j].y * rstd); w.y = pk2(v[j].z * rstd, v[j].w * rstd); o8[64 * j] = w; }
      } }
    { const float* sk = A.in[IN_SK]; bf16_t* SKB = (bf16_t*)(F.ws + WS_SKB);
      for (int i = gw * 64 + lane; i < PH * 2 * NKEYS * 128 / 4; i += NGW * 64) { const f32x4 v = ((const f32x4*)sk)[i]; u32x2 w; w.x = pk2(v.x, v.y); w.y = pk2(v.z, v.w); ((u32x2*)SKB)[i] = w; }
      f32x2* RT = (f32x2*)(F.ws + WS_ROPE);
      for (int i = gw * 64 + lane; i < 64 * 32; i += NGW * 64) { const int p = i >> 5, j = i & 31;
          const float inv = exp2f(-(float)j * (13.287712379549449f / 32.f)); const float ang = (float)p * inv;
          float rev = ang * 0.15915494309189535f; rev -= floorf(rev);
          f32x2 cs; cs.x = __builtin_amdgcn_cosf(rev); cs.y = __builtin_amdgcn_sinf(rev); RT[i] = cs; } }
}

__device__ __forceinline__ void p1_meta_gemm(Frame& F, const Args& A) {
    const bf16_t* XNm = (const bf16_t*)(F.ws + WS_XN) + (size_t)MR * DM; const bf16_t* WT1 = (const bf16_t*)(F.ws + WS_WT1); bf16_t* ZM = (bf16_t*)(F.ws + WS_ZM);
    LAS float* red = (LAS float*)F.lds;
    const int lane = F.lane, c16 = lane & 15, q = lane >> 4;
    for (int item = F.vcu; item < (OFF_Y - OFF_K) / 16; item += F.G) {
        const int n0 = OFF_K + 16 * item;
        f32x4 acc = {0.f, 0.f, 0.f, 0.f};
        const bf16_t* ap = XNm + (size_t)c16 * DM + F.wave * 512 + 8 * q; const bf16_t* bp = WT1 + (size_t)(n0 + c16) * DM + F.wave * 512 + 8 * q;
#pragma unroll
        for (int ks = 0; ks < 16; ++ks) { const bf16x8 a = *(const bf16x8*)(ap + 32 * ks), b = *(const bf16x8*)(bp + 32 * ks); acc = __builtin_amdgcn_mfma_f32_16x16x32_bf16(a, b, acc, 0, 0, 0); }
#pragma unroll
        for (int r = 0; r < 4; ++r) red[F.wave * 256 + (4 * q + r) * 16 + c16] = acc[r];
        __syncthreads();
        if (F.tid < 256) { float s = 0.f;
#pragma unroll
            for (int w = 0; w < 8; ++w) s += red[w * 256 + F.tid];
            ZM[(size_t)(F.tid >> 4) * INC + n0 + (F.tid & 15)] = (bf16_t)f2bf(s); }
        __syncthreads();
    }
}

template <int dir> __device__ __forceinline__ void scan_unit(Frame& F, const Args& A, int u) {
    const int half = (u >> 1) & 1, n = (u >> 2) & 15, b = u >> 6;
    const int tid = F.tid, lane = F.lane, wave = F.wave;
    const bf16_t* Z = (const bf16_t*)(F.ws + WS_Z); const bf16_t* ZM = (const bf16_t*)(F.ws + WS_ZM);
    bf16_t* HO = (bf16_t*)(F.ws + (dir ? WS_HB : WS_HF));
    LAS unsigned char* XR = F.lds;
    LAS unsigned char* XC = F.lds + 18432;
    LAS float* AS = (LAS float*)(F.lds + 35840);
    LAS float* BS = (LAS float*)(F.lds + 52224);
    LAS float* HS = (LAS float*)(F.lds + 68608);
    LAS float* SM = (LAS float*)(F.lds + 84992);
    LAS float* CR = (LAS float*)(F.lds + 89088);
    const int mt = wave & 3, dh = wave >> 2, r16 = lane & 15, q4 = lane >> 4;
    bf16x8 bw[4][4];
#pragma unroll
    for (int nt = 0; nt < 4; ++nt) { const int gate = nt >> 1, dcol = 64 * half + 32 * dh + 16 * (nt & 1) + r16;
        const bf16_t* wp = (const bf16_t*)(F.ws + WS_WG) + ((size_t)((dir * 16 + n) * 2 + gate) * 128 + dcol) * 128 + 8 * q4;
#pragma unroll
        for (int ks = 0; ks < 4; ++ks) bw[nt][ks] = *(const bf16x8*)(wp + 32 * ks); }
    float br[2], bi[2], sp8[2];
#pragma unroll
    for (int db = 0; db < 2; ++db) { const int che = 128 * n + 64 * half + 32 * dh + 16 * db + r16;
        br[db] = A.in[IN_BRG][dir * DRNN + che]; bi[db] = A.in[IN_BIG][dir * DRNN + che]; sp8[db] = 8.f * log1pf(__expf(-A.in[IN_LAM][dir * DRNN + che])); }
    const int cp = tid & 63, tg = tid >> 6;
    float cw[2][4], cb[2];
#pragma unroll
    for (int c = 0; c < 2; ++c) { const int ch = 128 * n + 2 * cp + c;
#pragma unroll
        for (int j = 0; j < 4; ++j) cw[c][j] = A.in[IN_CW][j * DRNN + ch];
        cb[c] = A.in[IN_CB][ch]; }
    const int ntile = dir ? 64 : 65;
    const int lr = tid >> 4, lc = tid & 15;
    u32x4 pf[3];
#define TILE_P0(it) (dir ? (NMETA + 64 * (63 - (it))) : ((it) == 0 ? -48 : NMETA + 64 * ((it) - 1)))
#define XR_PREFETCH(it) do { const int _p0 = TILE_P0(it); _Pragma("unroll") for (int _j = 0; _j < 3; ++_j) { const int _r = lr + 32 * _j; const int _p = _p0 - 2 + _r; u32x4 _v = {0u, 0u, 0u, 0u}; \
        if (_r < 67 && _p >= 0 && _p < LTOT) { const bf16_t* _row = (_p < NMETA) ? (ZM + (size_t)_p * INC) : (Z + (size_t)(b * SEQ + _p - NMETA) * INC); _v = *(const u32x4*)(_row + OFF_X + 128 * n + 8 * lc); } pf[_j] = _v; } } while (0)
    XR_PREFETCH(0);
    if (tid < 128) CR[tid] = 0.f;
    for (int it = 0; it < ntile; ++it) {
        const int p0 = TILE_P0(it);
#pragma unroll
        for (int j = 0; j < 3; ++j) { const int r = lr + 32 * j; if (r < 67) *(LAS u32x4*)(XR + r * 272 + lc * 16) = pf[j]; }
        __syncthreads();
        if (it + 1 < ntile) XR_PREFETCH(it + 1);
        { float x0[11], x1[11];
#pragma unroll
          for (int i = 0; i < 11; ++i) { const unsigned w = *(const LAS unsigned*)(XR + (8 * tg + i) * 272 + cp * 4); x0[i] = bflo(w); x1[i] = bfhi(w); }
#pragma unroll
          for (int i = 0; i < 8; ++i) { const float y0 = cw[0][0] * x0[i] + cw[0][1] * x0[i + 1] + cw[0][2] * x0[i + 2] + cw[0][3] * x0[i + 3] + cb[0];
              const float y1 = cw[1][0] * x1[i] + cw[1][1] * x1[i + 1] + cw[1][2] * x1[i + 2] + cw[1][3] * x1[i + 3] + cb[1];
              *(LAS unsigned*)(XC + (8 * tg + i) * 272 + cp * 4) = pk2(y0, y1); } }
        __syncthreads();
        { bf16x8 af[4];
#pragma unroll
          for (int ks = 0; ks < 4; ++ks) af[ks] = *(const LAS bf16x8*)(XC + (16 * mt + r16) * 272 + (32 * ks + 8 * q4) * 2);
          f32x4 acc[4];
#pragma unroll
          for (int nt = 0; nt < 4; ++nt) { acc[nt] = (f32x4){0.f, 0.f, 0.f, 0.f};
#pragma unroll
              for (int ks = 0; ks < 4; ++ks) acc[nt] = __builtin_amdgcn_mfma_f32_16x16x32_bf16(af[ks], bw[nt][ks], acc[nt], 0, 0, 0); }
#pragma unroll
          for (int db = 0; db < 2; ++db)
#pragma unroll
              for (int rg = 0; rg < 4; ++rg) { const int t = 16 * mt + 4 * q4 + rg, dloc = 32 * dh + 16 * db + r16;
                  const float gr = acc[db][rg] + br[db], gi = acc[2 + db][rg] + bi[db];
                  const float rr = __builtin_amdgcn_rcpf(1.f + __expf(-gr)), ii = __builtin_amdgcn_rcpf(1.f + __expf(-gi));
                  const float la = -sp8[db] * rr; float a = __expf(la);
                  const float x2 = 2.f * la;
                  const float ser = -x2 * (1.f + 0.5f * x2 * (1.f + (1.f / 3.f) * x2 * (1.f + 0.25f * x2 * (1.f + 0.2f * x2))));
                  const float om = (x2 > -0.125f) ? ser : (1.f - a * a);
                  const float xcv = bf2f(*(const LAS bf16_t*)(XC + t * 272 + (64 * half + dloc) * 2));
                  float bb = sqrtf(om) * (ii * xcv);
                  if (p0 + t < 0) { a = 1.f; bb = 0.f; }
                  AS[t * 64 + dloc] = a; BS[t * 64 + dloc] = bb; } }
        __syncthreads();
        float hl[8], pl[8];
        { float h = 0.f, pr = 1.f;
#pragma unroll
          for (int i = 0; i < 8; ++i) { const int j = 8 * wave + i, t = dir ? 63 - j : j; const float a = AS[t * 64 + lane], bq = BS[t * 64 + lane]; h = a * h + bq; pr *= a; hl[i] = h; pl[i] = pr; }
          SM[(wave * 64 + lane) * 2] = pr; SM[(wave * 64 + lane) * 2 + 1] = h; }
        __syncthreads();
        { float hin = CR[(it & 1) * 64 + lane];
          float sp_[7], sh_[7];
#pragma unroll
          for (int v = 0; v < 7; ++v) { sp_[v] = SM[(v * 64 + lane) * 2]; sh_[v] = SM[(v * 64 + lane) * 2 + 1]; }
#pragma unroll
          for (int v = 0; v < 7; ++v) hin = (v < wave) ? (sp_[v] * hin + sh_[v]) : hin;
#pragma unroll
          for (int i = 0; i < 8; ++i) { const int j = 8 * wave + i, t = dir ? 63 - j : j; const float h = hl[i] + pl[i] * hin; HS[t * 64 + lane] = h; if (i == 7 && wave == 7) CR[((it + 1) & 1) * 64 + lane] = h; } }
        __syncthreads();
        if (p0 >= NMETA) {
            const int c2 = (tid & 31) * 2;
#pragma unroll
            for (int ps = 0; ps < 4; ++ps) { const int t = (tid >> 5) + 16 * ps; const size_t m = (size_t)b * SEQ + (p0 + t - NMETA);
                *(unsigned*)(HO + m * DRNN + 128 * n + 64 * half + c2) = pk2(HS[t * 64 + c2], HS[t * 64 + c2 + 1]); }
        }
    }
    __syncthreads();
#undef TILE_P0
#undef XR_PREFETCH
}

__device__ __forceinline__ void normrope_rows(Frame& F, const Args& A) {
    const int gw = F.vcu * NWAVES + F.wave, NGW = F.G * NWAVES, lane = F.lane;
    bf16_t* Z = (bf16_t*)(F.ws + WS_Z); const bf16_t* ZM = (const bf16_t*)(F.ws + WS_ZM);
    bf16_t* KP = (bf16_t*)(F.ws + WS_KP); bf16_t* VP = (bf16_t*)(F.ws + WS_VP);
    const f32x2* RT = (const f32x2*)(F.ws + WS_ROPE);
    const int g = lane >> 4, i16 = lane & 15, j0 = 2 * i16;
    float gq[8], gk[8];
#pragma unroll
    for (int s = 0; s < 4; ++s) { gq[2 * s] = A.in[IN_QG][32 * s + j0]; gq[2 * s + 1] = A.in[IN_QG][32 * s + j0 + 1]; gk[2 * s] = A.in[IN_KG][32 * s + j0]; gk[2 * s + 1] = A.in[IN_KG][32 * s + j0 + 1]; }
    const int NIT = NB * KPAD;
    for (int it = gw; it < NIT; it += NGW) {
        const int b = it / KPAD, kidx = it - b * KPAD; const bool meta = (kidx >= SEQ) && (kidx < LTOT), pad = kidx >= LTOT;
        const bf16_t* row = meta ? (ZM + (size_t)(kidx - SEQ) * INC) : (Z + (size_t)(b * SEQ + (pad ? 0 : kidx)) * INC);
        if (pad) { const u32x4 z = {0u, 0u, 0u, 0u};
            *(u32x4*)(KP + ((size_t)(b * NKV + g) * KPAD + kidx) * HD + i16 * 8) = z; *(u32x4*)(VP + ((size_t)(b * NKV + g) * KPAD + kidx) * HD + i16 * 8) = z; continue; }
        f32x2 cr0 = {1.f, 0.f}, cr1 = {1.f, 0.f}, cc0 = {1.f, 0.f}, cc1 = {1.f, 0.f};
        if (!meta) { const int prow = kidx >> 6, pcol = kidx & 63; cr0 = RT[prow * 32 + j0]; cr1 = RT[prow * 32 + j0 + 1]; cc0 = RT[pcol * 32 + j0]; cc1 = RT[pcol * 32 + j0 + 1]; }
        { const bf16_t* base = row + OFF_K + g * HD;
          unsigned e[4];
#pragma unroll
          for (int sgm = 0; sgm < 4; ++sgm) e[sgm] = *(const unsigned*)(base + 32 * sgm + j0);
          float x[8]; float ss = 0.f;
#pragma unroll
          for (int sgm = 0; sgm < 4; ++sgm) { x[2 * sgm] = bflo(e[sgm]); x[2 * sgm + 1] = bfhi(e[sgm]); ss += x[2 * sgm] * x[2 * sgm] + x[2 * sgm + 1] * x[2 * sgm + 1]; }
          ss += __shfl_xor(ss, 1); ss += __shfl_xor(ss, 2); ss += __shfl_xor(ss, 4); ss += __shfl_xor(ss, 8);
          const float rstd = 1.f / sqrtf(ss * (1.f / HD) + EPS);
#pragma unroll
          for (int k = 0; k < 8; ++k) x[k] = x[k] * rstd * gk[k];
          float y[8];
          y[0] = x[0] * cr0.x - x[2] * cr0.y; y[2] = x[2] * cr0.x + x[0] * cr0.y;
          y[1] = x[1] * cr1.x - x[3] * cr1.y; y[3] = x[3] * cr1.x + x[1] * cr1.y;
          y[4] = x[4] * cc0.x - x[6] * cc0.y; y[6] = x[6] * cc0.x + x[4] * cc0.y;
          y[5] = x[5] * cc1.x - x[7] * cc1.y; y[7] = x[7] * cc1.x + x[5] * cc1.y;
          bf16_t* dst = KP + ((size_t)(b * NKV + g) * KPAD + kidx) * HD;
#pragma unroll
          for (int sgm = 0; sgm < 4; ++sgm) *(unsigned*)(dst + 32 * sgm + j0) = pk2(y[2 * sgm], y[2 * sgm + 1]); }
        { const u32x4 vv = *(const u32x4*)(row + OFF_V + lane * 8);
          *(u32x4*)(VP + ((size_t)(b * NKV + g) * KPAD + kidx) * HD + i16 * 8) = vv; }
    }
}

__device__ __forceinline__ void combine_rows(Frame& F, const Args& A) {
    const int gw = F.vcu * NWAVES + F.wave, NGW = F.G * NWAVES, lane = F.lane;
    bf16_t* MRG = (bf16_t*)(F.ws + WS_MRG); const bf16_t* HFp = (const bf16_t*)(F.ws + WS_HF); const bf16_t* HBp = (const bf16_t*)(F.ws + WS_HB); const bf16_t* Z = (const bf16_t*)(F.ws + WS_Z);
    for (int m = gw; m < MR; m += NGW) {
        u32x4* ap = (u32x4*)(MRG + (size_t)m * DM) + lane;
        u32x4 av[4]; float sa = 0.f;
#pragma unroll
        for (int j = 0; j < 4; ++j) { av[j] = ap[64 * j];
#pragma unroll
            for (int k = 0; k < 4; ++k) { const float lo = bflo(av[j][k]), hi = bfhi(av[j][k]); sa += lo * lo + hi * hi; } }
        const u32x4* fp = (const u32x4*)(HFp + (size_t)m * DRNN) + lane; const u32x4* bp = (const u32x4*)(HBp + (size_t)m * DRNN) + lane; const u32x4* yp = (const u32x4*)(Z + (size_t)m * INC + OFF_Y) + lane;
        float lv[32]; float sl = 0.f;
#pragma unroll
        for (int j = 0; j < 4; ++j) { const u32x4 f = fp[64 * j], bq = bp[64 * j], y = yp[64 * j];
#pragma unroll
            for (int k = 0; k < 4; ++k) { const float l0 = (bflo(f[k]) + bflo(bq[k])) * gelu_tanh(bflo(y[k])), l1 = (bfhi(f[k]) + bfhi(bq[k])) * gelu_tanh(bfhi(y[k]));
                lv[8 * j + 2 * k] = l0; lv[8 * j + 2 * k + 1] = l1; sl += l0 * l0 + l1 * l1; } }
        const float ra = 1.f / sqrtf(wave_sum(sa) * (1.f / DATT) + EPS), rl = 1.f / sqrtf(wave_sum(sl) * (1.f / DRNN) + EPS);
#pragma unroll
        for (int j = 0; j < 4; ++j) { u32x4 w;
#pragma unroll
            for (int k = 0; k < 4; ++k) w[k] = pk2(bflo(av[j][k]) * ra, bfhi(av[j][k]) * ra);
            ap[64 * j] = w; }
        u32x4* lp = (u32x4*)(MRG + (size_t)m * DM + DATT) + lane;
#pragma unroll
        for (int j = 0; j < 4; ++j) { u32x4 w;
#pragma unroll
            for (int k = 0; k < 4; ++k) w[k] = pk2(lv[8 * j + 2 * k] * rl, lv[8 * j + 2 * k + 1] * rl);
            lp[64 * j] = w; }
    }
}

constexpr int PIECE = 256;
__device__ __forceinline__ unsigned lane_xor1_u(unsigned v) { return (unsigned)__builtin_amdgcn_update_dpp(0, (int)v, 0xB1, 0xF, 0xF, false); }
__device__ __forceinline__ void convert_uv(Frame& F, const Args& A) {
    const int gw = F.vcu * NWAVES + F.wave, NGW = F.G * NWAVES, lane = F.lane;
    f32x4 vn[16];
    if (gw < 2 * NEXP) { const float* src = (gw < NEXP ? A.in[IN_U] + (size_t)gw * DM : A.in[IN_V] + (size_t)(gw - NEXP) * DM) + 4 * lane;
#pragma unroll
        for (int i = 0; i < 16; ++i) vn[i] = *(const f32x4*)(src + 256 * i); }
    for (int r = gw; r < 2 * NEXP; r += NGW) {
        const bool isu = r < NEXP; const int row = isu ? r : r - NEXP;
        f32x4 v[16]; float m = 0.f, ss = 0.f;
#pragma unroll
        for (int i = 0; i < 16; ++i) { const f32x4 x = vn[i]; v[i] = x;
            m = fmaxf(m, fmaxf(fmaxf(fabsf(x.x), fabsf(x.y)), fmaxf(fabsf(x.z), fabsf(x.w)))); ss += (x.x * x.x + x.y * x.y) + (x.z * x.z + x.w * x.w); }
        { const int rn = r + NGW;
          if (rn < 2 * NEXP) { const float* src = (rn < NEXP ? A.in[IN_U] + (size_t)rn * DM : A.in[IN_V] + (size_t)(rn - NEXP) * DM) + 4 * lane;
#pragma unroll
              for (int i = 0; i < 16; ++i) vn[i] = *(const f32x4*)(src + 256 * i); } }
        m = wave_max(m); ss = wave_sum(ss);
        const float rms = sqrtf(ss * (1.f / DM));
        const float step = isu ? fmaxf(fmaxf(0.49f * rms, m * (1.f / 12.f)), 1e-30f) : fmaxf(fmaxf(0.3352f * rms, m * (1.f / 15.f)), 1e-30f), inv = 1.f / step;
        unsigned char* tab = F.ws + (isu ? WS_UB : WS_VB);
        const bool odd = lane & 1;
#pragma unroll
        for (int i = 0; i < 16; ++i) {
            const float xs[4] = {v[i].x * inv, v[i].y * inv, v[i].z * inv, v[i].w * inv};
            unsigned w = 0;
            if (isu) {
#pragma unroll
                for (int k = 0; k < 4; ++k) { const float a = fabsf(xs[k]);
                    const unsigned c = (unsigned)(a > 0.25f) + (unsigned)(a > 0.75f) + (unsigned)(a > 1.25f) + (unsigned)(a > 1.75f) + (unsigned)(a > 2.5f) + (unsigned)(a > 3.5f) + (unsigned)(a > 5.f);
                    w |= (c | (xs[k] < 0.f ? 8u : 0u)) << (4 * k); }
                w = odd ? (w << 16) : w;
            } else {
#pragma unroll
                for (int k = 0; k < 4; ++k) { const unsigned n = (unsigned)min(max((int)floorf(xs[k]) + 8, 0), 15); w |= n << (8 * k); }
                w = odd ? ((w << 4) ^ 0x80808080u) : w;
            }
            w |= lane_xor1_u(w);
            if (!odd) *(unsigned*)(tab + ((size_t)(i >> 1) * NEXP + row) * PIECE + 128 * (i & 1) + 2 * lane) = w;
        }
        if (lane == 0) ((float*)(F.ws + (isu ? WS_SU : WS_SV)))[row] = step;
    }
}

__device__ __forceinline__ int lt_bit(float v, float mid) { return (int)(__float_as_uint(v - mid) >> 31); }
constexpr int CSTR = 17;
#define SKSWZ(row, colB) ((row) * 256 + ((colB) ^ (((row) & 7) << 4)))
__device__ __forceinline__ void topk_unit(Frame& F, const Args& A, int unit) {
    const int h = unit & 7, t0 = (unit >> 3) * 256 + F.wave * 32, lane = F.lane, j = lane & 31, hq = lane >> 5;
    const bf16_t* QP = (const bf16_t*)(F.ws + WS_QP); const bf16_t* SKB = (const bf16_t*)(F.ws + WS_SKB);
    LAS unsigned char* SKL = F.lds;
    LAS u32x2* CAND = (LAS u32x2*)(F.lds + 65536 + F.wave * (32 * 2 * CSTR * 8));
    __syncthreads();
    { const int row = F.tid >> 4, ch = F.tid & 15;
#pragma unroll
      for (int i = 0; i < 8; ++i) { const int rr = row + 32 * i;
          const u32x4 v = *(const u32x4*)(SKB + ((size_t)h * 256 + rr) * 128 + ch * 8);
          *(LAS u32x4*)(SKL + (rr >> 7) * 32768 + SKSWZ(rr & 127, ch * 16)) = v; } }
    __syncthreads();
    float rstd2;
    { const f32x4* sp = (const f32x4*)((const float*)(F.ws + WS_SSQ2) + (size_t)(t0 + j) * 64 + 32 * hq); float s = 0.f;
#pragma unroll
      for (int k = 0; k < 8; ++k) { const f32x4 v = sp[k]; s += (v.x + v.y) + (v.z + v.w); }
      s += __shfl_xor(s, 32);
      rstd2 = 1.f / sqrtf(s * (1.f / DM) + EPS);
      if (h == 0 && hq == 0) ((float*)(F.ws + WS_RSTD2))[t0 + j] = rstd2; }
#pragma nounroll
    for (int p = 0; p < 2; ++p) {
        f32x16 acc[4];
#pragma unroll
        for (int kt = 0; kt < 4; ++kt) acc[kt] = f32x16{};
        const bf16_t* qp = QP + (size_t)(t0 + j) * 2048 + h * 256 + p * 128 + 8 * hq;
        bf16x8 bq[8];
#pragma unroll
        for (int ks = 0; ks < 8; ++ks) bq[ks] = *(const bf16x8*)(qp + 16 * ks);
#pragma unroll
        for (int ks = 0; ks < 8; ++ks) {
#pragma unroll
            for (int kt = 0; kt < 4; ++kt) { const bf16x8 ak = *(const LAS bf16x8*)(SKL + p * 32768 + SKSWZ(32 * kt + j, (16 * ks + 8 * hq) * 2)); acc[kt] = __builtin_amdgcn_mfma_f32_32x32x16_bf16(ak, bq[ks], acc[kt], 0, 0, 0); } }
        float vmx = acc[0][0], vmn = acc[0][0];
#pragma unroll
        for (int kt = 0; kt < 4; ++kt)
#pragma unroll
            for (int r = 0; r < 16; ++r) { vmx = fmaxf(vmx, acc[kt][r]); vmn = fminf(vmn, acc[kt][r]); }
        vmx = fmaxf(vmx, __shfl_xor(vmx, 32)); vmn = fminf(vmn, __shfl_xor(vmn, 32));
        float lo = vmn, hi = vmx + 1.0f, T = vmn; int done = 0;
#pragma nounroll
        for (int iter = 0; iter < 64; ++iter) {
            if (!__any(done == 0)) break;
            const float mid = 0.5f * (lo + hi);
            int c4[4] = {0, 0, 0, 0};
#pragma unroll
            for (int kt = 0; kt < 4; ++kt)
#pragma unroll
                for (int r = 0; r < 16; ++r) c4[kt] += lt_bit(acc[kt][r], mid);
            int c = (c4[0] + c4[1]) + (c4[2] + c4[3]);
            c += __shfl_xor(c, 32); c = NKEYS - c;
            if (done == 0) {
                if (c == PTOPK) { T = mid; done = 1; }
                else if (mid <= lo || mid >= hi) { T = lo; done = 1; }
                else if (c > PTOPK) lo = mid; else hi = mid;
            }
        }
        if (done == 0) T = lo;
        int cm = 0;
#pragma unroll
        for (int kt = 0; kt < 4; ++kt)
#pragma unroll
            for (int r = 0; r < 16; ++r) cm += lt_bit(acc[kt][r], T);
        cm = 64 - cm;
        const int co = __shfl_xor(cm, 32);
        int slot = hq ? co : 0;
        f32x16 rowidx;
        { bf16x8 ac = {0, 0, 0, 0, 0, 0, 0, 0}, bc = {0, 0, 0, 0, 0, 0, 0, 0};
          if (hq == 0) { ac[0] = (short)f2bf((float)j); bc[0] = (short)0x3F80; }
          rowidx = __builtin_amdgcn_mfma_f32_32x32x16_bf16(ac, bc, f32x16{}, 0, 0, 0); }
        LAS u32x2* cb = CAND + (j * 2 + p) * CSTR;
#pragma unroll
        for (int kt = 0; kt < 4; ++kt)
#pragma unroll
            for (int r = 0; r < 16; ++r) { const float v = acc[kt][r];
                const int take = (1 - lt_bit(v, T)) & (int)((unsigned)(slot - PTOPK) >> 31);
                u32x2 w; w.x = __float_as_uint(v); w.y = (unsigned)(32 * kt + (int)rowidx[r]);
                cb[take ? slot : PTOPK] = w; slot += take; }
    }
    LDS_WAIT();
    float sv[16]; int si[16];
    { LAS u32x2* cb = CAND + (j * 2 + hq) * CSTR;
#pragma unroll
      for (int k = 0; k < 16; ++k) { const u32x2 w = cb[k]; sv[k] = __uint_as_float(w.x); si[k] = (int)w.y; } }
#pragma unroll
    for (int k = 2; k <= 16; k <<= 1)
#pragma unroll
        for (int jj = k >> 1; jj > 0; jj >>= 1)
#pragma unroll
            for (int i = 0; i < 16; ++i) { const int l = i ^ jj;
                if (l > i) { const bool desc = ((i & k) == 0); const bool sw = desc ? (sv[i] < sv[l]) : (sv[i] > sv[l]);
                    const float tv = sw ? sv[l] : sv[i], tw = sw ? sv[i] : sv[l]; const int ti = sw ? si[l] : si[i], tj = sw ? si[i] : si[l];
                    sv[i] = tv; sv[l] = tw; si[i] = ti; si[l] = tj; } }
    float s1[16], s2[16]; int i1[16], i2[16];
#pragma unroll
    for (int k = 0; k < 16; ++k) { const float ov = __shfl_xor(sv[k], 32); const int oi = __shfl_xor(si[k], 32);
        s1[k] = hq ? ov : sv[k]; s2[k] = hq ? sv[k] : ov; i1[k] = hq ? oi : si[k]; i2[k] = hq ? si[k] : oi; }
    float cs[50];
    { int q = 0;
#pragma unroll
      for (int a = 0; a < 16; ++a)
#pragma unroll
          for (int b2 = 0; b2 < 16; ++b2) if ((a + 1) * (b2 + 1) <= 16) { cs[q] = s1[a] + s2[b2]; ++q; } }
    float lo = fminf(s1[15] + s2[0], s1[0] + s2[15]), hi = s1[0] + s2[0] + 1.0f, T = lo; int done = 0;
#pragma nounroll
    for (int iter = 0; iter < 64; ++iter) {
        if (!__any(done == 0)) break;
        const float mid = 0.5f * (lo + hi);
        int c4[5] = {0, 0, 0, 0, 0};
#pragma unroll
        for (int q = 0; q < 50; ++q) c4[q % 5] += lt_bit(cs[q], mid);
        const int c = 50 - ((c4[0] + c4[1]) + (c4[2] + c4[3]) + c4[4]);
        if (done == 0) {
            if (c == PTOPK) { T = mid; done = 1; }
            else if (mid <= lo || mid >= hi) { T = lo; done = 1; }
            else if (c > PTOPK) lo = mid; else hi = mid;
        }
    }
    if (done == 0) T = lo;
    LAS u32x2* wb = CAND + (j * 2) * CSTR;
    if (hq == 0) { int slot = 0; int q = 0;
#pragma unroll
        for (int a = 0; a < 16; ++a)
#pragma unroll
            for (int b2 = 0; b2 < 16; ++b2) if ((a + 1) * (b2 + 1) <= 16) {
                const int take = (1 - lt_bit(cs[q], T)) & (int)((unsigned)(slot - PTOPK) >> 31);
                u32x2 w; w.x = __float_as_uint(cs[q]); w.y = (unsigned)(i1[a] * NKEYS + i2[b2]);
                wb[take ? slot : PTOPK] = w; slot += take; ++q; } }
    LDS_WAIT();
    float wv[16]; int wi[16]; float mx = -1e30f;
#pragma unroll
    for (int k = 0; k < 16; ++k) { const u32x2 w = wb[k]; wv[k] = __uint_as_float(w.x); wi[k] = (int)w.y; mx = fmaxf(mx, wv[k]); }
    float se = 0.f;
#pragma unroll
    for (int k = 0; k < 16; ++k) { wv[k] = __expf((wv[k] - mx) * rstd2); se += wv[k]; }
    const float inv = 1.f / se;
    int* IDX = (int*)(F.ws + WS_IDX) + (size_t)(t0 + j) * PE + h * PTOPK + 8 * hq; float* GT = (float*)(F.ws + WS_GATE) + (size_t)(t0 + j) * PE + h * PTOPK + 8 * hq;
    float* SUT = (float*)(F.ws + WS_SUT) + (size_t)(t0 + j) * PE + h * PTOPK + 8 * hq; float* GS = (float*)(F.ws + WS_GS) + (size_t)(t0 + j) * PE + h * PTOPK + 8 * hq;
#pragma unroll
    for (int k = 0; k < 8; ++k) { const int id = hq ? wi[8 + k] : wi[k]; const float gte = (hq ? wv[8 + k] : wv[k]) * inv;
        IDX[k] = id; GT[k] = gte; SUT[k] = ((const float*)(F.ws + WS_SU))[id]; GS[k] = gte * ((const float*)(F.ws + WS_SV))[id]; }
    LDS_WAIT();
}

__device__ __forceinline__ int row_sum16(int v) {
    v += __builtin_amdgcn_update_dpp(0, v, 0xB1, 0xF, 0xF, false);
    v += __builtin_amdgcn_update_dpp(0, v, 0x4E, 0xF, 0xF, false);
    v += __builtin_amdgcn_update_dpp(0, v, 0x141, 0xF, 0xF, false);
    v += __builtin_amdgcn_update_dpp(0, v, 0x128, 0xF, 0xF, false);
    return v;
}
typedef int i32x8 __attribute__((ext_vector_type(8)));
struct PeerUMeta { u32x4 hv; int id0, id1; float rstd2; };
__device__ __forceinline__ void peer_u_meta(Frame& F, int t, int x, PeerUMeta& M) {
    const int lane = F.lane;
    const bf16_t* H1B = (const bf16_t*)(F.ws + WS_XN);
    M.hv = *(const u32x4*)(H1B + (size_t)t * DM + 512 * x + 8 * lane);
    const int* IDX = (const int*)(F.ws + WS_IDX) + (size_t)t * PE;
    M.id0 = IDX[lane]; M.id1 = IDX[64 + lane]; M.rstd2 = ((const float*)(F.ws + WS_RSTD2))[t];
}
__device__ __forceinline__ int wave_sum_i(int v) { v = row_sum16(v); v += __shfl_xor(v, 16); v += __shfl_xor(v, 32); return v; }
__device__ __forceinline__ int row_max16i(int v) {
    v = max(v, __builtin_amdgcn_update_dpp(0, v, 0xB1, 0xF, 0xF, false)); v = max(v, __builtin_amdgcn_update_dpp(0, v, 0x4E, 0xF, 0xF, false));
    v = max(v, __builtin_amdgcn_update_dpp(0, v, 0x141, 0xF, 0xF, false)); v = max(v, __builtin_amdgcn_update_dpp(0, v, 0x128, 0xF, 0xF, false));
    return v;
}
__device__ __forceinline__ float quad_swap1(float v) { return __builtin_bit_cast(float, __builtin_amdgcn_update_dpp(0, __builtin_bit_cast(int, v), 0xB1, 0xF, 0xF, false)); }
#ifndef PROBE_MODE
#define PROBE_MODE 0
#endif
__device__ __forceinline__ float quad_swap2(float v) { return __builtin_bit_cast(float, __builtin_amdgcn_update_dpp(0, __builtin_bit_cast(int, v), 0x4E, 0xF, 0xF, false)); }
__device__ __forceinline__ float row_ror4(float v) { return __builtin_bit_cast(float, __builtin_amdgcn_update_dpp(0, __builtin_bit_cast(int, v), 0x124, 0xF, 0xF, false)); }
__device__ __forceinline__ void peer_u_issue(const unsigned char* UBs, int idv, int lane, u32x4 (&w)[16]) {
    const int ei = lane & 15, gk = lane >> 4, r4 = ei >> 2, quarter = ei & 3;
#pragma unroll
    for (int b = 0; b < 16; ++b) { const int row = __builtin_amdgcn_ds_bpermute((16 * r4 + b) * 4, idv);
        w[b] = *(const u32x4*)(UBs + (((unsigned)row << 8) + 64u * (unsigned)gk + 16u * (unsigned)quarter)); }
}
__device__ __forceinline__ float sel4(float a, float b, float c, float d, unsigned m0, unsigned m1, unsigned m2, unsigned m3) {
    return __builtin_bit_cast(float, (__builtin_bit_cast(unsigned, a) & m0) | (__builtin_bit_cast(unsigned, b) & m1) | (__builtin_bit_cast(unsigned, c) & m2) | (__builtin_bit_cast(unsigned, d) & m3)); }
__device__ __forceinline__ void peer_u_consume(const u32x4 (&w)[16], const i32x8& B, int lane, unsigned m0, unsigned m1, unsigned m2, unsigned m3, float& keep) {
    const int ei = lane & 15; const bool q1 = (lane >> 1) & 1, q2 = (lane >> 2) & 1;
#pragma unroll
    for (int b0 = 0; b0 < 16; b0 += 4) {
        f32x4 D[4];
#pragma unroll
        for (int k = 0; k < 4; ++k) { const f32x4 z = {0.f, 0.f, 0.f, 0.f};
            const i32x8 a = {(int)w[b0 + k].x, (int)w[b0 + k].y, (int)w[b0 + k].z, (int)w[b0 + k].w, 0, 0, 0, 0};
            D[k] = __builtin_amdgcn_mfma_scale_f32_16x16x128_f8f6f4(a, B, z, 4, 0, 0, 0x7f7f7f7f, 0, 0x7f7f7f7f); }
        __builtin_amdgcn_sched_barrier(0);
        float v[4];
#pragma unroll
        for (int k = 0; k < 4; ++k) { const float lo = q1 ? D[k].y : D[k].x, hi = q1 ? D[k].w : D[k].z; v[k] = q2 ? hi : lo; }
#pragma unroll
        for (int k = 0; k < 4; ++k) v[k] += quad_swap1(v[k]);
#pragma unroll
        for (int k = 0; k < 4; ++k) v[k] += quad_swap2(v[k]);
#pragma unroll
        for (int k = 0; k < 4; ++k) v[k] += row_ror4(v[k]);
#pragma unroll
        for (int k = 0; k < 4; ++k) keep = (ei == b0 + k) ? v[k] : keep;
    }
}
__device__ __forceinline__ float peer_u_xquant(Frame& F, const PeerUMeta& M, const float (&g2s)[8], i32x8& B) {
    const int lane = F.lane, ei = lane & 15, g = lane >> 4, qn = (ei >> 1) & 3;
    LAS unsigned char* XB = F.lds + F.wave * 1024;
    float xf[8];
    { const float rs = M.rstd2; const u32x4 hv = M.hv;
      xf[0] = bflo(hv.x) * rs * g2s[0]; xf[1] = bfhi(hv.x) * rs * g2s[1]; xf[2] = bflo(hv.y) * rs * g2s[2]; xf[3] = bfhi(hv.y) * rs * g2s[3];
      xf[4] = bflo(hv.z) * rs * g2s[4]; xf[5] = bfhi(hv.z) * rs * g2s[5]; xf[6] = bflo(hv.w) * rs * g2s[6]; xf[7] = bfhi(hv.w) * rs * g2s[7]; }
    float m = 0.f;
#pragma unroll
    for (int i = 0; i < 8; ++i) m = fmaxf(m, fabsf(xf[i]));
    int mi = row_max16i(__builtin_bit_cast(int, m)); mi = max(mi, __shfl_xor(mi, 16)); mi = max(mi, __shfl_xor(mi, 32));
    m = fmaxf(__builtin_bit_cast(float, mi), 1e-30f); const float sx = m * (1.f / 224.f), inv = 224.f * __builtin_amdgcn_rcpf(m);
    { u32x2 hi, lo;
#pragma unroll
      for (int d = 0; d < 2; ++d) { const float a0 = xf[4 * d] * inv, a1 = xf[4 * d + 1] * inv, a2 = xf[4 * d + 2] * inv, a3 = xf[4 * d + 3] * inv;
          int h = __builtin_amdgcn_cvt_pk_fp8_f32(a0, a1, 0, false); h = __builtin_amdgcn_cvt_pk_fp8_f32(a2, a3, h, true);
          const f32x2 b01 = __builtin_amdgcn_cvt_pk_f32_fp8(h, false), b23 = __builtin_amdgcn_cvt_pk_f32_fp8(h, true);
          int l = __builtin_amdgcn_cvt_pk_fp8_f32(a0 - b01.x, a1 - b01.y, 0, false); l = __builtin_amdgcn_cvt_pk_fp8_f32(a2 - b23.x, a3 - b23.y, l, true);
          hi[d] = (unsigned)h; lo[d] = (unsigned)l; }
      *(LAS u32x2*)(XB + 8 * lane) = hi; *(LAS u32x2*)(XB + 512 + 8 * lane) = lo; }
    LDS_WAIT();
    { LAS const unsigned char* p = XB + ((ei & 1) ? 512 : 0) + 128 * (g >> 1) + 32 * qn + 16 * (g & 1);
      const u32x4 b0 = *(LAS const u32x4*)p, b1 = *(LAS const u32x4*)(p + 256);
      B = i32x8{(int)b0.x, (int)b0.y, (int)b0.z, (int)b0.w, (int)b1.x, (int)b1.y, (int)b1.z, (int)b1.w}; }
    LDS_WAIT();
    return sx;
}
__device__ __forceinline__ void peer_u_meta_async(Frame& F, int t, int x, PeerUMeta& M) {
    const int lane = F.lane;
    const bf16_t* hp = (const bf16_t*)(F.ws + WS_XN) + (size_t)t * DM + 512 * x + 8 * lane;
    const int* ip = (const int*)(F.ws + WS_IDX) + (size_t)t * PE + lane; const float* rp = (const float*)(F.ws + WS_RSTD2) + t;
    asm volatile("global_load_dwordx4 %0, %1, off" : "=v"(M.hv) : "v"(hp) : "memory");
    asm volatile("global_load_dword %0, %1, off" : "=v"(M.id0) : "v"(ip) : "memory");
    asm volatile("global_load_dword %0, %1, off offset:256" : "=v"(M.id1) : "v"(ip) : "memory");
    asm volatile("global_load_dword %0, %1, off" : "=v"(M.rstd2) : "v"(rp) : "memory");
}
template <bool DRY> __device__ __forceinline__ void peer_u_loop(Frame& F, int x, int tb, int tstep, const float (&g2s)[8]) {
    const int lane = F.lane;
    const unsigned char* UBs = F.ws + WS_UB + (size_t)x * NEXP * PIECE;
    PeerUMeta M, Mn, Mn2;
    peer_u_meta(F, tb, x, M); peer_u_meta(F, tb + tstep, x, Mn); Mn2 = Mn;
    u32x4 wA[16], wB[16];
    peer_u_issue(UBs, M.id0, lane, wA);
    unsigned m0, m1, m2, m3; { const int qn = (lane >> 1) & 3; m0 = qn == 0 ? ~0u : 0u; m1 = qn == 1 ? ~0u : 0u; m2 = qn == 2 ? ~0u : 0u; m3 = qn == 3 ? ~0u : 0u; asm volatile("" : "+v"(m0), "+v"(m1), "+v"(m2), "+v"(m3)); }
    i32x8 B, Bn; float sx = peer_u_xquant(F, M, g2s, B), sxn = sx; Bn = B;
#pragma nounroll
    for (int t = tb; t < MR; t += tstep) {
        if (t + 2 * tstep < MR) peer_u_meta_async(F, t + 2 * tstep, x, Mn2);
        float keep0 = 0.f, keep1 = 0.f;
        peer_u_issue(UBs, M.id1, lane, wB);
        __builtin_amdgcn_sched_barrier(0);
        peer_u_consume(wA, B, lane, m0, m1, m2, m3, keep0);
        __builtin_amdgcn_sched_barrier(0);
        if (t + tstep < MR) { peer_u_issue(UBs, Mn.id0, lane, wA); __builtin_amdgcn_sched_barrier(0); sxn = peer_u_xquant(F, Mn, g2s, Bn); }
        __builtin_amdgcn_sched_barrier(0);
        peer_u_consume(wB, B, lane, m0, m1, m2, m3, keep1);
        __builtin_amdgcn_sched_barrier(0);
        if constexpr (!DRY) { float* pa = (float*)(F.ws + WS_PACT) + ((size_t)t * 8 + x) * PE;
            pa[lane] = keep0 * sx; pa[64 + lane] = keep1 * sx; }
        else asm volatile("" :: "v"(keep0), "v"(keep1));
        asm volatile("" : "+v"(Mn2.hv), "+v"(Mn2.id0), "+v"(Mn2.id1), "+v"(Mn2.rstd2));
        M = Mn; Mn = Mn2; B = Bn; sx = sxn;
    }
}
typedef int i32x4 __attribute__((ext_vector_type(4)));
struct PeerVRest { unsigned wdw; float sw; int qw; u32x4 hv; };
struct PeerVIds { int id0, id1; };
__device__ __forceinline__ void peer_v_ids(Frame& F, int t, PeerVIds& I) { const int* IDX = (const int*)(F.ws + WS_IDX) + (size_t)t * PE; I.id0 = IDX[F.lane]; I.id1 = IDX[64 + F.lane]; }
__device__ __forceinline__ void peer_v_rest(Frame& F, int t, int x, PeerVRest& R) {
    const int lane = F.lane, r = lane >> 4, sp = lane & 15;
    R.wdw = ((const unsigned*)(F.ws + WS_WQ))[(size_t)t * 32 + (lane & 31)];
    const u32x2 sq = ((const u32x2*)(F.ws + WS_SWQ))[t]; R.sw = __builtin_bit_cast(float, sq.x); R.qw = (int)sq.y;
    R.hv = *(const u32x4*)((const bf16_t*)(F.ws + WS_XN) + (size_t)t * DM + 512 * x + 32 * sp + 8 * r);
}
__device__ __forceinline__ void peer_v_ids_async(Frame& F, int t, PeerVIds& I) {
    const int* ip = (const int*)(F.ws + WS_IDX) + (size_t)t * PE + F.lane;
    asm volatile("global_load_dword %0, %1, off" : "=v"(I.id0) : "v"(ip) : "memory");
    asm volatile("global_load_dword %0, %1, off offset:256" : "=v"(I.id1) : "v"(ip) : "memory");
}
__device__ __forceinline__ void peer_v_rest_async(Frame& F, int t, int x, PeerVRest& R) {
    const int lane = F.lane, r = lane >> 4, sp = lane & 15;
    const unsigned* wp = (const unsigned*)(F.ws + WS_WQ) + (size_t)t * 32 + (lane & 31);
    const unsigned* qp = (const unsigned*)(F.ws + WS_SWQ) + (size_t)t * 2;
    const bf16_t* hp = (const bf16_t*)(F.ws + WS_XN) + (size_t)t * DM + 512 * x + 32 * sp + 8 * r;
    asm volatile("global_load_dword %0, %1, off" : "=v"(R.wdw) : "v"(wp) : "memory");
    asm volatile("global_load_dword %0, %1, off" : "=v"(R.sw) : "v"(qp) : "memory");
    asm volatile("global_load_dword %0, %1, off offset:4" : "=v"(R.qw) : "v"(qp) : "memory");
    asm volatile("global_load_dwordx4 %0, %1, off" : "=v"(R.hv) : "v"(hp) : "memory");
}
__device__ __forceinline__ void peer_v_pin(PeerVRest& R) { asm volatile("" : "+v"(R.wdw), "+v"(R.sw), "+v"(R.qw), "+v"(R.hv)); }
__device__ __forceinline__ void peer_v_prologue(Frame& F, const PeerVRest& R, float& sw, int& qw) {
    LAS unsigned* QW8 = (LAS unsigned*)(F.lds + F.wave * 256);
    if (F.lane < 32) QW8[F.lane] = R.wdw;
    sw = R.sw; qw = R.qw;
    LDS_WAIT();
}
__device__ __forceinline__ void peer_w_pass(Frame& F) {
    const int gw = F.vcu * NWAVES + F.wave, NGW = F.G * NWAVES, lane = F.lane;
    for (int t = gw; t < MR; t += NGW) {
        const float* SUT = (const float*)(F.ws + WS_SUT) + (size_t)t * PE; const float* GS = (const float*)(F.ws + WS_GS) + (size_t)t * PE;
        const float su0 = SUT[lane], su1 = SUT[64 + lane], gs0 = GS[lane], gs1 = GS[64 + lane];
        const float* pa = (const float*)(F.ws + WS_PACT) + (size_t)t * 8 * PE;
        float a0 = 0.f, a1 = 0.f;
#pragma unroll
        for (int xx = 0; xx < 8; ++xx) { a0 += pa[xx * PE + lane]; a1 += pa[xx * PE + 64 + lane]; }
        const float w0 = gs0 * gelu_tanh(a0 * su0), w1 = gs1 * gelu_tanh(a1 * su1);
        int wmi = row_max16i(__builtin_bit_cast(int, fmaxf(fabsf(w0), fabsf(w1)))); wmi = max(wmi, __shfl_xor(wmi, 16)); wmi = max(wmi, __shfl_xor(wmi, 32));
        const float wm = fmaxf(__builtin_bit_cast(float, wmi), 1e-30f); const float sw = wm * (1.f / 127.f), winv = 127.f * __builtin_amdgcn_rcpf(wm);
        const int q0 = max(min((int)__builtin_rintf(w0 * winv), 127), -127), q1 = max(min((int)__builtin_rintf(w1 * winv), 127), -127);
        const int qw = wave_sum_i(q0 + q1);
        unsigned char* WQ = F.ws + WS_WQ + (size_t)t * 128;
        WQ[((lane >> 4) * 4 + (lane & 3)) * 4 + ((lane >> 2) & 3)] = (unsigned char)(q0 & 0xff);
        WQ[(((64 + lane) >> 4) * 4 + (lane & 3)) * 4 + ((lane >> 2) & 3)] = (unsigned char)(q1 & 0xff);
        if (lane == 0) { u32x2 sq; sq.x = __builtin_bit_cast(unsigned, sw); sq.y = (unsigned)qw; ((u32x2*)(F.ws + WS_SWQ))[t] = sq; }
    }
}
template <bool DRY> __device__ __forceinline__ void peer_v_issue4(const unsigned char* VBs, int idv, int lane, int gg, u32x4 (&w)[16]) {
    const int r = lane >> 4, sp = lane & 15;
#pragma unroll
    for (int k = 0; k < 4; ++k) { const int q = 4 * gg + k; const int row = __builtin_amdgcn_ds_bpermute((4 * q + r) * 4, idv);
#if PROBE_MODE == 1
        if constexpr (DRY) { const unsigned ur = (unsigned)row + r; w[q] = u32x4{ur, ur * 3u, ur * 5u, ur * 7u}; } else
#endif
        w[q] = *(const u32x4*)(VBs + (((unsigned)row << 8) + 16u * (unsigned)sp)); }
}
template <bool DRY> __device__ __forceinline__ void peer_v_round(Frame& F, const unsigned char* VBs, u32x4 (&w)[16], int h, int idv_next, int lane, const unsigned (&sel)[4], i32x4 (&Dl)[4], i32x4 (&Dh)[4]) {
    const int r = lane >> 4;
    LAS const unsigned char* QW8 = F.lds + F.wave * 256;
#pragma unroll
    for (int gg = 0; gg < 4; ++gg) {
        i32x4 blo[4], bhi[4];
#pragma unroll
        for (int j = 0; j < 4; ++j) {
            blo[j] = i32x4{(int)(w[4 * gg][j] & 0x0F0F0F0Fu), (int)(w[4 * gg + 1][j] & 0x0F0F0F0Fu), (int)(w[4 * gg + 2][j] & 0x0F0F0F0Fu), (int)(w[4 * gg + 3][j] & 0x0F0F0F0Fu)};
            bhi[j] = i32x4{(int)(w[4 * gg][j] & 0xF0F0F0F0u), (int)(w[4 * gg + 1][j] & 0xF0F0F0F0u), (int)(w[4 * gg + 2][j] & 0xF0F0F0F0u), (int)(w[4 * gg + 3][j] & 0xF0F0F0F0u)}; }
        __builtin_amdgcn_sched_barrier(0);
        peer_v_issue4<DRY>(VBs, idv_next, lane, gg, w);
        __builtin_amdgcn_sched_barrier(0);
#if PROBE_MODE == 2
        if constexpr (DRY) { _Pragma("unroll") for (int j = 0; j < 4; ++j) { Dl[j].x ^= blo[j].x ^ blo[j].y ^ blo[j].z ^ blo[j].w; Dh[j].x ^= bhi[j].x ^ bhi[j].y ^ bhi[j].z ^ bhi[j].w; } continue; }
#endif
        const unsigned wpk = *(const LAS unsigned*)(QW8 + ((4 * h + gg) * 4 + r) * 4);
        const i32x4 a = {(int)__builtin_amdgcn_perm(wpk, wpk, sel[0]), (int)__builtin_amdgcn_perm(wpk, wpk, sel[1]), (int)__builtin_amdgcn_perm(wpk, wpk, sel[2]), (int)__builtin_amdgcn_perm(wpk, wpk, sel[3])};
#pragma unroll
        for (int j = 0; j < 4; ++j) { Dl[j] = __builtin_amdgcn_mfma_i32_16x16x64_i8(a, blo[j], Dl[j], 0, 0, 0); Dh[j] = __builtin_amdgcn_mfma_i32_16x16x64_i8(a, bhi[j], Dh[j], 0, 0, 0); }
        __builtin_amdgcn_sched_barrier(0);
    }
}
__device__ __forceinline__ int sel4i(int a, int b, int c, int d, unsigned m0, unsigned m1, unsigned m2, unsigned m3) { return (int)(((unsigned)a & m0) | ((unsigned)b & m1) | ((unsigned)c & m2) | ((unsigned)d & m3)); }
template <bool DRY> __device__ __forceinline__ void peer_v_loop(Frame& F, int x, int tb, int tstep) {
    const int lane = F.lane, r = lane >> 4, sp = lane & 15;
    const unsigned char* VBs = F.ws + WS_VB + (size_t)x * NEXP * PIECE;
    unsigned sel[4];
#pragma unroll
    for (int e = 0; e < 4; ++e) sel[e] = (0x0C0C0C0Cu & ~(0xFFu << (8 * (lane & 3)))) | ((unsigned)e << (8 * (lane & 3)));
    unsigned m0 = r == 0 ? ~0u : 0u, m1 = r == 1 ? ~0u : 0u, m2 = r == 2 ? ~0u : 0u, m3 = r == 3 ? ~0u : 0u;
    asm volatile("" : "+v"(m0), "+v"(m1), "+v"(m2), "+v"(m3));
    PeerVIds I, In, I2; PeerVRest R, Rn;
    peer_v_ids(F, tb, I); peer_v_ids(F, tb + tstep, In); I2 = In;
    peer_v_rest(F, tb, x, R); Rn = R;
    u32x4 w[16];
#pragma unroll
    for (int gg = 0; gg < 4; ++gg) peer_v_issue4<DRY>(VBs, I.id0, lane, gg, w);
    float sw; int qw; u32x4 hv = R.hv;
    peer_v_prologue(F, R, sw, qw);
#pragma nounroll
    for (int t = tb; t < MR; t += tstep) {
        const bool more = t + tstep < MR;
        if (more) peer_v_rest_async(F, t + tstep, x, Rn);
        if (t + 2 * tstep < MR) peer_v_ids_async(F, t + 2 * tstep, I2);
        i32x4 Dl[4], Dh[4];
#pragma unroll
        for (int j = 0; j < 4; ++j) { Dl[j] = i32x4{0, 0, 0, 0}; Dh[j] = i32x4{0, 0, 0, 0}; }
        peer_v_round<DRY>(F, VBs, w, 0, I.id1, lane, sel, Dl, Dh);
        peer_v_round<DRY>(F, VBs, w, 1, In.id0, lane, sel, Dl, Dh);
        if constexpr (!DRY) {
            int a8[8];
            a8[0] = sel4i(Dl[0].x, Dl[1].x, Dl[2].x, Dl[3].x, m0, m1, m2, m3); a8[1] = sel4i(Dl[0].y, Dl[1].y, Dl[2].y, Dl[3].y, m0, m1, m2, m3);
            a8[2] = sel4i(Dl[0].z, Dl[1].z, Dl[2].z, Dl[3].z, m0, m1, m2, m3); a8[3] = sel4i(Dl[0].w, Dl[1].w, Dl[2].w, Dl[3].w, m0, m1, m2, m3);
            a8[4] = sel4i(Dh[0].x, Dh[1].x, Dh[2].x, Dh[3].x, m0, m1, m2, m3); a8[5] = sel4i(Dh[0].y, Dh[1].y, Dh[2].y, Dh[3].y, m0, m1, m2, m3);
            a8[6] = sel4i(Dh[0].z, Dh[1].z, Dh[2].z, Dh[3].z, m0, m1, m2, m3); a8[7] = sel4i(Dh[0].w, Dh[1].w, Dh[2].w, Dh[3].w, m0, m1, m2, m3);
            const float c75 = 7.5f * (float)qw, c05 = 0.5f * (float)qw;
            f32x4 o0, o1;
            o0.x = bflo(hv.x) + sw * ((float)a8[0] - c75); o0.y = bfhi(hv.x) + sw * ((float)a8[1] - c75); o0.z = bflo(hv.y) + sw * ((float)a8[2] - c75); o0.w = bfhi(hv.y) + sw * ((float)a8[3] - c75);
            o1.x = bflo(hv.z) + sw * ((float)(a8[4] >> 4) + c05); o1.y = bfhi(hv.z) + sw * ((float)(a8[5] >> 4) + c05); o1.z = bflo(hv.w) + sw * ((float)(a8[6] >> 4) + c05); o1.w = bfhi(hv.w) + sw * ((float)(a8[7] >> 4) + c05);
            float* op = F.out + (size_t)t * DM + 512 * x + 32 * sp + 8 * r;
            __builtin_nontemporal_store(o0, (f32x4*)op); __builtin_nontemporal_store(o1, (f32x4*)(op + 4));
        } else { _Pragma("unroll") for (int j = 0; j < 4; ++j) asm volatile("" :: "v"(Dl[j]), "v"(Dh[j])); }
        if (more) { peer_v_pin(Rn); hv = Rn.hv; peer_v_prologue(F, Rn, sw, qw); }
        asm volatile("" : "+v"(I2.id0), "+v"(I2.id1));
        I = In; In = I2;
    }
}

template <int ONLY> __global__ void __launch_bounds__(NWAVES * 64, 2) mega(Args args) {
    extern __shared__ __attribute__((aligned(16))) unsigned char lds[];
    Frame F;
    F.lds = (LAS unsigned char*)lds; F.ldsg = (char*)lds;
    F.tid = threadIdx.x; F.lane = F.tid & 63; F.wave = __builtin_amdgcn_readfirstlane(F.tid >> 6);
    F.G = gridDim.x; { const int bx = blockIdx.x; F.vcu = (F.G % 8 == 0) ? (bx % 8) * (F.G / 8) + bx / 8 : bx; }
    F.out = args.out; F.ws = args.ws;
    const int lo = args.ph_lo, hi = args.ph_hi;
#define IN(k) ((ONLY < 0 || ONLY == (k)) && lo <= (k) && (k) < hi)
    XcdBarrier bar; bar.bar = nullptr; bar.x = 0; bar.st = nullptr;
    if constexpr (ONLY < 0) {
        volatile LAS unsigned* MISC = (volatile LAS unsigned*)(F.lds + LDS_MISC);
        if (F.tid < 64) MISC[F.tid] = 0u;
        __syncthreads();
        bar = xcd_barrier_post((unsigned*)(F.ws + WS_CTL) + 4096, MISC + 8);
    }
#ifndef PROBE_REPEAT
#define PROBE_REPEAT 0
#endif
#define NREP(k) (((PROBE_REPEAT >> (k)) & 1) ? 2 : 1)
#define SEAM(k) do { if constexpr (ONLY < 0) { if (IN(k) && IN((k) + 1)) xcd_barrier(bar); } } while (0)

    if (IN(0)) { for (int rep = 0; rep < NREP(0); ++rep) { p0_prologue(F, args); if (rep + 1 < NREP(0)) xcd_barrier(bar); } }
    SEAM(0);
    if (IN(1)) for (int rep = 0; rep < NREP(1); ++rep) {
        if (rep) xcd_barrier(bar);
        p1_meta_gemm(F, args);
        pg8::Gemm g{(const bf16_t*)(F.ws + WS_XN), (const bf16_t*)(F.ws + WS_WT1), MR, INC, DM}; pg8::StaticOrder S; S.init(MR, INC, F.G, (int)blockIdx.x);
        pg8::EpiBf16 E{(bf16_t*)(F.ws + WS_Z), INC};
        pg8::gemm_phase<pg8::EpiBf16>(F.lds, g, S, E);
    }
    SEAM(1);
    if (IN(2)) {
        for (int rep = 0; rep < NREP(2); ++rep) { if (rep) xcd_barrier(bar); for (int u = F.vcu; u < 256; u += F.G) { if (u & 1) scan_unit<1>(F, args, u); else scan_unit<0>(F, args, u); } }
        normrope_rows(F, args);
    }
    SEAM(2);
    if (IN(3)) for (int rep = 0; rep < NREP(3); ++rep) {
        if (rep) xcd_barrier(bar);
        const bf16_t* Z = (const bf16_t*)(F.ws + WS_Z); const bf16_t* KP = (const bf16_t*)(F.ws + WS_KP); const bf16_t* VP = (const bf16_t*)(F.ws + WS_VP); bf16_t* MRG = (bf16_t*)(F.ws + WS_MRG);
        for (int u = F.vcu; u < NB * NQ * (SEQ / 256); u += F.G) {
            const int grp = u >> 6, within = u & 63, b = grp >> 2, kvh = grp & 3, hq = within >> 4, qb = within & 15, h = kvh * 4 + hq;
            att::attn_unit(Z + (size_t)(b * SEQ + qb * 256) * INC + h * HD, KP + (size_t)(b * NKV + kvh) * KPAD * HD, VP + (size_t)(b * NKV + kvh) * KPAD * HD,
                           MRG + (size_t)(b * SEQ + qb * 256) * DM + h * HD, F.ldsg, qb * 256, args.in[IN_QG], (const f32x2*)(F.ws + WS_ROPE));
        }
    }
    SEAM(3);
    if (IN(4)) { combine_rows(F, args); }
    SEAM(4);
    if (IN(5)) for (int rep = 0; rep < NREP(5); ++rep) {
        if (rep) xcd_barrier(bar);
        pg8::Gemm g{(const bf16_t*)(F.ws + WS_MRG), (const bf16_t*)(F.ws + WS_WT2), MR, DM, DM}; pg8::StaticOrder S; S.init(MR, DM, F.G, (int)blockIdx.x);
        pg8::EpiResid E{args.in[IN_X], F.out, (bf16_t*)(F.ws + WS_XN), (float*)(F.ws + WS_SSQ2), DM};
        pg8::gemm_phase<pg8::EpiResid>(F.lds, g, S, E);
    }
    SEAM(5);
    if (IN(6)) for (int rep = 0; rep < NREP(6); ++rep) {
        if (rep) xcd_barrier(bar);
        convert_uv(F, args);
        pg8::Gemm g{(const bf16_t*)(F.ws + WS_XN), (const bf16_t*)(F.ws + WS_WT3), MR, 2048, DM}; pg8::StaticOrder S; S.init(MR, 2048, F.G, (int)blockIdx.x);
        pg8::EpiBf16 E{(bf16_t*)(F.ws + WS_QP), 2048};
        pg8::gemm_phase<pg8::EpiBf16>(F.lds, g, S, E);
    }
    SEAM(6);
    if (IN(7)) { for (int rep = 0; rep < NREP(7); ++rep) { if (rep) xcd_barrier(bar); for (int u = F.vcu; u < MR / 32; u += F.G) topk_unit(F, args, u); } }
    SEAM(7);
    if (IN(8)) {
        const int x = (int)blockIdx.x & 7, y = (int)blockIdx.x >> 3, ny = F.G >> 3;
        float g2s[8];
#pragma unroll
        for (int i = 0; i < 8; ++i) g2s[i] = args.in[IN_G2][512 * x + 8 * F.lane + i];
        const int tstep = ny * NWAVES;
        if (NREP(8) == 2) { peer_u_loop<true>(F, x, y * NWAVES + F.wave, tstep, g2s); xcd_barrier(bar); }
        peer_u_loop<false>(F, x, y * NWAVES + F.wave, tstep, g2s);
    }
    SEAM(8);
    if (IN(9)) { for (int rep = 0; rep < NREP(9); ++rep) { if (rep) xcd_barrier(bar); peer_w_pass(F); } }
    SEAM(9);
    if (IN(10)) {
        const int x = (int)blockIdx.x & 7, y = (int)blockIdx.x >> 3, ny = F.G >> 3; const int tstep = ny * NWAVES;
        if (NREP(10) == 2) { peer_v_loop<true>(F, x, y * NWAVES + F.wave, tstep); xcd_barrier(bar); }
        peer_v_loop<false>(F, x, y * NWAVES + F.wave, tstep);
    }
#undef IN
#undef SEAM
}

template <int P> static void launch_phase(int grid, hipStream_t stream, Args a) {
    static bool attr = false;
    if (!attr) { if (hipFuncSetAttribute((const void*)mega<P>, hipFuncAttributeMaxDynamicSharedMemorySize, LDS_BYTES) != hipSuccess) fprintf(stderr, "hipFuncSetAttribute failed (phase %d)\n", P); attr = true; }
    a.ph_lo = P; a.ph_hi = P + 1;
    hipLaunchKernelGGL(mega<P>, dim3(grid), dim3(NWAVES * 64), LDS_BYTES, stream, a);
}
extern "C" void kernel_launch(void* const* d_in, const int* in_sizes, int n_in, void* d_out, int out_size, void* d_ws, size_t ws_size, hipStream_t stream) {
    static int grid = 0;
    if (grid == 0) {
        if (n_in != 21 || out_size != MR * DM || ws_size < WS_END) { fprintf(stderr, "kernel_launch: unexpected shapes n_in %d out %d ws %zu\n", n_in, out_size, ws_size); grid = -1; return; }
        int dev = 0, cus = 0;
        (void)hipGetDevice(&dev); (void)hipDeviceGetAttribute(&cus, hipDeviceAttributeMultiprocessorCount, dev);
        grid = (cus / 8) * 8;
        if (grid < 8) { fprintf(stderr, "kernel_launch: device with %d CUs not supported\n", cus); grid = -1; return; }
#if N_LAUNCH_MODE == 1
        int per_cu = 0;
        if (hipFuncSetAttribute((const void*)mega<-1>, hipFuncAttributeMaxDynamicSharedMemorySize, LDS_BYTES) != hipSuccess) { fprintf(stderr, "kernel_launch: hipFuncSetAttribute failed\n"); grid = -1; return; }
        if (hipOccupancyMaxActiveBlocksPerMultiprocessor(&per_cu, (const void*)mega<-1>, NWAVES * 64, LDS_BYTES) != hipSuccess || per_cu < 1) { fprintf(stderr, "kernel_launch: occupancy query %d\n", per_cu); grid = -1; return; }
        (void)hipGetLastError();
#endif
    }
    if (grid < 0) return;
    Args a{};
    for (int i = 0; i < 21; ++i) a.in[i] = (const float*)d_in[i];
    a.out = (float*)d_out; a.ws = (unsigned char*)d_ws;
#if N_LAUNCH_MODE == 0
    launch_phase<0>(grid, stream, a); launch_phase<1>(grid, stream, a); launch_phase<2>(grid, stream, a); launch_phase<3>(grid, stream, a); launch_phase<4>(grid, stream, a);
    launch_phase<5>(grid, stream, a); launch_phase<6>(grid, stream, a); launch_phase<7>(grid, stream, a); launch_phase<8>(grid, stream, a); launch_phase<9>(grid, stream, a); launch_phase<10>(grid, stream, a);
#else
    if (hipMemsetAsync((char*)d_ws + WS_CTL, 0, 65536, stream) != hipSuccess) { fprintf(stderr, "kernel_launch: memset failed\n"); return; }
    a.ph_lo = 0; a.ph_hi = NPHASE;
    void* kargs[] = {&a};
    hipError_t e = hipLaunchCooperativeKernel((const void*)mega<-1>, dim3(grid), dim3(NWAVES * 64), kargs, LDS_BYTES, stream);
    if (e != hipSuccess) fprintf(stderr, "cooperative launch failed: %s (grid %d)\n", hipGetErrorString(e), grid);
#endif
    const hipError_t le = hipPeekAtLastError();
    if (le != hipSuccess) fprintf(stderr, "kernel_launch: launch failed: %s\n", hipGetErrorName(le));
}
```

```cpp
#include <hip/hip_runtime.h>
#include <hip/hip_cooperative_groups.h>
#include <cstdio>
#include <cstdint>
namespace cg = cooperative_groups;

#ifndef N_LAUNCH_MODE
#define N_LAUNCH_MODE 1
#endif

#define GAS __attribute__((address_space(1)))
#define LAS __attribute__((address_space(3)))
typedef unsigned short bf16_t;
typedef short bf16x8 __attribute__((ext_vector_type(8)));
typedef short s16x4 __attribute__((ext_vector_type(4)));
typedef float f32x2 __attribute__((ext_vector_type(2)));
typedef float f32x4 __attribute__((ext_vector_type(4)));
typedef float f32x16 __attribute__((ext_vector_type(16)));
typedef unsigned u32x2 __attribute__((ext_vector_type(2)));
typedef unsigned u32x4 __attribute__((ext_vector_type(4)));
typedef __bf16 bf16x2 __attribute__((ext_vector_type(2)));

constexpr int DM = 4096, NB = 4, SEQ = 4096, NMETA = 16, LTOT = SEQ + NMETA;
constexpr int MR = NB * SEQ;
constexpr int INC = 7168, OFF_K = 2048, OFF_V = 2560, OFF_X = 3072, OFF_Y = 5120;
constexpr int HD = 128, NQ = 16, NKV = 4, DATT = 2048, DRNN = 2048;
constexpr int KPAD = 4224;
constexpr int NT_REAL = 64;
constexpr int PH = 8, NKEYS = 128, PDQ = 256, PTOPK = 16, PE = 128, NEXP = 16384;
constexpr float EPS = 1e-6f;

constexpr size_t MiB = 1u << 20;
constexpr size_t WS_CTL = 0;
constexpr size_t WS_ROPE = 1 * MiB;
constexpr size_t WS_RSTD2 = 1 * MiB + 65536;
constexpr size_t WS_SU = 1 * MiB + 131072;
constexpr size_t WS_SV = 1 * MiB + 196608;
constexpr size_t WS_SKB = 2 * MiB;
constexpr size_t WS_ZM = 2 * MiB + 524288;
constexpr size_t WS_WG = 3 * MiB;
constexpr size_t WS_WT1 = 5 * MiB;
constexpr size_t WS_WT2 = 61 * MiB;
constexpr size_t WS_WT3 = 93 * MiB;
constexpr size_t WS_XN = 109 * MiB;
constexpr size_t WS_KP = 238 * MiB;
constexpr size_t WS_VP = 255 * MiB;
constexpr size_t WS_MRG = 272 * MiB;
constexpr size_t WS_SSQ2 = 400 * MiB;
constexpr size_t WS_IDX = 404 * MiB;
constexpr size_t WS_GATE = 412 * MiB;
constexpr size_t WS_QP = 420 * MiB;
constexpr size_t WS_Z = 484 * MiB;
constexpr size_t WS_HF = 708 * MiB;
constexpr size_t WS_HB = 772 * MiB;
constexpr size_t WS_UB = 484 * MiB;
constexpr size_t WS_VB = 516 * MiB;
constexpr size_t WS_SUT = 336 * MiB;
constexpr size_t WS_GS = 344 * MiB;
constexpr size_t WS_PACT = 272 * MiB;
constexpr size_t WS_WQ = 352 * MiB;
constexpr size_t WS_SWQ = 354 * MiB;
constexpr size_t WS_END = 836 * MiB;

constexpr int LDS_BYTES = 147456; constexpr int LDS_MISC = 147456 - 256;
constexpr int NWAVES = 8;
constexpr int NPHASE = 11;

__device__ __forceinline__ unsigned f2bf(float f) { unsigned u = __builtin_bit_cast(unsigned, f); return (u + 0x7fffu + ((u >> 16) & 1u)) >> 16; }
__device__ __forceinline__ unsigned pk2(float lo, float hi) { return f2bf(lo) | (f2bf(hi) << 16); }
__device__ __forceinline__ float bflo(unsigned w) { return __builtin_bit_cast(float, w << 16); }
__device__ __forceinline__ float bfhi(unsigned w) { return __builtin_bit_cast(float, w & 0xffff0000u); }
__device__ __forceinline__ float bf2f(bf16_t b) { return __builtin_bit_cast(float, ((unsigned)b) << 16); }
__device__ __forceinline__ unsigned cvt_pk_bf16(float lo, float hi) { unsigned r; asm volatile("v_cvt_pk_bf16_f32 %0, %1, %2" : "=v"(r) : "v"(lo), "v"(hi)); return r; }
__device__ __forceinline__ float wave_sum(float v) {
#pragma unroll
    for (int o = 1; o < 64; o <<= 1) v += __shfl_xor(v, o);
    return v;
}
__device__ __forceinline__ float gelu_tanh(float x) {
    const float y = 0.7978845608028654f * (x + 0.044715f * x * x * x);
    const float e = __expf(2.f * y);
    const float th = 1.f - 2.f / (1.f + e);
    return 0.5f * x * (1.f + th);
}
__device__ __forceinline__ float sigmoidf_(float x) { return 1.f / (1.f + __expf(-x)); }
__device__ __forceinline__ float dot2bf(unsigned w, unsigned x, float acc) { return __builtin_amdgcn_fdot2_f32_bf16(__builtin_bit_cast(bf16x2, w), __builtin_bit_cast(bf16x2, x), acc, false); }
__device__ __forceinline__ float ub0(unsigned x) { float r; asm("v_cvt_f32_ubyte0 %0, %1" : "=v"(r) : "v"(x)); return r; }
__device__ __forceinline__ float ub1(unsigned x) { float r; asm("v_cvt_f32_ubyte1 %0, %1" : "=v"(r) : "v"(x)); return r; }
__device__ __forceinline__ float ub2(unsigned x) { float r; asm("v_cvt_f32_ubyte2 %0, %1" : "=v"(r) : "v"(x)); return r; }
__device__ __forceinline__ float ub3(unsigned x) { float r; asm("v_cvt_f32_ubyte3 %0, %1" : "=v"(r) : "v"(x)); return r; }
__device__ __forceinline__ float wave_max(float v) {
#pragma unroll
    for (int o = 1; o < 64; o <<= 1) v = fmaxf(v, __shfl_xor(v, o));
    return v;
}
__device__ __forceinline__ unsigned pack_i8x4(float a, float b, float c, float d, int bias) {
    const int ia = (int)__builtin_rintf(a) + bias, ib = (int)__builtin_rintf(b) + bias, ic = (int)__builtin_rintf(c) + bias, id = (int)__builtin_rintf(d) + bias;
    return (unsigned)(ia & 0xff) | ((unsigned)(ib & 0xff) << 8) | ((unsigned)(ic & 0xff) << 16) | ((unsigned)id << 24);
}
#define LDS_WAIT() asm volatile("s_waitcnt lgkmcnt(0)" ::: "memory")

namespace pg8 {
constexpr int BM = 256, BK = 64, HALF = 128, HTB = HALF * BK * 2, STAGE_BYTES = 8 * HTB, NXCD = 8, WGM = 8;
__host__ __device__ __forceinline__ int lds_byte(int r, int c) { const int st = (r >> 4) * 2 + (c >> 5), rr = r & 15, cc = c & 31, ob = rr * 64 + cc * 2; return st * 1024 + (ob ^ (((ob >> 9) & 1) << 5)); }
__host__ __device__ __forceinline__ void stage_rc(int b, int& R, int& C) { const int st = b / 1024, sb = b % 1024, swz = sb ^ (((sb >> 9) & 1) << 5); R = (st >> 1) * 16 + swz / 64; C = (st & 1) * 32 + (swz % 64) / 2; }
__host__ __device__ __forceinline__ int perm32(int rho) { const int n = rho >> 4, i = rho & 15; return 8 * (i >> 2) + 4 * n + (i & 3); }
struct Unit { int pm, pn; };
struct Gemm { const bf16_t* A; const bf16_t* Bt; int M, N, K; };
struct StaticOrder {
    int nM, nN, nwg, G, c;
    __host__ __device__ void init(int M, int N, int G_, int c_) { nM = M / BM; nN = N / BM; nwg = nM * nN; G = G_; c = c_; }
    __host__ __device__ bool next(int i, Unit& u) const {
        const long L = (long)i * G + c; if (L >= nwg) return false;
        int wgid = (int)L; { const int q = nwg / NXCD, r = nwg % NXCD, xcd = wgid % NXCD, off = wgid / NXCD; wgid = (xcd < r ? xcd * (q + 1) : r * (q + 1) + (xcd - r) * q) + off; }
        const int nig = WGM * nN, gid = wgid / nig, fm = gid * WGM, gsz = (nM - fm) < WGM ? (nM - fm) : WGM;
        u.pm = fm + ((wgid % nig) % gsz); u.pn = (wgid % nig) / gsz; return true;
    }
};
struct EpiBf16 {
    bf16_t* O; int ldc;
    __device__ __forceinline__ void operator()(const f32x4 (&acc)[2][2][4][2], const Unit& u, int wr, int wc, int fr, int fq) const {
        const int row0 = u.pm * BM + wr * 64 + fr; const int col0 = u.pn * BM + wc * 32 + 8 * fq;
#pragma unroll
        for (int ai = 0; ai < 2; ++ai)
#pragma unroll
            for (int m = 0; m < 4; ++m) { bf16_t* rowp = O + (size_t)(row0 + ai * HALF + m * 16) * ldc + col0;
#pragma unroll
                for (int bj = 0; bj < 2; ++bj) { const f32x4 v0 = acc[ai][bj][m][0], v1 = acc[ai][bj][m][1];
                    u32x4 w; w.x = cvt_pk_bf16(v0[0], v0[1]); w.y = cvt_pk_bf16(v0[2], v0[3]); w.z = cvt_pk_bf16(v1[0], v1[1]); w.w = cvt_pk_bf16(v1[2], v1[3]);
                    *(u32x4*)(rowp + bj * HALF) = w; } }
    }
};
struct EpiResid {
    const float* X; float* OUT; bf16_t* HB; float* SSQ; int ldc;
    __device__ __forceinline__ void operator()(const f32x4 (&acc)[2][2][4][2], const Unit& u, int wr, int wc, int fr, int fq) const {
        const int row0 = u.pm * BM + wr * 64 + fr; const int col0 = u.pn * BM + wc * 32 + 8 * fq;
#pragma unroll
        for (int ai = 0; ai < 2; ++ai)
#pragma unroll
            for (int m = 0; m < 4; ++m) { const int row = row0 + ai * HALF + m * 16; const size_t off = (size_t)row * ldc + col0; float ss = 0.f;
#pragma unroll
                for (int bj = 0; bj < 2; ++bj) {
                    const f32x4 x0 = *(const f32x4*)(X + off + bj * HALF), x1 = *(const f32x4*)(X + off + bj * HALF + 4);
                    const f32x4 v0 = acc[ai][bj][m][0] + x0, v1 = acc[ai][bj][m][1] + x1;
                    u32x4 w; w.x = cvt_pk_bf16(v0[0], v0[1]); w.y = cvt_pk_bf16(v0[2], v0[3]); w.z = cvt_pk_bf16(v1[0], v1[1]); w.w = cvt_pk_bf16(v1[2], v1[3]);
                    *(u32x4*)(HB + off + bj * HALF) = w;
                    ss += (v0[0] * v0[0] + v0[1] * v0[1]) + (v0[2] * v0[2] + v0[3] * v0[3]) + (v1[0] * v1[0] + v1[1] * v1[1]) + (v1[2] * v1[2] + v1[3] * v1[3]); }
                ss += __shfl_xor(ss, 16); ss += __shfl_xor(ss, 32);
                if (fq == 0) SSQ[(size_t)row * 64 + u.pn * 4 + wc] = ss; }
    }
};

template <class Epi>
__device__ __forceinline__ void gemm_phase(LAS unsigned char* lds, const Gemm g, const StaticOrder& S, const Epi& E) {
    const int tid = threadIdx.x, wid = __builtin_amdgcn_readfirstlane(tid >> 6), lane = tid & 63, wr = wid >> 2, wc = wid & 3, fr = lane & 15, fq = lane >> 4;
    const int K = g.K, nt = K / BK;
    unsigned voffA[2], voffB[2];
#pragma unroll
    for (int i = 0; i < 2; ++i) { int R, C; stage_rc(tid * 16 + i * 8192, R, C); const int Rb = (R & ~31) + perm32(R & 31);
        voffA[i] = (unsigned)(R * K + C) * 2u; voffB[i] = (unsigned)(Rb * K + C) * 2u; }
    const size_t kstep = (size_t)(BK * 2);
    const size_t hstep = (size_t)HALF * K * 2;
    const size_t tstep = 2 * hstep;
    const unsigned ldsw = (unsigned)wid * 1024u;
    const int aoff = lds_byte(wr * 64 + fr, fq * 8), boff = lds_byte(wc * 32 + fr, fq * 8);
#define PG8_SA(b, h) (((b) * 2 + (h)) * HTB)
#define PG8_SB(b, h) ((4 + (b) * 2 + (h)) * HTB)
#define PG8_STAGE(bufoff, gbase, voff) do { _Pragma("unroll") for (int _i = 0; _i < 2; ++_i) \
        __builtin_amdgcn_global_load_lds((const unsigned*)((const char*)(gbase) + (voff)[_i]), (LAS unsigned*)(lds + (bufoff) + ldsw + _i * 8192), 16, 0, 0); } while (0)
#define PG8_LDA(dst, b, h) do { _Pragma("unroll") for (int m = 0; m < 4; ++m) _Pragma("unroll") for (int k = 0; k < 2; ++k) dst[m][k] = *(const LAS bf16x8*)(lds + PG8_SA(b, h) + aoff + m * 2048 + k * 1024); } while (0)
#define PG8_LDB(dst, b, h) do { _Pragma("unroll") for (int n = 0; n < 2; ++n) _Pragma("unroll") for (int k = 0; k < 2; ++k) dst[n][k] = *(const LAS bf16x8*)(lds + PG8_SB(b, h) + boff + n * 2048 + k * 1024); } while (0)
#define PG8_MMA(ai, bj, At, Bt) do { __builtin_amdgcn_s_setprio(1); _Pragma("unroll") for (int m = 0; m < 4; ++m) _Pragma("unroll") for (int n = 0; n < 2; ++n) _Pragma("unroll") for (int k = 0; k < 2; ++k) \
        acc[ai][bj][m][n] = __builtin_amdgcn_mfma_f32_16x16x32_bf16(Bt[n][k], At[m][k], acc[ai][bj][m][n], 0, 0, 0); __builtin_amdgcn_s_setprio(0); } while (0)
#define PG8_WAIT_V(n) asm volatile("s_waitcnt vmcnt(" #n ")" ::: "memory")
#define PG8_WAIT_L(n) asm volatile("s_waitcnt lgkmcnt(" #n ")" ::: "memory")
#define PG8_BAR __builtin_amdgcn_s_barrier()
#define PG8_SCHED __builtin_amdgcn_sched_barrier(0)
    Unit cur, nxt; int ui = 0;
    if (!S.next(0, cur)) return;
    f32x4 acc[2][2][4][2];
#pragma unroll
    for (int a = 0; a < 2; ++a)
#pragma unroll
        for (int b = 0; b < 2; ++b)
#pragma unroll
            for (int m = 0; m < 4; ++m)
#pragma unroll
                for (int n = 0; n < 2; ++n) acc[a][b][m][n] = (f32x4){0.f, 0.f, 0.f, 0.f};
    bf16x8 At[4][2], B0[2][2], B1[2][2];
    const char* cA = (const char*)g.A + (size_t)cur.pm * tstep; const char* cB = (const char*)g.Bt + (size_t)cur.pn * tstep;
    PG8_STAGE(PG8_SB(0, 0), cB, voffB); PG8_STAGE(PG8_SB(0, 1), cB + hstep, voffB); PG8_STAGE(PG8_SA(0, 0), cA, voffA); PG8_STAGE(PG8_SA(0, 1), cA + hstep, voffA);
    if (wr == 1) PG8_BAR;
    PG8_WAIT_V(2); PG8_BAR;
    PG8_STAGE(PG8_SB(1, 0), cB + kstep, voffB); PG8_STAGE(PG8_SA(1, 0), cA + kstep, voffA); PG8_STAGE(PG8_SB(1, 1), cB + hstep + kstep, voffB);
    PG8_WAIT_V(6); PG8_BAR;
    for (;;) {
        const bool has_next = S.next(ui + 1, nxt);
        const char* nA = has_next ? (const char*)g.A + (size_t)nxt.pm * tstep : cA; const char* nB = has_next ? (const char*)g.Bt + (size_t)nxt.pn * tstep : cB;
        for (int t = 0; t < nt; t += 2) {
            const bool last = (t == nt - 2);
            const char* a1 = cA + (size_t)(t + 1) * kstep;
            const char* a2 = last ? nA : cA + (size_t)(t + 2) * kstep; const char* b2 = last ? nB : cB + (size_t)(t + 2) * kstep;
            const char* a3 = a2 + kstep; const char* b3 = b2 + kstep;
            PG8_LDB(B0, 0, 0); PG8_LDB(B1, 0, 1); PG8_SCHED; PG8_LDA(At, 0, 0); PG8_STAGE(PG8_SA(1, 1), a1 + hstep, voffA);
            PG8_WAIT_V(8); PG8_WAIT_L(0); PG8_BAR; PG8_MMA(0, 0, At, B0); PG8_MMA(0, 1, At, B1); PG8_BAR; PG8_SCHED;
            PG8_LDA(At, 0, 1); PG8_STAGE(PG8_SB(0, 0), b2, voffB); PG8_STAGE(PG8_SB(0, 1), b2 + hstep, voffB); PG8_STAGE(PG8_SA(0, 0), a2, voffA);
            PG8_WAIT_V(8); PG8_WAIT_L(0); PG8_BAR; PG8_MMA(1, 0, At, B0); PG8_MMA(1, 1, At, B1); PG8_BAR; PG8_SCHED;
            PG8_LDB(B0, 1, 0); PG8_LDB(B1, 1, 1); PG8_SCHED; PG8_LDA(At, 1, 0); PG8_STAGE(PG8_SA(0, 1), a2 + hstep, voffA);
            PG8_WAIT_V(8); PG8_WAIT_L(0); PG8_BAR; PG8_MMA(0, 0, At, B0); PG8_MMA(0, 1, At, B1); PG8_BAR; PG8_SCHED;
            PG8_LDA(At, 1, 1); PG8_STAGE(PG8_SB(1, 0), b3, voffB); PG8_STAGE(PG8_SB(1, 1), b3 + hstep, voffB); PG8_STAGE(PG8_SA(1, 0), a3, voffA);
            PG8_WAIT_V(8); PG8_WAIT_L(0); PG8_BAR; PG8_MMA(1, 0, At, B0); PG8_MMA(1, 1, At, B1); PG8_BAR; PG8_SCHED;
        }
        if (wr == 0) PG8_BAR;
        E(acc, cur, wr, wc, fr, fq);
        if (!has_next) break;
#pragma unroll
        for (int a = 0; a < 2; ++a)
#pragma unroll
            for (int b = 0; b < 2; ++b)
#pragma unroll
                for (int m = 0; m < 4; ++m)
#pragma unroll
                    for (int n = 0; n < 2; ++n) acc[a][b][m][n] = (f32x4){0.f, 0.f, 0.f, 0.f};
        cur = nxt; cA = nA; cB = nB; ++ui;
        if (wr == 1) PG8_BAR;
    }
    PG8_WAIT_V(0);
    PG8_BAR;
#undef PG8_SA
#undef PG8_SB
#undef PG8_STAGE
#undef PG8_LDA
#undef PG8_LDB
#undef PG8_MMA
#undef PG8_WAIT_V
#undef PG8_WAIT_L
#undef PG8_BAR
#undef PG8_SCHED
}
}

namespace att {
constexpr int D = 128, NW = 8, QBLK = 32, KVBLK = 64;
constexpr float SCALE = 0.088388347648318440f;
constexpr float THR = 8.f;
constexpr int LDQ = INC, LDK = HD, LDO = DM;
constexpr size_t SHM_V = KVBLK * D * 2, SHM_K = KVBLK * D * 2, SHM_ATTN = 2 * SHM_V + 2 * SHM_K + NW * 64 * 4;
#define KSWZ(row, colB) ((row) * 256 + ((colB) ^ (((row) & 7) << 4)))
#define SBAR() __builtin_amdgcn_sched_barrier(0)
__device__ __forceinline__ int crow(int r, int hi) { return (r & 3) + 8 * (r >> 2) + 4 * hi; }
__device__ __forceinline__ unsigned cvtpk(float lo, float hi) { unsigned r; asm volatile("v_cvt_pk_bf16_f32 %0, %1, %2" : "=v"(r) : "v"(lo), "v"(hi)); return r; }
template <int NV> __device__ __forceinline__ void partialSM(f32x16& p0, f32x16& p1, float& m_reg, float& mn, float& alpha) {
    constexpr float C = SCALE * 1.4426950408889634f;
    float pmax = p0[0];
#pragma unroll
    for (int r = 1; r < 16; ++r) pmax = fmaxf(pmax, p0[r]);
#pragma unroll
    for (int r = 0; r < 16; ++r) pmax = fmaxf(pmax, p1[r]);
    { auto rr = __builtin_amdgcn_permlane32_swap(__float_as_uint(pmax), __float_as_uint(pmax), false, false);
      pmax = fmaxf(__uint_as_float(rr[0]), __uint_as_float(rr[1])); }
    if (__builtin_expect(__all(pmax - m_reg <= THR / SCALE), 1)) { mn = m_reg; alpha = 1.f; }
    else { mn = fmaxf(m_reg, pmax); alpha = __builtin_amdgcn_exp2f((m_reg - mn) * C); m_reg = mn; }
    float mnC = -mn * C;
#pragma unroll
    for (int r = 0; r < 16; ++r) p0[r] = fmaf(p0[r], C, mnC);
#pragma unroll
    for (int r = 0; r < 16; ++r) p1[r] = fmaf(p1[r], C, mnC);
#pragma unroll
    for (int r = 0; r < 16; ++r) p0[r] = __builtin_amdgcn_exp2f(p0[r]);
}
__device__ __forceinline__ void finishSM(f32x16& p0, f32x16& p1, float alpha, float& l_reg, bf16x8& pa0, bf16x8& pa1, bf16x8& pa2, bf16x8& pa3) {
#pragma unroll
    for (int r = 0; r < 16; ++r) p1[r] = __builtin_amdgcn_exp2f(p1[r]);
    float ps = 0;
#pragma unroll
    for (int r = 0; r < 16; ++r) ps += p0[r];
#pragma unroll
    for (int r = 0; r < 16; ++r) ps += p1[r];
    { auto rr = __builtin_amdgcn_permlane32_swap(__float_as_uint(ps), __float_as_uint(ps), false, false);
      ps = __uint_as_float(rr[0]) + __uint_as_float(rr[1]); }
    l_reg = l_reg * alpha + ps;
#define PK4(P, BASE, OUT) do { unsigned a0 = cvtpk(P[BASE + 0], P[BASE + 1]), a1 = cvtpk(P[BASE + 2], P[BASE + 3]);   \
    unsigned b0 = cvtpk(P[BASE + 4], P[BASE + 5]), b1 = cvtpk(P[BASE + 6], P[BASE + 7]);                              \
    auto r0 = __builtin_amdgcn_permlane32_swap(a0, b0, false, false); auto r1 = __builtin_amdgcn_permlane32_swap(a1, b1, false, false); \
    u32x4 w = {r0[0], r1[0], r0[1], r1[1]}; OUT = *reinterpret_cast<bf16x8*>(&w); } while (0)
    PK4(p0, 0, pa0); PK4(p0, 8, pa1); PK4(p1, 0, pa2); PK4(p1, 8, pa3);
#undef PK4
}
__device__ __forceinline__ void qkt(f32x16& p0, f32x16& p1, const bf16_t* Ks, const bf16x8* qr, int r32, int hi) {
    p0 = f32x16{}; p1 = f32x16{};
#pragma unroll
    for (int d0 = 0; d0 < 8; ++d0) { int cb = (d0 * 16 + hi * 8) * 2;
        bf16x8 b0 = *reinterpret_cast<const bf16x8*>((const char*)Ks + KSWZ(r32, cb));
        bf16x8 b1 = *reinterpret_cast<const bf16x8*>((const char*)Ks + KSWZ(32 + r32, cb));
        p0 = __builtin_amdgcn_mfma_f32_32x32x16_bf16(b0, qr[d0], p0, 0, 0, 0);
        p1 = __builtin_amdgcn_mfma_f32_32x32x16_bf16(b1, qr[d0], p1, 0, 0, 0); }
}
__device__ __forceinline__ int v_st(int k, int c) { const int kk = (k & ~0xC) | ((k & 4) << 1) | ((k & 8) >> 1); return ((kk >> 3) * 4 + (c >> 5)) * 512 + ((kk & 7) * 32 + (c & 31)) * 2; }
__device__ __forceinline__ int v_rd_base(int lane) { return ((lane & 3) << 3) | (((lane >> 2) & 3) << 6) | (((lane >> 4) & 1) << 5) | (((lane >> 5) & 1) << 8); }
constexpr int v_rd_off(int d0, int ks, int half) { return d0 * 512 + ks * 4096 + half * 2048; }
template <int OFF> __device__ __forceinline__ s16x4 tr_read(int vb) {
    s16x4 r; asm volatile("ds_read_b64_tr_b16 %0, %1 offset:%2" : "=&v"(r) : "v"(vb), "i"(OFF) : "memory"); return r;
}
template <int D0> __device__ __forceinline__ void pv_one(f32x16& od, int vb, bf16x8 pa0, bf16x8 pa1, bf16x8 pa2, bf16x8 pa3) {
    const s16x4 l0 = tr_read<v_rd_off(D0, 0, 0)>(vb), h0 = tr_read<v_rd_off(D0, 0, 1)>(vb), l1 = tr_read<v_rd_off(D0, 1, 0)>(vb), h1 = tr_read<v_rd_off(D0, 1, 1)>(vb);
    const s16x4 l2 = tr_read<v_rd_off(D0, 2, 0)>(vb), h2 = tr_read<v_rd_off(D0, 2, 1)>(vb), l3 = tr_read<v_rd_off(D0, 3, 0)>(vb), h3 = tr_read<v_rd_off(D0, 3, 1)>(vb);
    asm volatile("s_waitcnt lgkmcnt(0)" ::: "memory"); SBAR();
#define PK(L, H) (bf16x8){L[0], L[1], L[2], L[3], H[0], H[1], H[2], H[3]}
    od = __builtin_amdgcn_mfma_f32_32x32x16_bf16(pa0, PK(l0, h0), od, 0, 0, 0);
    od = __builtin_amdgcn_mfma_f32_32x32x16_bf16(pa1, PK(l1, h1), od, 0, 0, 0);
    od = __builtin_amdgcn_mfma_f32_32x32x16_bf16(pa2, PK(l2, h2), od, 0, 0, 0);
    od = __builtin_amdgcn_mfma_f32_32x32x16_bf16(pa3, PK(l3, h3), od, 0, 0, 0);
#undef PK
}
__device__ __forceinline__ void pv_d0(f32x16* o, int vb, bf16x8 pa0, bf16x8 pa1, bf16x8 pa2, bf16x8 pa3) {
    pv_one<0>(o[0], vb, pa0, pa1, pa2, pa3); pv_one<1>(o[1], vb, pa0, pa1, pa2, pa3); pv_one<2>(o[2], vb, pa0, pa1, pa2, pa3); pv_one<3>(o[3], vb, pa0, pa1, pa2, pa3);
}

__device__ __forceinline__ void attn_unit(const bf16_t* __restrict__ Qb, const bf16_t* __restrict__ Kh, const bf16_t* __restrict__ Vh, bf16_t* __restrict__ Ob, char* lds,
                                          const int s0, const float* __restrict__ gq, const f32x2* __restrict__ RT) {
    const int tid = threadIdx.x, wid = tid >> 6, lane = tid & 63, r32 = lane & 31, hi = lane >> 5;
    bf16_t* V_lds = (bf16_t*)lds; bf16_t* K_lds = (bf16_t*)(lds + 2 * SHM_V);
    float* ws = (float*)(lds + 2 * SHM_V + 2 * SHM_K) + wid * 64; float* li_l = ws; float* al_l = ws + 32;
    float m_reg = -1e30f, l_reg = 0; bf16x8 qr[8];
    const bf16_t* Qw = Qb + (long)(wid * QBLK + r32) * LDQ + hi * 8;
#pragma unroll
    for (int d0 = 0; d0 < 8; ++d0) qr[d0] = *reinterpret_cast<const bf16x8*>(Qw + d0 * 16);
    { float ss = 0.f;
#pragma unroll
      for (int d0 = 0; d0 < 8; ++d0)
#pragma unroll
          for (int j = 0; j < 8; ++j) { const float x = bf2f((bf16_t)qr[d0][j]); ss += x * x; }
      ss += __shfl_xor(ss, 32);
      const float rstd = 1.f / sqrtf(ss * (1.f / HD) + EPS);
      const int sq = s0 + wid * QBLK + r32, prow = sq >> 6, pcol = sq & 63;
#pragma unroll
      for (int pr = 0; pr < 4; ++pr) { const int da = (pr & 1) + 4 * (pr >> 1), db = da + 2; const int pos = (pr < 2) ? prow : pcol;
          const f32x4* cs4 = (const f32x4*)(RT + pos * 32 + (da & 1) * 16 + hi * 8);
          const f32x4* ga4 = (const f32x4*)(gq + da * 16 + hi * 8); const f32x4* gb4 = (const f32x4*)(gq + db * 16 + hi * 8);
          unsigned wa[4], wb[4];
#pragma unroll
          for (int jj = 0; jj < 4; ++jj) { const f32x4 cs = cs4[jj]; const f32x4 ga = ga4[jj >> 1], gb = gb4[jj >> 1];
              const int j = 2 * jj; const float g0a = (jj & 1) ? ga.z : ga.x, g1a = (jj & 1) ? ga.w : ga.y, g0b = (jj & 1) ? gb.z : gb.x, g1b = (jj & 1) ? gb.w : gb.y;
              const float xa0 = bf2f((bf16_t)qr[da][j]) * rstd * g0a, xa1 = bf2f((bf16_t)qr[da][j + 1]) * rstd * g1a;
              const float xb0 = bf2f((bf16_t)qr[db][j]) * rstd * g0b, xb1 = bf2f((bf16_t)qr[db][j + 1]) * rstd * g1b;
              wa[jj] = cvtpk(xa0 * cs.x - xb0 * cs.y, xa1 * cs.z - xb1 * cs.w);
              wb[jj] = cvtpk(xb0 * cs.x + xa0 * cs.y, xb1 * cs.z + xa1 * cs.w); }
          const u32x4 va = {wa[0], wa[1], wa[2], wa[3]}, vb = {wb[0], wb[1], wb[2], wb[3]};
          qr[da] = *reinterpret_cast<const bf16x8*>(&va); qr[db] = *reinterpret_cast<const bf16x8*>(&vb); } }
    f32x16 o[4] = {};
    const int sr = tid >> 4, sc = (tid & 15) * 8, vst0 = v_st(sr, sc), vst1 = v_st(32 + sr, sc);
    const int vb0 = (int)(uintptr_t)V_lds + v_rd_base(lane);
    struct { bf16x8 vs0, vs1, ks0, ks1; } sr_[2];
    const unsigned toff = (unsigned)(sr * LDK + sc) * 2u;
#define SLOAD(i, k0) do { const char* _kb = (const char*)Kh + (size_t)(k0) * (LDK * 2); const char* _vb = (const char*)Vh + (size_t)(k0) * (LDK * 2); \
    sr_[i].vs0 = *reinterpret_cast<const bf16x8*>(_vb + toff); sr_[i].vs1 = *reinterpret_cast<const bf16x8*>(_vb + 32 * LDK * 2 + toff); \
    sr_[i].ks0 = *reinterpret_cast<const bf16x8*>(_kb + toff); sr_[i].ks1 = *reinterpret_cast<const bf16x8*>(_kb + 32 * LDK * 2 + toff); } while (0)
#define SWRITE(b, i) do { *(bf16x8*)((char*)V_lds + (b) * SHM_V + vst0) = sr_[i].vs0;          \
    *(bf16x8*)((char*)V_lds + (b) * SHM_V + vst1) = sr_[i].vs1; int kc = sc * 2;               \
    *(bf16x8*)((char*)K_lds + (b) * SHM_K + KSWZ(sr, kc)) = sr_[i].ks0;                       \
    *(bf16x8*)((char*)K_lds + (b) * SHM_K + KSWZ(32 + sr, kc)) = sr_[i].ks1; } while (0)
#define SWAIT() asm volatile("s_waitcnt vmcnt(4)" ::: "memory")
#define RESC(a) do { if (__any((a) < 1.f)) { if (hi == 0) al_l[r32] = (a); asm volatile("s_waitcnt lgkmcnt(0)" ::: "memory"); \
    _Pragma("unroll") for (int d = 0; d < 4; ++d) _Pragma("unroll") for (int r = 0; r < 16; ++r) o[d][r] *= al_l[crow(r, hi)]; } } while (0)
    f32x16 pA0, pA1, pB0, pB1; float mnA, mnB, alA, alB; bf16x8 pa0, pa1, pa2, pa3; constexpr int NT = KPAD / KVBLK; static_assert(NT == NT_REAL + 2, "tile count");
    constexpr int SE = 0, SO = 1;
    SLOAD(SE, 0); asm volatile("s_waitcnt vmcnt(0)" ::: "memory"); SWRITE(0, SE); __syncthreads();
    qkt(pA0, pA1, K_lds, qr, r32, hi); partialSM<64>(pA0, pA1, m_reg, mnA, alA);
    SLOAD(SO, KVBLK); SLOAD(SE, 2 * KVBLK);
    SWAIT(); SWRITE(1, SO); __syncthreads();
    for (int j = 1; j + 1 < NT; j += 2) {
        SBAR(); qkt(pB0, pB1, (bf16_t*)((char*)K_lds + SHM_K), qr, r32, hi);
        finishSM(pA0, pA1, alA, l_reg, pa0, pa1, pa2, pa3); SBAR();
        SLOAD(SO, (j + 2) * KVBLK); SBAR();
        pv_d0(o, vb0, pa0, pa1, pa2, pa3); partialSM<64>(pB0, pB1, m_reg, mnB, alB);
        __syncthreads(); SWAIT(); SWRITE(0, SE);
        RESC(alB); __syncthreads();
        SBAR(); qkt(pA0, pA1, K_lds, qr, r32, hi);
        finishSM(pB0, pB1, alB, l_reg, pa0, pa1, pa2, pa3); SBAR();
        if (j + 3 < NT) SLOAD(SE, (j + 3) * KVBLK); SBAR();
        pv_d0(o, vb0 + (int)SHM_V, pa0, pa1, pa2, pa3); partialSM<64>(pA0, pA1, m_reg, mnA, alA);
        __syncthreads(); SWAIT(); SWRITE(1, SO);
        RESC(alA); __syncthreads();
    }
    SBAR(); qkt(pB0, pB1, (bf16_t*)((char*)K_lds + SHM_K), qr, r32, hi);
    finishSM(pA0, pA1, alA, l_reg, pa0, pa1, pa2, pa3); SBAR();
    pv_d0(o, vb0, pa0, pa1, pa2, pa3); partialSM<64>(pB0, pB1, m_reg, mnB, alB);
    __syncthreads(); RESC(alB);
    finishSM(pB0, pB1, alB, l_reg, pa0, pa1, pa2, pa3); SBAR();
    pv_d0(o, vb0 + (int)SHM_V, pa0, pa1, pa2, pa3);
    l_reg -= (float)(KPAD - LTOT) * __builtin_amdgcn_exp2f(-m_reg * (SCALE * 1.4426950408889634f));
    if (hi == 0) li_l[r32] = l_reg; asm volatile("s_waitcnt lgkmcnt(0)" ::: "memory");
    float rli[16];
#pragma unroll
    for (int r = 0; r < 16; ++r) rli[r] = __builtin_amdgcn_rcpf(li_l[crow(r, hi)]);
    bf16_t* Ow = Ob + (long)(wid * QBLK) * LDO;
    const int odd = lane & 1;
#pragma unroll
    for (int r = 0; r < 16; r += 2) {
#pragma unroll
        for (int d0 = 0; d0 < 4; ++d0) {
            const float a = o[d0][r] * rli[r], b = o[d0][r + 1] * rli[r + 1];
            const float send = odd ? a : b;
            const float recv = __builtin_bit_cast(float, __builtin_amdgcn_update_dpp(0, __builtin_bit_cast(int, send), 0xB1, 0xF, 0xF, false));
            const float plo = odd ? recv : a, phi = odd ? b : recv;
            const unsigned w = cvtpk(plo, phi);
            const int orow = crow(odd ? r + 1 : r, hi);
            *(unsigned*)(Ow + (long)orow * LDO + d0 * 32 + (r32 & ~1)) = w;
        }
    }
    __syncthreads();
#undef SLOAD
#undef SWRITE
#undef SWAIT
#undef RESC
}
}

#define XB_TMO      128
#define XB_XCNT(j)  (256  + 64 * (j))
#define XB_XSUB(j)  (1280 + 64 * (j))
#define XB_XGEN(j)  (2304 + 64 * (j))
#define XB_TOP      3328
#define XB_TOPGEN   3392
#define XCD_BAR_WORDS 3456
#define XB_SPIN_CAP (1u << 22)
__device__ __forceinline__ unsigned xb_ld(unsigned* p)              { return __hip_atomic_load(p, __ATOMIC_RELAXED, __HIP_MEMORY_SCOPE_AGENT); }
__device__ __forceinline__ unsigned xb_add(unsigned* p, unsigned v) { return __hip_atomic_fetch_add(p, v, __ATOMIC_RELAXED, __HIP_MEMORY_SCOPE_AGENT); }
__device__ __forceinline__ unsigned xb_xcc_id() { return (unsigned)__builtin_amdgcn_s_getreg((3 << 11) | 20) & 0xFu; }
#define XB_SPIN(cond, bar) do { unsigned _sp = 0; while (cond) { __builtin_amdgcn_s_sleep(1); \
    if ((++_sp & 255u) == 0u) { if (xb_ld(&(bar)[XB_TMO])) break; if (_sp > XB_SPIN_CAP) { atomicAdd(&(bar)[XB_TMO], 1u); break; } } } } while (0)
struct XcdBarrier { unsigned* bar; unsigned x; volatile LAS unsigned* st; };
__device__ __forceinline__ XcdBarrier xcd_barrier_post(unsigned* bar, volatile LAS unsigned* st) {
    XcdBarrier b; b.bar = bar; b.x = xb_xcc_id(); b.st = st;
    if (threadIdx.x == 0) (void)xb_add(&bar[XB_XCNT(b.x)], 1u);
    return b;
}
__device__ __forceinline__ void xcd_barrier_complete(unsigned* bar, unsigned x, unsigned& nloc, unsigned& nx) {
    const unsigned G = gridDim.x * gridDim.y * gridDim.z;
    unsigned sum, cnt, mine, sp = 0u;
    for (;;) {
        sum = 0u; cnt = 0u; mine = 0u;
#pragma unroll
        for (unsigned j = 0; j < 16; ++j) { const unsigned c = xb_ld(&bar[XB_XCNT(j)]); sum += c; cnt += (c > 0u) ? 1u : 0u; mine = (j == x) ? c : mine; }
        if (sum == G) break;
        __builtin_amdgcn_s_sleep(1);
        if ((++sp & 255u) == 0u) { if (xb_ld(&bar[XB_TMO])) break; if (sp > XB_SPIN_CAP) { atomicAdd(&bar[XB_TMO], 1u); break; } }
    }
    nloc = mine > 0u ? mine : 1u; nx = cnt > 0u ? cnt : 1u;
}
__device__ __forceinline__ void xcd_barrier(const XcdBarrier& b) {
    asm volatile("s_waitcnt vmcnt(0)" ::: "memory");
    __syncthreads();
    if (threadIdx.x == 0) {
        unsigned* bar = b.bar;
        __builtin_amdgcn_s_waitcnt(0);
        unsigned nloc = b.st[0], nx = b.st[1];
        if (nloc == 0u) { xcd_barrier_complete(bar, b.x, nloc, nx); b.st[0] = nloc; b.st[1] = nx; }
        const unsigned old = xb_add(&bar[XB_XSUB(b.x)], 1u);
        const unsigned gen = old / nloc;
        if (old + 1u == (gen + 1u) * nloc) {
            __builtin_amdgcn_fence(__ATOMIC_RELEASE, "agent");
            asm volatile("s_waitcnt vmcnt(0)" ::: "memory");
            const unsigned og = xb_add(&bar[XB_TOP], 1u);
            const unsigned tg = og / nx;
            if (og + 1u == (tg + 1u) * nx) xb_add(&bar[XB_TOPGEN], 1u);
            else XB_SPIN(xb_ld(&bar[XB_TOPGEN]) == tg, bar);
            __builtin_amdgcn_fence(__ATOMIC_ACQUIRE, "agent");
            xb_add(&bar[XB_XGEN(b.x)], 1u);
            asm volatile("s_waitcnt vmcnt(0)" ::: "memory");
        } else {
            XB_SPIN(xb_ld(&bar[XB_XGEN(b.x)]) == gen, bar);
            __builtin_amdgcn_fence(__ATOMIC_ACQUIRE, "agent");
            asm volatile("s_waitcnt vmcnt(0)" ::: "memory");
        }
    }
    __syncthreads();
}

struct Args { const float* in[21]; float* out; unsigned char* ws; int ph_lo, ph_hi; };
struct Frame {
    LAS unsigned char* lds; char* ldsg;
    int tid, lane, wave, vcu, G;
    float* out; unsigned char* ws;
};
#define IN_X 0
#define IN_META 1
#define IN_G1 2
#define IN_WIN 3
#define IN_QG 4
#define IN_KG 5
#define IN_CW 6
#define IN_CB 7
#define IN_WRG 8
#define IN_BRG 9
#define IN_WIG 10
#define IN_BIG 11
#define IN_LAM 12
#define IN_GA 13
#define IN_GL 14
#define IN_WOUT 15
#define IN_G2 16
#define IN_WQ 17
#define IN_SK 18
#define IN_U 19
#define IN_V 20

struct TItem { const float* W; const float* gk; bf16_t* WT; int N, K, k0, n0; };
__device__ __forceinline__ void p0_item_load(const TItem& T, int lane, f32x4 (&v)[16], float (&g)[16]) {
    const int kq = lane >> 4, nq = lane & 15;
#pragma unroll
    for (int i = 0; i < 16; ++i) { const int kk = 4 * i + kq; v[i] = *(const f32x4*)(T.W + (size_t)(T.k0 + kk) * T.N + T.n0 + 4 * nq); g[i] = T.gk ? T.gk[T.k0 + kk] : 1.f; }
}
__device__ __forceinline__ void p0_item_store(const TItem& T, int lane, const f32x4 (&v)[16], const float (&g)[16], LAS float* scr) {
    const int kq = lane >> 4, nq = lane & 15;
#pragma unroll
    for (int i = 0; i < 16; ++i) { const int kk = 4 * i + kq; LAS float* d = scr + kk * 65 + 4 * nq; d[0] = v[i].x * g[i]; d[1] = v[i].y * g[i]; d[2] = v[i].z * g[i]; d[3] = v[i].w * g[i]; }
    LDS_WAIT(); asm volatile("" ::: "memory");
    const int c = lane & 7;
#pragma unroll
    for (int j = 0; j < 8; ++j) { const int n = (lane >> 3) + 8 * j; const LAS float* sp = scr + (8 * c) * 65 + n;
        u32x4 o; o.x = pk2(sp[0 * 65], sp[1 * 65]); o.y = pk2(sp[2 * 65], sp[3 * 65]); o.z = pk2(sp[4 * 65], sp[5 * 65]); o.w = pk2(sp[6 * 65], sp[7 * 65]);
        *(u32x4*)(T.WT + (size_t)(T.n0 + n) * T.K + T.k0 + 8 * c) = o; }
    LDS_WAIT(); asm volatile("" ::: "memory");
}
__device__ __forceinline__ TItem p0_item_decode(Frame& F, const Args& A, int it) {
    constexpr int I_1 = (DM / 64) * (INC / 64), I_2 = (DM / 64) * (DM / 64), I_3 = (DM / 64) * (2048 / 64);
    TItem T; int r = it;
    if (r < I_1) { T.W = A.in[IN_WIN]; T.gk = A.in[IN_G1]; T.WT = (bf16_t*)(F.ws + WS_WT1); T.N = INC; T.K = DM; }
    else if ((r -= I_1) < I_2) { const int kb = r % (DM / 64); T.W = A.in[IN_WOUT]; T.gk = (kb < 32) ? A.in[IN_GA] : (A.in[IN_GL] - DATT); T.WT = (bf16_t*)(F.ws + WS_WT2); T.N = DM; T.K = DM; }
    else if ((r -= I_2) < I_3) { T.W = A.in[IN_WQ]; T.gk = A.in[IN_G2]; T.WT = (bf16_t*)(F.ws + WS_WT3); T.N = 2048; T.K = DM; }
    else { r -= I_3; const int mat = r >> 2; const int dirn = mat >> 1, gate = mat & 1;
        T.W = (gate ? A.in[IN_WIG] : A.in[IN_WRG]) + (size_t)dirn * 128 * 128; T.gk = nullptr; T.WT = (bf16_t*)(F.ws + WS_WG) + (size_t)mat * 128 * 128; T.N = 128; T.K = 128; r &= 3; }
    const int nkb = T.K / 64; T.k0 = 64 * (r % nkb); T.n0 = 64 * (r / nkb);
    return T;
}
__device__ __forceinline__ void p0_prologue(Frame& F, const Args& A) {
    LAS float* scr = (LAS float*)(F.lds + F.wave * 16640);
    const int gw = F.vcu * NWAVES + F.wave, NGW = F.G * NWAVES, lane = F.lane;
    constexpr int NITEMS = (DM / 64) * (INC / 64) + (DM / 64) * (DM / 64) + (DM / 64) * (2048 / 64) + 64 * 4;
    if (gw < NITEMS) {
        TItem T = p0_item_decode(F, A, gw); f32x4 v[16]; float g[16];
        p0_item_load(T, lane, v, g);
        for (int it = gw; it < NITEMS; it += NGW) {
            TItem Tn = T; f32x4 vn[16]; float gn[16];
            const bool more = it + NGW < NITEMS;
            if (more) { Tn = p0_item_decode(F, A, it + NGW); p0_item_load(Tn, lane, vn, gn); }
            p0_item_store(T, lane, v, g, scr);
            if (more) { T = Tn;
#pragma unroll
                for (int i = 0; i < 16; ++i) { v[i] = vn[i]; g[i] = gn[i]; } }
        }
    }
    bf16_t* XN = (bf16_t*)(F.ws + WS_XN);
    { f32x4 vn[16];
      if (gw < MR + NMETA) { const f32x4* xr = (const f32x4*)((gw < MR) ? A.in[IN_X] + (size_t)gw * DM : A.in[IN_META] + (size_t)(gw - MR) * DM) + lane;
#pragma unroll
          for (int j = 0; j < 16; ++j) vn[j] = xr[64 * j]; }
      for (int m = gw; m < MR + NMETA; m += NGW) {
        f32x4 v[16]; float s = 0.f;
#pragma unroll
        for (int j = 0; j < 16; ++j) { v[j] = vn[j]; s += (v[j].x * v[j].x + v[j].y * v[j].y) + (v[j].z * v[j].z + v[j].w * v[j].w); }
        { const int mn = m + NGW;
          if (mn < MR + NMETA) { const f32x4* xr = (const f32x4*)((mn < MR) ? A.in[IN_X] + (size_t)mn * DM : A.in[IN_META] + (size_t)(mn - MR) * DM) + lane;
#pragma unroll
              for (int j = 0; j < 16; ++j) vn[j] = xr[64 * j]; } }
        const float rstd = 1.f / sqrtf(wave_sum(s) * (1.f / DM) + EPS);
        u32x2* o8 = (u32x2*)(XN + (size_t)m * DM) + lane;
#pragma unroll
        for (int j = 0; j < 16; ++j) { u32x2 w; w.x = pk2(v[j].x * rstd, v[j].y * rstd); w.y = pk2(v[j].z * rstd, v[j].w * rstd); o8[64 * j] = w; }
      } }
    { const float* sk = A.in[IN_SK]; bf16_t* SKB = (bf16_t*)(F.ws + WS_SKB);
      for (int i = gw * 64 + lane; i < PH * 2 * NKEYS * 128 / 4; i += NGW * 64) { const f32x4 v = ((const f32x4*)sk)[i]; u32x2 w; w.x = pk2(v.x, v.y); w.y = pk2(v.z, v.w); ((u32x2*)SKB)[i] = w; }
      f32x2* RT = (f32x2*)(F.ws + WS_ROPE);
      for (int i = gw * 64 + lane; i < 64 * 32; i += NGW * 64) { const int p = i >> 5, j = i & 31;
          const float inv = exp2f(-(float)j * (13.287712379549449f / 32.f)); const float ang = (float)p * inv;
          float rev = ang * 0.15915494309189535f; rev -= floorf(rev);
          f32x2 cs; cs.x = __builtin_amdgcn_cosf(rev); cs.y = __builtin_amdgcn_sinf(rev); RT[i] = cs; } }
}

__device__ __forceinline__ void p1_meta_gemm(Frame& F, const Args& A) {
    const bf16_t* XNm = (const bf16_t*)(F.ws + WS_XN) + (size_t)MR * DM; const bf16_t* WT1 = (const bf16_t*)(F.ws + WS_WT1); bf16_t* ZM = (bf16_t*)(F.ws + WS_ZM);
    LAS float* red = (LAS float*)F.lds;
    const int lane = F.lane, c16 = lane & 15, q = lane >> 4;
    for (int item = F.vcu; item < (OFF_Y - OFF_K) / 16; item += F.G) {
        const int n0 = OFF_K + 16 * item;
        f32x4 acc = {0.f, 0.f, 0.f, 0.f};
        const bf16_t* ap = XNm + (size_t)c16 * DM + F.wave * 512 + 8 * q; const bf16_t* bp = WT1 + (size_t)(n0 + c16) * DM + F.wave * 512 + 8 * q;
#pragma unroll
        for (int ks = 0; ks < 16; ++ks) { const bf16x8 a = *(const bf16x8*)(ap + 32 * ks), b = *(const bf16x8*)(bp + 32 * ks); acc = __builtin_amdgcn_mfma_f32_16x16x32_bf16(a, b, acc, 0, 0, 0); }
#pragma unroll
        for (int r = 0; r < 4; ++r) red[F.wave * 256 + (4 * q + r) * 16 + c16] = acc[r];
        __syncthreads();
        if (F.tid < 256) { float s = 0.f;
#pragma unroll
            for (int w = 0; w < 8; ++w) s += red[w * 256 + F.tid];
            ZM[(size_t)(F.tid >> 4) * INC + n0 + (F.tid & 15)] = (bf16_t)f2bf(s); }
        __syncthreads();
    }
}

template <int dir> __device__ __forceinline__ void scan_unit(Frame& F, const Args& A, int u) {
    const int half = (u >> 1) & 1, n = (u >> 2) & 15, b = u >> 6;
    const int tid = F.tid, lane = F.lane, wave = F.wave;
    const bf16_t* Z = (const bf16_t*)(F.ws + WS_Z); const bf16_t* ZM = (const bf16_t*)(F.ws + WS_ZM);
    bf16_t* HO = (bf16_t*)(F.ws + (dir ? WS_HB : WS_HF));
    LAS unsigned char* XR = F.lds;
    LAS unsigned char* XC = F.lds + 18432;
    LAS float* AS = (LAS float*)(F.lds + 35840);
    LAS float* BS = (LAS float*)(F.lds + 52224);
    LAS float* HS = (LAS float*)(F.lds + 68608);
    LAS float* SM = (LAS float*)(F.lds + 84992);
    LAS float* CR = (LAS float*)(F.lds + 89088);
    const int mt = wave & 3, dh = wave >> 2, r16 = lane & 15, q4 = lane >> 4;
    bf16x8 bw[4][4];
#pragma unroll
    for (int nt = 0; nt < 4; ++nt) { const int gate = nt >> 1, dcol = 64 * half + 32 * dh + 16 * (nt & 1) + r16;
        const bf16_t* wp = (const bf16_t*)(F.ws + WS_WG) + ((size_t)((dir * 16 + n) * 2 + gate) * 128 + dcol) * 128 + 8 * q4;
#pragma unroll
        for (int ks = 0; ks < 4; ++ks) bw[nt][ks] = *(const bf16x8*)(wp + 32 * ks); }
    float br[2], bi[2], sp8[2];
#pragma unroll
    for (int db = 0; db < 2; ++db) { const int che = 128 * n + 64 * half + 32 * dh + 16 * db + r16;
        br[db] = A.in[IN_BRG][dir * DRNN + che]; bi[db] = A.in[IN_BIG][dir * DRNN + che]; sp8[db] = 8.f * log1pf(__expf(-A.in[IN_LAM][dir * DRNN + che])); }
    const int cp = tid & 63, tg = tid >> 6;
    float cw[2][4], cb[2];
#pragma unroll
    for (int c = 0; c < 2; ++c) { const int ch = 128 * n + 2 * cp + c;
#pragma unroll
        for (int j = 0; j < 4; ++j) cw[c][j] = A.in[IN_CW][j * DRNN + ch];
        cb[c] = A.in[IN_CB][ch]; }
    const int ntile = dir ? 64 : 65;
    const int lr = tid >> 4, lc = tid & 15;
    u32x4 pf[3];
#define TILE_P0(it) (dir ? (NMETA + 64 * (63 - (it))) : ((it) == 0 ? -48 : NMETA + 64 * ((it) - 1)))
#define XR_PREFETCH(it) do { const int _p0 = TILE_P0(it); _Pragma("unroll") for (int _j = 0; _j < 3; ++_j) { const int _r = lr + 32 * _j; const int _p = _p0 - 2 + _r; u32x4 _v = {0u, 0u, 0u, 0u}; \
        if (_r < 67 && _p >= 0 && _p < LTOT) { const bf16_t* _row = (_p < NMETA) ? (ZM + (size_t)_p * INC) : (Z + (size_t)(b * SEQ + _p - NMETA) * INC); _v = *(const u32x4*)(_row + OFF_X + 128 * n + 8 * lc); } pf[_j] = _v; } } while (0)
    XR_PREFETCH(0);
    if (tid < 128) CR[tid] = 0.f;
    for (int it = 0; it < ntile; ++it) {
        const int p0 = TILE_P0(it);
#pragma unroll
        for (int j = 0; j < 3; ++j) { const int r = lr + 32 * j; if (r < 67) *(LAS u32x4*)(XR + r * 272 + lc * 16) = pf[j]; }
        __syncthreads();
        if (it + 1 < ntile) XR_PREFETCH(it + 1);
        { float x0[11], x1[11];
#pragma unroll
          for (int i = 0; i < 11; ++i) { const unsigned w = *(const LAS unsigned*)(XR + (8 * tg + i) * 272 + cp * 4); x0[i] = bflo(w); x1[i] = bfhi(w); }
#pragma unroll
          for (int i = 0; i < 8; ++i) { const float y0 = cw[0][0] * x0[i] + cw[0][1] * x0[i + 1] + cw[0][2] * x0[i + 2] + cw[0][3] * x0[i + 3] + cb[0];
              const float y1 = cw[1][0] * x1[i] + cw[1][1] * x1[i + 1] + cw[1][2] * x1[i + 2] + cw[1][3] * x1[i + 3] + cb[1];
              *(LAS unsigned*)(XC + (8 * tg + i) * 272 + cp * 4) = pk2(y0, y1); } }
        __syncthreads();
        { bf16x8 af[4];
#pragma unroll
          for (int ks = 0; ks < 4; ++ks) af[ks] = *(const LAS bf16x8*)(XC + (16 * mt + r16) * 272 + (32 * ks + 8 * q4) * 2);
          f32x4 acc[4];
#pragma unroll
          for (int nt = 0; nt < 4; ++nt) { acc[nt] = (f32x4){0.f, 0.f, 0.f, 0.f};
#pragma unroll
              for (int ks = 0; ks < 4; ++ks) acc[nt] = __builtin_amdgcn_mfma_f32_16x16x32_bf16(af[ks], bw[nt][ks], acc[nt], 0, 0, 0); }
#pragma unroll
          for (int db = 0; db < 2; ++db)
#pragma unroll
              for (int rg = 0; rg < 4; ++rg) { const int t = 16 * mt + 4 * q4 + rg, dloc = 32 * dh + 16 * db + r16;
                  const float gr = acc[db][rg] + br[db], gi = acc[2 + db][rg] + bi[db];
                  const float rr = __builtin_amdgcn_rcpf(1.f + __expf(-gr)), ii = __builtin_amdgcn_rcpf(1.f + __expf(-gi));
                  const float la = -sp8[db] * rr; float a = __expf(la);
                  const float x2 = 2.f * la;
                  const float ser = -x2 * (1.f + 0.5f * x2 * (1.f + (1.f / 3.f) * x2 * (1.f + 0.25f * x2 * (1.f + 0.2f * x2))));
                  const float om = (x2 > -0.125f) ? ser : (1.f - a * a);
                  const float xcv = bf2f(*(const LAS bf16_t*)(XC + t * 272 + (64 * half + dloc) * 2));
                  float bb = sqrtf(om) * (ii * xcv);
                  if (p0 + t < 0) { a = 1.f; bb = 0.f; }
                  AS[t * 64 + dloc] = a; BS[t * 64 + dloc] = bb; } }
        __syncthreads();
        float hl[8], pl[8];
        { float h = 0.f, pr = 1.f;
#pragma unroll
          for (int i = 0; i < 8; ++i) { const int j = 8 * wave + i, t = dir ? 63 - j : j; const float a = AS[t * 64 + lane], bq = BS[t * 64 + lane]; h = a * h + bq; pr *= a; hl[i] = h; pl[i] = pr; }
          SM[(wave * 64 + lane) * 2] = pr; SM[(wave * 64 + lane) * 2 + 1] = h; }
        __syncthreads();
        { float hin = CR[(it & 1) * 64 + lane];
          float sp_[7], sh_[7];
#pragma unroll
          for (int v = 0; v < 7; ++v) { sp_[v] = SM[(v * 64 + lane) * 2]; sh_[v] = SM[(v * 64 + lane) * 2 + 1]; }
#pragma unroll
          for (int v = 0; v < 7; ++v) hin = (v < wave) ? (sp_[v] * hin + sh_[v]) : hin;
#pragma unroll
          for (int i = 0; i < 8; ++i) { const int j = 8 * wave + i, t = dir ? 63 - j : j; const float h = hl[i] + pl[i] * hin; HS[t * 64 + lane] = h; if (i == 7 && wave == 7) CR[((it + 1) & 1) * 64 + lane] = h; } }
        __syncthreads();
        if (p0 >= NMETA) {
            const int c2 = (tid & 31) * 2;
#pragma unroll
            for (int ps = 0; ps < 4; ++ps) { const int t = (tid >> 5) + 16 * ps; const size_t m = (size_t)b * SEQ + (p0 + t - NMETA);
                *(unsigned*)(HO + m * DRNN + 128 * n + 64 * half + c2) = pk2(HS[t * 64 + c2], HS[t * 64 + c2 + 1]); }
        }
    }
    __syncthreads();
#undef TILE_P0
#undef XR_PREFETCH
}

__device__ __forceinline__ void normrope_rows(Frame& F, const Args& A) {
    const int gw = F.vcu * NWAVES + F.wave, NGW = F.G * NWAVES, lane = F.lane;
    bf16_t* Z = (bf16_t*)(F.ws + WS_Z); const bf16_t* ZM = (const bf16_t*)(F.ws + WS_ZM);
    bf16_t* KP = (bf16_t*)(F.ws + WS_KP); bf16_t* VP = (bf16_t*)(F.ws + WS_VP);
    const f32x2* RT = (const f32x2*)(F.ws + WS_ROPE);
    const int g = lane >> 4, i16 = lane & 15, j0 = 2 * i16;
    float gq[8], gk[8];
#pragma unroll
    for (int s = 0; s < 4; ++s) { gq[2 * s] = A.in[IN_QG][32 * s + j0]; gq[2 * s + 1] = A.in[IN_QG][32 * s + j0 + 1]; gk[2 * s] = A.in[IN_KG][32 * s + j0]; gk[2 * s + 1] = A.in[IN_KG][32 * s + j0 + 1]; }
    const int NIT = NB * KPAD;
    for (int it = gw; it < NIT; it += NGW) {
        const int b = it / KPAD, kidx = it - b * KPAD; const bool meta = (kidx >= SEQ) && (kidx < LTOT), pad = kidx >= LTOT;
        const bf16_t* row = meta ? (ZM + (size_t)(kidx - SEQ) * INC) : (Z + (size_t)(b * SEQ + (pad ? 0 : kidx)) * INC);
        if (pad) { const u32x4 z = {0u, 0u, 0u, 0u};
            *(u32x4*)(KP + ((size_t)(b * NKV + g) * KPAD + kidx) * HD + i16 * 8) = z; *(u32x4*)(VP + ((size_t)(b * NKV + g) * KPAD + kidx) * HD + i16 * 8) = z; continue; }
        f32x2 cr0 = {1.f, 0.f}, cr1 = {1.f, 0.f}, cc0 = {1.f, 0.f}, cc1 = {1.f, 0.f};
        if (!meta) { const int prow = kidx >> 6, pcol = kidx & 63; cr0 = RT[prow * 32 + j0]; cr1 = RT[prow * 32 + j0 + 1]; cc0 = RT[pcol * 32 + j0]; cc1 = RT[pcol * 32 + j0 + 1]; }
        { const bf16_t* base = row + OFF_K + g * HD;
          unsigned e[4];
#pragma unroll
          for (int sgm = 0; sgm < 4; ++sgm) e[sgm] = *(const unsigned*)(base + 32 * sgm + j0);
          float x[8]; float ss = 0.f;
#pragma unroll
          for (int sgm = 0; sgm < 4; ++sgm) { x[2 * sgm] = bflo(e[sgm]); x[2 * sgm + 1] = bfhi(e[sgm]); ss += x[2 * sgm] * x[2 * sgm] + x[2 * sgm + 1] * x[2 * sgm + 1]; }
          ss += __shfl_xor(ss, 1); ss += __shfl_xor(ss, 2); ss += __shfl_xor(ss, 4); ss += __shfl_xor(ss, 8);
          const float rstd = 1.f / sqrtf(ss * (1.f / HD) + EPS);
#pragma unroll
          for (int k = 0; k < 8; ++k) x[k] = x[k] * rstd * gk[k];
          float y[8];
          y[0] = x[0] * cr0.x - x[2] * cr0.y; y[2] = x[2] * cr0.x + x[0] * cr0.y;
          y[1] = x[1] * cr1.x - x[3] * cr1.y; y[3] = x[3] * cr1.x + x[1] * cr1.y;
          y[4] = x[4] * cc0.x - x[6] * cc0.y; y[6] = x[6] * cc0.x + x[4] * cc0.y;
          y[5] = x[5] * cc1.x - x[7] * cc1.y; y[7] = x[7] * cc1.x + x[5] * cc1.y;
          bf16_t* dst = KP + ((size_t)(b * NKV + g) * KPAD + kidx) * HD;
#pragma unroll
          for (int sgm = 0; sgm < 4; ++sgm) *(unsigned*)(dst + 32 * sgm + j0) = pk2(y[2 * sgm], y[2 * sgm + 1]); }
        { const u32x4 vv = *(const u32x4*)(row + OFF_V + lane * 8);
          *(u32x4*)(VP + ((size_t)(b * NKV + g) * KPAD + kidx) * HD + i16 * 8) = vv; }
    }
}

__device__ __forceinline__ void combine_rows(Frame& F, const Args& A) {
    const int gw = F.vcu * NWAVES + F.wave, NGW = F.G * NWAVES, lane = F.lane;
    bf16_t* MRG = (bf16_t*)(F.ws + WS_MRG); const bf16_t* HFp = (const bf16_t*)(F.ws + WS_HF); const bf16_t* HBp = (const bf16_t*)(F.ws + WS_HB); const bf16_t* Z = (const bf16_t*)(F.ws + WS_Z);
    for (int m = gw; m < MR; m += NGW) {
        u32x4* ap = (u32x4*)(MRG + (size_t)m * DM) + lane;
        u32x4 av[4]; float sa = 0.f;
#pragma unroll
        for (int j = 0; j < 4; ++j) { av[j] = ap[64 * j];
#pragma unroll
            for (int k = 0; k < 4; ++k) { const float lo = bflo(av[j][k]), hi = bfhi(av[j][k]); sa += lo * lo + hi * hi; } }
        const u32x4* fp = (const u32x4*)(HFp + (size_t)m * DRNN) + lane; const u32x4* bp = (const u32x4*)(HBp + (size_t)m * DRNN) + lane; const u32x4* yp = (const u32x4*)(Z + (size_t)m * INC + OFF_Y) + lane;
        float lv[32]; float sl = 0.f;
#pragma unroll
        for (int j = 0; j < 4; ++j) { const u32x4 f = fp[64 * j], bq = bp[64 * j], y = yp[64 * j];
#pragma unroll
            for (int k = 0; k < 4; ++k) { const float l0 = (bflo(f[k]) + bflo(bq[k])) * gelu_tanh(bflo(y[k])), l1 = (bfhi(f[k]) + bfhi(bq[k])) * gelu_tanh(bfhi(y[k]));
                lv[8 * j + 2 * k] = l0; lv[8 * j + 2 * k + 1] = l1; sl += l0 * l0 + l1 * l1; } }
        const float ra = 1.f / sqrtf(wave_sum(sa) * (1.f / DATT) + EPS), rl = 1.f / sqrtf(wave_sum(sl) * (1.f / DRNN) + EPS);
#pragma unroll
        for (int j = 0; j < 4; ++j) { u32x4 w;
#pragma unroll
            for (int k = 0; k < 4; ++k) w[k] = pk2(bflo(av[j][k]) * ra, bfhi(av[j][k]) * ra);
            ap[64 * j] = w; }
        u32x4* lp = (u32x4*)(MRG + (size_t)m * DM + DATT) + lane;
#pragma unroll
        for (int j = 0; j < 4; ++j) { u32x4 w;
#pragma unroll
            for (int k = 0; k < 4; ++k) w[k] = pk2(lv[8 * j + 2 * k] * rl, lv[8 * j + 2 * k + 1] * rl);
            lp[64 * j] = w; }
    }
}

constexpr int PIECE = 256;
__device__ __forceinline__ unsigned lane_xor1_u(unsigned v) { return (unsigned)__builtin_amdgcn_update_dpp(0, (int)v, 0xB1, 0xF, 0xF, false); }
__device__ __forceinline__ void convert_uv(Frame& F, const Args& A) {
    const int gw = F.vcu * NWAVES + F.wave, NGW = F.G * NWAVES, lane = F.lane;
    f32x4 vn[16];
    if (gw < 2 * NEXP) { const float* src = (gw < NEXP ? A.in[IN_U] + (size_t)gw * DM : A.in[IN_V] + (size_t)(gw - NEXP) * DM) + 4 * lane;
#pragma unroll
        for (int i = 0; i < 16; ++i) vn[i] = *(const f32x4*)(src + 256 * i); }
    for (int r = gw; r < 2 * NEXP; r += NGW) {
        const bool isu = r < NEXP; const int row = isu ? r : r - NEXP;
        f32x4 v[16]; float m = 0.f, ss = 0.f;
#pragma unroll
        for (int i = 0; i < 16; ++i) { const f32x4 x = vn[i]; v[i] = x;
            m = fmaxf(m, fmaxf(fmaxf(fabsf(x.x), fabsf(x.y)), fmaxf(fabsf(x.z), fabsf(x.w)))); ss += (x.x * x.x + x.y * x.y) + (x.z * x.z + x.w * x.w); }
        { const int rn = r + NGW;
          if (rn < 2 * NEXP) { const float* src = (rn < NEXP ? A.in[IN_U] + (size_t)rn * DM : A.in[IN_V] + (size_t)(rn - NEXP) * DM) + 4 * lane;
#pragma unroll
              for (int i = 0; i < 16; ++i) vn[i] = *(const f32x4*)(src + 256 * i); } }
        m = wave_max(m); ss = wave_sum(ss);
        const float rms = sqrtf(ss * (1.f / DM));
        const float step = isu ? fmaxf(fmaxf(0.49f * rms, m * (1.f / 12.f)), 1e-30f) : fmaxf(fmaxf(0.3352f * rms, m * (1.f / 15.f)), 1e-30f), inv = 1.f / step;
        unsigned char* tab = F.ws + (isu ? WS_UB : WS_VB);
        const bool odd = lane & 1;
#pragma unroll
        for (int i = 0; i < 16; ++i) {
            const float xs[4] = {v[i].x * inv, v[i].y * inv, v[i].z * inv, v[i].w * inv};
            unsigned w = 0;
            if (isu) {
#pragma unroll
                for (int k = 0; k < 4; ++k) { const float a = fabsf(xs[k]);
                    const unsigned c = (unsigned)(a > 0.25f) + (unsigned)(a > 0.75f) + (unsigned)(a > 1.25f) + (unsigned)(a > 1.75f) + (unsigned)(a > 2.5f) + (unsigned)(a > 3.5f) + (unsigned)(a > 5.f);
                    w |= (c | (xs[k] < 0.f ? 8u : 0u)) << (4 * k); }
                w = odd ? (w << 16) : w;
            } else {
#pragma unroll
                for (int k = 0; k < 4; ++k) { const unsigned n = (unsigned)min(max((int)floorf(xs[k]) + 8, 0), 15); w |= n << (8 * k); }
                w = odd ? ((w << 4) ^ 0x80808080u) : w;
            }
            w |= lane_xor1_u(w);
            if (!odd) *(unsigned*)(tab + ((size_t)(i >> 1) * NEXP + row) * PIECE + 128 * (i & 1) + 2 * lane) = w;
        }
        if (lane == 0) ((float*)(F.ws + (isu ? WS_SU : WS_SV)))[row] = step;
    }
}

__device__ __forceinline__ int lt_bit(float v, float mid) { return (int)(__float_as_uint(v - mid) >> 31); }
constexpr int CSTR = 17;
#define SKSWZ(row, colB) ((row) * 256 + ((colB) ^ (((row) & 7) << 4)))
__device__ __forceinline__ void topk_unit(Frame& F, const Args& A, int unit) {
    const int h = unit & 7, t0 = (unit >> 3) * 256 + F.wave * 32, lane = F.lane, j = lane & 31, hq = lane >> 5;
    const bf16_t* QP = (const bf16_t*)(F.ws + WS_QP); const bf16_t* SKB = (const bf16_t*)(F.ws + WS_SKB);
    LAS unsigned char* SKL = F.lds;
    LAS u32x2* CAND = (LAS u32x2*)(F.lds + 65536 + F.wave * (32 * 2 * CSTR * 8));
    __syncthreads();
    { const int row = F.tid >> 4, ch = F.tid & 15;
#pragma unroll
      for (int i = 0; i < 8; ++i) { const int rr = row + 32 * i;
          const u32x4 v = *(const u32x4*)(SKB + ((size_t)h * 256 + rr) * 128 + ch * 8);
          *(LAS u32x4*)(SKL + (rr >> 7) * 32768 + SKSWZ(rr & 127, ch * 16)) = v; } }
    __syncthreads();
    float rstd2;
    { const f32x4* sp = (const f32x4*)((const float*)(F.ws + WS_SSQ2) + (size_t)(t0 + j) * 64 + 32 * hq); float s = 0.f;
#pragma unroll
      for (int k = 0; k < 8; ++k) { const f32x4 v = sp[k]; s += (v.x + v.y) + (v.z + v.w); }
      s += __shfl_xor(s, 32);
      rstd2 = 1.f / sqrtf(s * (1.f / DM) + EPS);
      if (h == 0 && hq == 0) ((float*)(F.ws + WS_RSTD2))[t0 + j] = rstd2; }
#pragma nounroll
    for (int p = 0; p < 2; ++p) {
        f32x16 acc[4];
#pragma unroll
        for (int kt = 0; kt < 4; ++kt) acc[kt] = f32x16{};
        const bf16_t* qp = QP + (size_t)(t0 + j) * 2048 + h * 256 + p * 128 + 8 * hq;
        bf16x8 bq[8];
#pragma unroll
        for (int ks = 0; ks < 8; ++ks) bq[ks] = *(const bf16x8*)(qp + 16 * ks);
#pragma unroll
        for (int ks = 0; ks < 8; ++ks) {
#pragma unroll
            for (int kt = 0; kt < 4; ++kt) { const bf16x8 ak = *(const LAS bf16x8*)(SKL + p * 32768 + SKSWZ(32 * kt + j, (16 * ks + 8 * hq) * 2)); acc[kt] = __builtin_amdgcn_mfma_f32_32x32x16_bf16(ak, bq[ks], acc[kt], 0, 0, 0); } }
        float vmx = acc[0][0], vmn = acc[0][0];
#pragma unroll
        for (int kt = 0; kt < 4; ++kt)
#pragma unroll
            for (int r = 0; r < 16; ++r) { vmx = fmaxf(vmx, acc[kt][r]); vmn = fminf(vmn, acc[kt][r]); }
        vmx = fmaxf(vmx, __shfl_xor(vmx, 32)); vmn = fminf(vmn, __shfl_xor(vmn, 32));
        float lo = vmn, hi = vmx + 1.0f, T = vmn; int done = 0;
#pragma nounroll
        for (int iter = 0; iter < 64; ++iter) {
            if (!__any(done == 0)) break;
            const float mid = 0.5f * (lo + hi);
            int c4[4] = {0, 0, 0, 0};
#pragma unroll
            for (int kt = 0; kt < 4; ++kt)
#pragma unroll
                for (int r = 0; r < 16; ++r) c4[kt] += lt_bit(acc[kt][r], mid);
            int c = (c4[0] + c4[1]) + (c4[2] + c4[3]);
            c += __shfl_xor(c, 32); c = NKEYS - c;
            if (done == 0) {
                if (c == PTOPK) { T = mid; done = 1; }
                else if (mid <= lo || mid >= hi) { T = lo; done = 1; }
                else if (c > PTOPK) lo = mid; else hi = mid;
            }
        }
        if (done == 0) T = lo;
        int cm = 0;
#pragma unroll
        for (int kt = 0; kt < 4; ++kt)
#pragma unroll
            for (int r = 0; r < 16; ++r) cm += lt_bit(acc[kt][r], T);
        cm = 64 - cm;
        const int co = __shfl_xor(cm, 32);
        int slot = hq ? co : 0;
        f32x16 rowidx;
        { bf16x8 ac = {0, 0, 0, 0, 0, 0, 0, 0}, bc = {0, 0, 0, 0, 0, 0, 0, 0};
          if (hq == 0) { ac[0] = (short)f2bf((float)j); bc[0] = (short)0x3F80; }
          rowidx = __builtin_amdgcn_mfma_f32_32x32x16_bf16(ac, bc, f32x16{}, 0, 0, 0); }
        LAS u32x2* cb = CAND + (j * 2 + p) * CSTR;
#pragma unroll
        for (int kt = 0; kt < 4; ++kt)
#pragma unroll
            for (int r = 0; r < 16; ++r) { const float v = acc[kt][r];
                const int take = (1 - lt_bit(v, T)) & (int)((unsigned)(slot - PTOPK) >> 31);
                u32x2 w; w.x = __float_as_uint(v); w.y = (unsigned)(32 * kt + (int)rowidx[r]);
                cb[take ? slot : PTOPK] = w; slot += take; }
    }
    LDS_WAIT();
    float sv[16]; int si[16];
    { LAS u32x2* cb = CAND + (j * 2 + hq) * CSTR;
#pragma unroll
      for (int k = 0; k < 16; ++k) { const u32x2 w = cb[k]; sv[k] = __uint_as_float(w.x); si[k] = (int)w.y; } }
#pragma unroll
    for (int k = 2; k <= 16; k <<= 1)
#pragma unroll
        for (int jj = k >> 1; jj > 0; jj >>= 1)
#pragma unroll
            for (int i = 0; i < 16; ++i) { const int l = i ^ jj;
                if (l > i) { const bool desc = ((i & k) == 0); const bool sw = desc ? (sv[i] < sv[l]) : (sv[i] > sv[l]);
                    const float tv = sw ? sv[l] : sv[i], tw = sw ? sv[i] : sv[l]; const int ti = sw ? si[l] : si[i], tj = sw ? si[i] : si[l];
                    sv[i] = tv; sv[l] = tw; si[i] = ti; si[l] = tj; } }
    float s1[16], s2[16]; int i1[16], i2[16];
#pragma unroll
    for (int k = 0; k < 16; ++k) { const float ov = __shfl_xor(sv[k], 32); const int oi = __shfl_xor(si[k], 32);
        s1[k] = hq ? ov : sv[k]; s2[k] = hq ? sv[k] : ov; i1[k] = hq ? oi : si[k]; i2[k] = hq ? si[k] : oi; }
    float cs[50];
    { int q = 0;
#pragma unroll
      for (int a = 0; a < 16; ++a)
#pragma unroll
          for (int b2 = 0; b2 < 16; ++b2) if ((a + 1) * (b2 + 1) <= 16) { cs[q] = s1[a] + s2[b2]; ++q; } }
    float lo = fminf(s1[15] + s2[0], s1[0] + s2[15]), hi = s1[0] + s2[0] + 1.0f, T = lo; int done = 0;
#pragma nounroll
    for (int iter = 0; iter < 64; ++iter) {
        if (!__any(done == 0)) break;
        const float mid = 0.5f * (lo + hi);
        int c4[5] = {0, 0, 0, 0, 0};
#pragma unroll
        for (int q = 0; q < 50; ++q) c4[q % 5] += lt_bit(cs[q], mid);
        const int c = 50 - ((c4[0] + c4[1]) + (c4[2] + c4[3]) + c4[4]);
        if (done == 0) {
            if (c == PTOPK) { T = mid; done = 1; }
            else if (mid <= lo || mid >= hi) { T = lo; done = 1; }
            else if (c > PTOPK) lo = mid; else hi = mid;
        }
    }
    if (done == 0) T = lo;
    LAS u32x2* wb = CAND + (j * 2) * CSTR;
    if (hq == 0) { int slot = 0; int q = 0;
#pragma unroll
        for (int a = 0; a < 16; ++a)
#pragma unroll
            for (int b2 = 0; b2 < 16; ++b2) if ((a + 1) * (b2 + 1) <= 16) {
                const int take = (1 - lt_bit(cs[q], T)) & (int)((unsigned)(slot - PTOPK) >> 31);
                u32x2 w; w.x = __float_as_uint(cs[q]); w.y = (unsigned)(i1[a] * NKEYS + i2[b2]);
                wb[take ? slot : PTOPK] = w; slot += take; ++q; } }
    LDS_WAIT();
    float wv[16]; int wi[16]; float mx = -1e30f;
#pragma unroll
    for (int k = 0; k < 16; ++k) { const u32x2 w = wb[k]; wv[k] = __uint_as_float(w.x); wi[k] = (int)w.y; mx = fmaxf(mx, wv[k]); }
    float se = 0.f;
#pragma unroll
    for (int k = 0; k < 16; ++k) { wv[k] = __expf((wv[k] - mx) * rstd2); se += wv[k]; }
    const float inv = 1.f / se;
    int* IDX = (int*)(F.ws + WS_IDX) + (size_t)(t0 + j) * PE + h * PTOPK + 8 * hq; float* GT = (float*)(F.ws + WS_GATE) + (size_t)(t0 + j) * PE + h * PTOPK + 8 * hq;
    float* SUT = (float*)(F.ws + WS_SUT) + (size_t)(t0 + j) * PE + h * PTOPK + 8 * hq; float* GS = (float*)(F.ws + WS_GS) + (size_t)(t0 + j) * PE + h * PTOPK + 8 * hq;
#pragma unroll
    for (int k = 0; k < 8; ++k) { const int id = hq ? wi[8 + k] : wi[k]; const float gte = (hq ? wv[8 + k] : wv[k]) * inv;
        IDX[k] = id; GT[k] = gte; SUT[k] = ((const float*)(F.ws + WS_SU))[id]; GS[k] = gte * ((const float*)(F.ws + WS_SV))[id]; }
    LDS_WAIT();
}

__device__ __forceinline__ int row_sum16(int v) {
    v += __builtin_amdgcn_update_dpp(0, v, 0xB1, 0xF, 0xF, false);
    v += __builtin_amdgcn_update_dpp(0, v, 0x4E, 0xF, 0xF, false);
    v += __builtin_amdgcn_update_dpp(0, v, 0x141, 0xF, 0xF, false);
    v += __builtin_amdgcn_update_dpp(0, v, 0x128, 0xF, 0xF, false);
    return v;
}
typedef int i32x8 __attribute__((ext_vector_type(8)));
struct PeerUMeta { u32x4 hv; int id0, id1; float rstd2; };
__device__ __forceinline__ void peer_u_meta(Frame& F, int t, int x, PeerUMeta& M) {
    const int lane = F.lane;
    const bf16_t* H1B = (const bf16_t*)(F.ws + WS_XN);
    M.hv = *(const u32x4*)(H1B + (size_t)t * DM + 512 * x + 8 * lane);
    const int* IDX = (const int*)(F.ws + WS_IDX) + (size_t)t * PE;
    M.id0 = IDX[lane]; M.id1 = IDX[64 + lane]; M.rstd2 = ((const float*)(F.ws + WS_RSTD2))[t];
}
__device__ __forceinline__ int wave_sum_i(int v) { v = row_sum16(v); v += __shfl_xor(v, 16); v += __shfl_xor(v, 32); return v; }
__device__ __forceinline__ int row_max16i(int v) {
    v = max(v, __builtin_amdgcn_update_dpp(0, v, 0xB1, 0xF, 0xF, false)); v = max(v, __builtin_amdgcn_update_dpp(0, v, 0x4E, 0xF, 0xF, false));
    v = max(v, __builtin_amdgcn_update_dpp(0, v, 0x141, 0xF, 0xF, false)); v = max(v, __builtin_amdgcn_update_dpp(0, v, 0x128, 0xF, 0xF, false));
    return v;
}
__device__ __forceinline__ float quad_swap1(float v) { return __builtin_bit_cast(float, __builtin_amdgcn_update_dpp(0, __builtin_bit_cast(int, v), 0xB1, 0xF, 0xF, false)); }
#ifndef PROBE_MODE
#define PROBE_MODE 0
#endif
__device__ __forceinline__ float quad_swap2(float v) { return __builtin_bit_cast(float, __builtin_amdgcn_update_dpp(0, __builtin_bit_cast(int, v), 0x4E, 0xF, 0xF, false)); }
__device__ __forceinline__ float row_ror4(float v) { return __builtin_bit_cast(float, __builtin_amdgcn_update_dpp(0, __builtin_bit_cast(int, v), 0x124, 0xF, 0xF, false)); }
__device__ __forceinline__ void peer_u_issue(const unsigned char* UBs, int idv, int lane, u32x4 (&w)[16]) {
    const int ei = lane & 15, gk = lane >> 4, r4 = ei >> 2, quarter = ei & 3;
#pragma unroll
    for (int b = 0; b < 16; ++b) { const int row = __builtin_amdgcn_ds_bpermute((16 * r4 + b) * 4, idv);
        w[b] = *(const u32x4*)(UBs + (((unsigned)row << 8) + 64u * (unsigned)gk + 16u * (unsigned)quarter)); }
}
__device__ __forceinline__ float sel4(float a, float b, float c, float d, unsigned m0, unsigned m1, unsigned m2, unsigned m3) {
    return __builtin_bit_cast(float, (__builtin_bit_cast(unsigned, a) & m0) | (__builtin_bit_cast(unsigned, b) & m1) | (__builtin_bit_cast(unsigned, c) & m2) | (__builtin_bit_cast(unsigned, d) & m3)); }
__device__ __forceinline__ void peer_u_consume(const u32x4 (&w)[16], const i32x8& B, int lane, unsigned m0, unsigned m1, unsigned m2, unsigned m3, float& keep) {
    const int ei = lane & 15; const bool q1 = (lane >> 1) & 1, q2 = (lane >> 2) & 1;
#pragma unroll
    for (int b0 = 0; b0 < 16; b0 += 4) {
        f32x4 D[4];
#pragma unroll
        for (int k = 0; k < 4; ++k) { const f32x4 z = {0.f, 0.f, 0.f, 0.f};
            const i32x8 a = {(int)w[b0 + k].x, (int)w[b0 + k].y, (int)w[b0 + k].z, (int)w[b0 + k].w, 0, 0, 0, 0};
            D[k] = __builtin_amdgcn_mfma_scale_f32_16x16x128_f8f6f4(a, B, z, 4, 0, 0, 0x7f7f7f7f, 0, 0x7f7f7f7f); }
        __builtin_amdgcn_sched_barrier(0);
        float v[4];
#pragma unroll
        for (int k = 0; k < 4; ++k) { const float lo = q1 ? D[k].y : D[k].x, hi = q1 ? D[k].w : D[k].z; v[k] = q2 ? hi : lo; }
#pragma unroll
        for (int k = 0; k < 4; ++k) v[k] += quad_swap1(v[k]);
#pragma unroll
        for (int k = 0; k < 4; ++k) v[k] += quad_swap2(v[k]);
#pragma unroll
        for (int k = 0; k < 4; ++k) v[k] += row_ror4(v[k]);
#pragma unroll
        for (int k = 0; k < 4; ++k) keep = (ei == b0 + k) ? v[k] : keep;
    }
}
__device__ __forceinline__ float peer_u_xquant(Frame& F, const PeerUMeta& M, const float (&g2s)[8], i32x8& B) {
    const int lane = F.lane, ei = lane & 15, g = lane >> 4, qn = (ei >> 1) & 3;
    LAS unsigned char* XB = F.lds + F.wave * 1024;
    float xf[8];
    { const float rs = M.rstd2; const u32x4 hv = M.hv;
      xf[0] = bflo(hv.x) * rs * g2s[0]; xf[1] = bfhi(hv.x) * rs * g2s[1]; xf[2] = bflo(hv.y) * rs * g2s[2]; xf[3] = bfhi(hv.y) * rs * g2s[3];
      xf[4] = bflo(hv.z) * rs * g2s[4]; xf[5] = bfhi(hv.z) * rs * g2s[5]; xf[6] = bflo(hv.w) * rs * g2s[6]; xf[7] = bfhi(hv.w) * rs * g2s[7]; }
    float m = 0.f;
#pragma unroll
    for (int i = 0; i < 8; ++i) m = fmaxf(m, fabsf(xf[i]));
    int mi = row_max16i(__builtin_bit_cast(int, m)); mi = max(mi, __shfl_xor(mi, 16)); mi = max(mi, __shfl_xor(mi, 32));
    m = fmaxf(__builtin_bit_cast(float, mi), 1e-30f); const float sx = m * (1.f / 224.f), inv = 224.f * __builtin_amdgcn_rcpf(m);
    { u32x2 hi, lo;
#pragma unroll
      for (int d = 0; d < 2; ++d) { const float a0 = xf[4 * d] * inv, a1 = xf[4 * d + 1] * inv, a2 = xf[4 * d + 2] * inv, a3 = xf[4 * d + 3] * inv;
          int h = __builtin_amdgcn_cvt_pk_fp8_f32(a0, a1, 0, false); h = __builtin_amdgcn_cvt_pk_fp8_f32(a2, a3, h, true);
          const f32x2 b01 = __builtin_amdgcn_cvt_pk_f32_fp8(h, false), b23 = __builtin_amdgcn_cvt_pk_f32_fp8(h, true);
          int l = __builtin_amdgcn_cvt_pk_fp8_f32(a0 - b01.x, a1 - b01.y, 0, false); l = __builtin_amdgcn_cvt_pk_fp8_f32(a2 - b23.x, a3 - b23.y, l, true);
          hi[d] = (unsigned)h; lo[d] = (unsigned)l; }
      *(LAS u32x2*)(XB + 8 * lane) = hi; *(LAS u32x2*)(XB + 512 + 8 * lane) = lo; }
    LDS_WAIT();
    { LAS const unsigned char* p = XB + ((ei & 1) ? 512 : 0) + 128 * (g >> 1) + 32 * qn + 16 * (g & 1);
      const u32x4 b0 = *(LAS const u32x4*)p, b1 = *(LAS const u32x4*)(p + 256);
      B = i32x8{(int)b0.x, (int)b0.y, (int)b0.z, (int)b0.w, (int)b1.x, (int)b1.y, (int)b1.z, (int)b1.w}; }
    LDS_WAIT();
    return sx;
}
__device__ __forceinline__ void peer_u_meta_async(Frame& F, int t, int x, PeerUMeta& M) {
    const int lane = F.lane;
    const bf16_t* hp = (const bf16_t*)(F.ws + WS_XN) + (size_t)t * DM + 512 * x + 8 * lane;
    const int* ip = (const int*)(F.ws + WS_IDX) + (size_t)t * PE + lane; const float* rp = (const float*)(F.ws + WS_RSTD2) + t;
    asm volatile("global_load_dwordx4 %0, %1, off" : "=v"(M.hv) : "v"(hp) : "memory");
    asm volatile("global_load_dword %0, %1, off" : "=v"(M.id0) : "v"(ip) : "memory");
    asm volatile("global_load_dword %0, %1, off offset:256" : "=v"(M.id1) : "v"(ip) : "memory");
    asm volatile("global_load_dword %0, %1, off" : "=v"(M.rstd2) : "v"(rp) : "memory");
}
template <bool DRY> __device__ __forceinline__ void peer_u_loop(Frame& F, int x, int tb, int tstep, const float (&g2s)[8]) {
    const int lane = F.lane;
    const unsigned char* UBs = F.ws + WS_UB + (size_t)x * NEXP * PIECE;
    PeerUMeta M, Mn, Mn2;
    peer_u_meta(F, tb, x, M); peer_u_meta(F, tb + tstep, x, Mn); Mn2 = Mn;
    u32x4 wA[16], wB[16];
    peer_u_issue(UBs, M.id0, lane, wA);
    unsigned m0, m1, m2, m3; { const int qn = (lane >> 1) & 3; m0 = qn == 0 ? ~0u : 0u; m1 = qn == 1 ? ~0u : 0u; m2 = qn == 2 ? ~0u : 0u; m3 = qn == 3 ? ~0u : 0u; asm volatile("" : "+v"(m0), "+v"(m1), "+v"(m2), "+v"(m3)); }
    i32x8 B, Bn; float sx = peer_u_xquant(F, M, g2s, B), sxn = sx; Bn = B;
#pragma nounroll
    for (int t = tb; t < MR; t += tstep) {
        if (t + 2 * tstep < MR) peer_u_meta_async(F, t + 2 * tstep, x, Mn2);
        float keep0 = 0.f, keep1 = 0.f;
        peer_u_issue(UBs, M.id1, lane, wB);
        __builtin_amdgcn_sched_barrier(0);
        peer_u_consume(wA, B, lane, m0, m1, m2, m3, keep0);
        __builtin_amdgcn_sched_barrier(0);
        if (t + tstep < MR) { peer_u_issue(UBs, Mn.id0, lane, wA); __builtin_amdgcn_sched_barrier(0); sxn = peer_u_xquant(F, Mn, g2s, Bn); }
        __builtin_amdgcn_sched_barrier(0);
        peer_u_consume(wB, B, lane, m0, m1, m2, m3, keep1);
        __builtin_amdgcn_sched_barrier(0);
        if constexpr (!DRY) { float* pa = (float*)(F.ws + WS_PACT) + ((size_t)t * 8 + x) * PE;
            pa[lane] = keep0 * sx; pa[64 + lane] = keep1 * sx; }
        else asm volatile("" :: "v"(keep0), "v"(keep1));
        asm volatile("" : "+v"(Mn2.hv), "+v"(Mn2.id0), "+v"(Mn2.id1), "+v"(Mn2.rstd2));
        M = Mn; Mn = Mn2; B = Bn; sx = sxn;
    }
}
typedef int i32x4 __attribute__((ext_vector_type(4)));
struct PeerVRest { unsigned wdw; float sw; int qw; u32x4 hv; };
struct PeerVIds { int id0, id1; };
__device__ __forceinline__ void peer_v_ids(Frame& F, int t, PeerVIds& I) { const int* IDX = (const int*)(F.ws + WS_IDX) + (size_t)t * PE; I.id0 = IDX[F.lane]; I.id1 = IDX[64 + F.lane]; }
__device__ __forceinline__ void peer_v_rest(Frame& F, int t, int x, PeerVRest& R) {
    const int lane = F.lane, r = lane >> 4, sp = lane & 15;
    R.wdw = ((const unsigned*)(F.ws + WS_WQ))[(size_t)t * 32 + (lane & 31)];
    const u32x2 sq = ((const u32x2*)(F.ws + WS_SWQ))[t]; R.sw = __builtin_bit_cast(float, sq.x); R.qw = (int)sq.y;
    R.hv = *(const u32x4*)((const bf16_t*)(F.ws + WS_XN) + (size_t)t * DM + 512 * x + 32 * sp + 8 * r);
}
__device__ __forceinline__ void peer_v_ids_async(Frame& F, int t, PeerVIds& I) {
    const int* ip = (const int*)(F.ws + WS_IDX) + (size_t)t * PE + F.lane;
    asm volatile("global_load_dword %0, %1, off" : "=v"(I.id0) : "v"(ip) : "memory");
    asm volatile("global_load_dword %0, %1, off offset:256" : "=v"(I.id1) : "v"(ip) : "memory");
}
__device__ __forceinline__ void peer_v_rest_async(Frame& F, int t, int x, PeerVRest& R) {
    const int lane = F.lane, r = lane >> 4, sp = lane & 15;
    const unsigned* wp = (const unsigned*)(F.ws + WS_WQ) + (size_t)t * 32 + (lane & 31);
    const unsigned* qp = (const unsigned*)(F.ws + WS_SWQ) + (size_t)t * 2;
    const bf16_t* hp = (const bf16_t*)(F.ws + WS_XN) + (size_t)t * DM + 512 * x + 32 * sp + 8 * r;
    asm volatile("global_load_dword %0, %1, off" : "=v"(R.wdw) : "v"(wp) : "memory");
    asm volatile("global_load_dword %0, %1, off" : "=v"(R.sw) : "v"(qp) : "memory");
    asm volatile("global_load_dword %0, %1, off offset:4" : "=v"(R.qw) : "v"(qp) : "memory");
    asm volatile("global_load_dwordx4 %0, %1, off" : "=v"(R.hv) : "v"(hp) : "memory");
}
__device__ __forceinline__ void peer_v_pin(PeerVRest& R) { asm volatile("" : "+v"(R.wdw), "+v"(R.sw), "+v"(R.qw), "+v"(R.hv)); }
__device__ __forceinline__ void peer_v_prologue(Frame& F, const PeerVRest& R, float& sw, int& qw) {
    LAS unsigned* QW8 = (LAS unsigned*)(F.lds + F.wave * 256);
    if (F.lane < 32) QW8[F.lane] = R.wdw;
    sw = R.sw; qw = R.qw;
    LDS_WAIT();
}
__device__ __forceinline__ void peer_w_pass(Frame& F) {
    const int gw = F.vcu * NWAVES + F.wave, NGW = F.G * NWAVES, lane = F.lane;
    for (int t = gw; t < MR; t += NGW) {
        const float* SUT = (const float*)(F.ws + WS_SUT) + (size_t)t * PE; const float* GS = (const float*)(F.ws + WS_GS) + (size_t)t * PE;
        const float su0 = SUT[lane], su1 = SUT[64 + lane], gs0 = GS[lane], gs1 = GS[64 + lane];
        const float* pa = (const float*)(F.ws + WS_PACT) + (size_t)t * 8 * PE;
        float a0 = 0.f, a1 = 0.f;
#pragma unroll
        for (int xx = 0; xx < 8; ++xx) { a0 += pa[xx * PE + lane]; a1 += pa[xx * PE + 64 + lane]; }
        const float w0 = gs0 * gelu_tanh(a0 * su0), w1 = gs1 * gelu_tanh(a1 * su1);
        int wmi = row_max16i(__builtin_bit_cast(int, fmaxf(fabsf(w0), fabsf(w1)))); wmi = max(wmi, __shfl_xor(wmi, 16)); wmi = max(wmi, __shfl_xor(wmi, 32));
        const float wm = fmaxf(__builtin_bit_cast(float, wmi), 1e-30f); const float sw = wm * (1.f / 127.f), winv = 127.f * __builtin_amdgcn_rcpf(wm);
        const int q0 = max(min((int)__builtin_rintf(w0 * winv), 127), -127), q1 = max(min((int)__builtin_rintf(w1 * winv), 127), -127);
        const int qw = wave_sum_i(q0 + q1);
        unsigned char* WQ = F.ws + WS_WQ + (size_t)t * 128;
        WQ[((lane >> 4) * 4 + (lane & 3)) * 4 + ((lane >> 2) & 3)] = (unsigned char)(q0 & 0xff);
        WQ[(((64 + lane) >> 4) * 4 + (lane & 3)) * 4 + ((lane >> 2) & 3)] = (unsigned char)(q1 & 0xff);
        if (lane == 0) { u32x2 sq; sq.x = __builtin_bit_cast(unsigned, sw); sq.y = (unsigned)qw; ((u32x2*)(F.ws + WS_SWQ))[t] = sq; }
    }
}
template <bool DRY> __device__ __forceinline__ void peer_v_issue4(const unsigned char* VBs, int idv, int lane, int gg, u32x4 (&w)[16]) {
    const int r = lane >> 4, sp = lane & 15;
#pragma unroll
    for (int k = 0; k < 4; ++k) { const int q = 4 * gg + k; const int row = __builtin_amdgcn_ds_bpermute((4 * q + r) * 4, idv);
#if PROBE_MODE == 1
        if constexpr (DRY) { const unsigned ur = (unsigned)row + r; w[q] = u32x4{ur, ur * 3u, ur * 5u, ur * 7u}; } else
#endif
        w[q] = *(const u32x4*)(VBs + (((unsigned)row << 8) + 16u * (unsigned)sp)); }
}
template <bool DRY> __device__ __forceinline__ void peer_v_round(Frame& F, const unsigned char* VBs, u32x4 (&w)[16], int h, int idv_next, int lane, const unsigned (&sel)[4], i32x4 (&Dl)[4], i32x4 (&Dh)[4]) {
    const int r = lane >> 4;
    LAS const unsigned char* QW8 = F.lds + F.wave * 256;
#pragma unroll
    for (int gg = 0; gg < 4; ++gg) {
        i32x4 blo[4], bhi[4];
#pragma unroll
        for (int j = 0; j < 4; ++j) {
            blo[j] = i32x4{(int)(w[4 * gg][j] & 0x0F0F0F0Fu), (int)(w[4 * gg + 1][j] & 0x0F0F0F0Fu), (int)(w[4 * gg + 2][j] & 0x0F0F0F0Fu), (int)(w[4 * gg + 3][j] & 0x0F0F0F0Fu)};
            bhi[j] = i32x4{(int)(w[4 * gg][j] & 0xF0F0F0F0u), (int)(w[4 * gg + 1][j] & 0xF0F0F0F0u), (int)(w[4 * gg + 2][j] & 0xF0F0F0F0u), (int)(w[4 * gg + 3][j] & 0xF0F0F0F0u)}; }
        __builtin_amdgcn_sched_barrier(0);
        peer_v_issue4<DRY>(VBs, idv_next, lane, gg, w);
        __builtin_amdgcn_sched_barrier(0);
#if PROBE_MODE == 2
        if constexpr (DRY) { _Pragma("unroll") for (int j = 0; j < 4; ++j) { Dl[j].x ^= blo[j].x ^ blo[j].y ^ blo[j].z ^ blo[j].w; Dh[j].x ^= bhi[j].x ^ bhi[j].y ^ bhi[j].z ^ bhi[j].w; } continue; }
#endif
        const unsigned wpk = *(const LAS unsigned*)(QW8 + ((4 * h + gg) * 4 + r) * 4);
        const i32x4 a = {(int)__builtin_amdgcn_perm(wpk, wpk, sel[0]), (int)__builtin_amdgcn_perm(wpk, wpk, sel[1]), (int)__builtin_amdgcn_perm(wpk, wpk, sel[2]), (int)__builtin_amdgcn_perm(wpk, wpk, sel[3])};
#pragma unroll
        for (int j = 0; j < 4; ++j) { Dl[j] = __builtin_amdgcn_mfma_i32_16x16x64_i8(a, blo[j], Dl[j], 0, 0, 0); Dh[j] = __builtin_amdgcn_mfma_i32_16x16x64_i8(a, bhi[j], Dh[j], 0, 0, 0); }
        __builtin_amdgcn_sched_barrier(0);
    }
}
__device__ __forceinline__ int sel4i(int a, int b, int c, int d, unsigned m0, unsigned m1, unsigned m2, unsigned m3) { return (int)(((unsigned)a & m0) | ((unsigned)b & m1) | ((unsigned)c & m2) | ((unsigned)d & m3)); }
template <bool DRY> __device__ __forceinline__ void peer_v_loop(Frame& F, int x, int tb, int tstep) {
    const int lane = F.lane, r = lane >> 4, sp = lane & 15;
    const unsigned char* VBs = F.ws + WS_VB + (size_t)x * NEXP * PIECE;
    unsigned sel[4];
#pragma unroll
    for (int e = 0; e < 4; ++e) sel[e] = (0x0C0C0C0Cu & ~(0xFFu << (8 * (lane & 3)))) | ((unsigned)e << (8 * (lane & 3)));
    unsigned m0 = r == 0 ? ~0u : 0u, m1 = r == 1 ? ~0u : 0u, m2 = r == 2 ? ~0u : 0u, m3 = r == 3 ? ~0u : 0u;
    asm volatile("" : "+v"(m0), "+v"(m1), "+v"(m2), "+v"(m3));
    PeerVIds I, In, I2; PeerVRest R, Rn;
    peer_v_ids(F, tb, I); peer_v_ids(F, tb + tstep, In); I2 = In;
    peer_v_rest(F, tb, x, R); Rn = R;
    u32x4 w[16];
#pragma unroll
    for (int gg = 0; gg < 4; ++gg) peer_v_issue4<DRY>(VBs, I.id0, lane, gg, w);
    float sw; int qw; u32x4 hv = R.hv;
    peer_v_prologue(F, R, sw, qw);
#pragma nounroll
    for (int t = tb; t < MR; t += tstep) {
        const bool more = t + tstep < MR;
        if (more) peer_v_rest_async(F, t + tstep, x, Rn);
        if (t + 2 * tstep < MR) peer_v_ids_async(F, t + 2 * tstep, I2);
        i32x4 Dl[4], Dh[4];
#pragma unroll
        for (int j = 0; j < 4; ++j) { Dl[j] = i32x4{0, 0, 0, 0}; Dh[j] = i32x4{0, 0, 0, 0}; }
        peer_v_round<DRY>(F, VBs, w, 0, I.id1, lane, sel, Dl, Dh);
        peer_v_round<DRY>(F, VBs, w, 1, In.id0, lane, sel, Dl, Dh);
        if constexpr (!DRY) {
            int a8[8];
            a8[0] = sel4i(Dl[0].x, Dl[1].x, Dl[2].x, Dl[3].x, m0, m1, m2, m3); a8[1] = sel4i(Dl[0].y, Dl[1].y, Dl[2].y, Dl[3].y, m0, m1, m2, m3);
            a8[2] = sel4i(Dl[0].z, Dl[1].z, Dl[2].z, Dl[3].z, m0, m1, m2, m3); a8[3] = sel4i(Dl[0].w, Dl[1].w, Dl[2].w, Dl[3].w, m0, m1, m2, m3);
            a8[4] = sel4i(Dh[0].x, Dh[1].x, Dh[2].x, Dh[3].x, m0, m1, m2, m3); a8[5] = sel4i(Dh[0].y, Dh[1].y, Dh[2].y, Dh[3].y, m0, m1, m2, m3);
            a8[6] = sel4i(Dh[0].z, Dh[1].z, Dh[2].z, Dh[3].z, m0, m1, m2, m3); a8[7] = sel4i(Dh[0].w, Dh[1].w, Dh[2].w, Dh[3].w, m0, m1, m2, m3);
            const float c75 = 7.5f * (float)qw, c05 = 0.5f * (float)qw;
            f32x4 o0, o1;
            o0.x = bflo(hv.x) + sw * ((float)a8[0] - c75); o0.y = bfhi(hv.x) + sw * ((float)a8[1] - c75); o0.z = bflo(hv.y) + sw * ((float)a8[2] - c75); o0.w = bfhi(hv.y) + sw * ((float)a8[3] - c75);
            o1.x = bflo(hv.z) + sw * ((float)(a8[4] >> 4) + c05); o1.y = bfhi(hv.z) + sw * ((float)(a8[5] >> 4) + c05); o1.z = bflo(hv.w) + sw * ((float)(a8[6] >> 4) + c05); o1.w = bfhi(hv.w) + sw * ((float)(a8[7] >> 4) + c05);
            float* op = F.out + (size_t)t * DM + 512 * x + 32 * sp + 8 * r;
            __builtin_nontemporal_store(o0, (f32x4*)op); __builtin_nontemporal_store(o1, (f32x4*)(op + 4));
        } else { _Pragma("unroll") for (int j = 0; j < 4; ++j) asm volatile("" :: "v"(Dl[j]), "v"(Dh[j])); }
        if (more) { peer_v_pin(Rn); hv = Rn.hv; peer_v_prologue(F, Rn, sw, qw); }
        asm volatile("" : "+v"(I2.id0), "+v"(I2.id1));
        I = In; In = I2;
    }
}

template <int ONLY> __global__ void __launch_bounds__(NWAVES * 64, 2) mega(Args args) {
    extern __shared__ __attribute__((aligned(16))) unsigned char lds[];
    Frame F;
    F.lds = (LAS unsigned char*)lds; F.ldsg = (char*)lds;
    F.tid = threadIdx.x; F.lane = F.tid & 63; F.wave = __builtin_amdgcn_readfirstlane(F.tid >> 6);
    F.G = gridDim.x; { const int bx = blockIdx.x; F.vcu = (F.G % 8 == 0) ? (bx % 8) * (F.G / 8) + bx / 8 : bx; }
    F.out = args.out; F.ws = args.ws;
    const int lo = args.ph_lo, hi = args.ph_hi;
#define IN(k) ((ONLY < 0 || ONLY == (k)) && lo <= (k) && (k) < hi)
    XcdBarrier bar; bar.bar = nullptr; bar.x = 0; bar.st = nullptr;
    if constexpr (ONLY < 0) {
        volatile LAS unsigned* MISC = (volatile LAS unsigned*)(F.lds + LDS_MISC);
        if (F.tid < 64) MISC[F.tid] = 0u;
        __syncthreads();
        bar = xcd_barrier_post((unsigned*)(F.ws + WS_CTL) + 4096, MISC + 8);
    }
#ifndef PROBE_REPEAT
#define PROBE_REPEAT 0
#endif
#define NREP(k) (((PROBE_REPEAT >> (k)) & 1) ? 2 : 1)
#define SEAM(k) do { if constexpr (ONLY < 0) { if (IN(k) && IN((k) + 1)) xcd_barrier(bar); } } while (0)

    if (IN(0)) { for (int rep = 0; rep < NREP(0); ++rep) { p0_prologue(F, args); if (rep + 1 < NREP(0)) xcd_barrier(bar); } }
    SEAM(0);
    if (IN(1)) for (int rep = 0; rep < NREP(1); ++rep) {
        if (rep) xcd_barrier(bar);
        p1_meta_gemm(F, args);
        pg8::Gemm g{(const bf16_t*)(F.ws + WS_XN), (const bf16_t*)(F.ws + WS_WT1), MR, INC, DM}; pg8::StaticOrder S; S.init(MR, INC, F.G, (int)blockIdx.x);
        pg8::EpiBf16 E{(bf16_t*)(F.ws + WS_Z), INC};
        pg8::gemm_phase<pg8::EpiBf16>(F.lds, g, S, E);
    }
    SEAM(1);
    if (IN(2)) {
        for (int rep = 0; rep < NREP(2); ++rep) { if (rep) xcd_barrier(bar); for (int u = F.vcu; u < 256; u += F.G) { if (u & 1) scan_unit<1>(F, args, u); else scan_unit<0>(F, args, u); } }
        normrope_rows(F, args);
    }
    SEAM(2);
    if (IN(3)) for (int rep = 0; rep < NREP(3); ++rep) {
        if (rep) xcd_barrier(bar);
        const bf16_t* Z = (const bf16_t*)(F.ws + WS_Z); const bf16_t* KP = (const bf16_t*)(F.ws + WS_KP); const bf16_t* VP = (const bf16_t*)(F.ws + WS_VP); bf16_t* MRG = (bf16_t*)(F.ws + WS_MRG);
        for (int u = F.vcu; u < NB * NQ * (SEQ / 256); u += F.G) {
            const int grp = u >> 6, within = u & 63, b = grp >> 2, kvh = grp & 3, hq = within >> 4, qb = within & 15, h = kvh * 4 + hq;
            att::attn_unit(Z + (size_t)(b * SEQ + qb * 256) * INC + h * HD, KP + (size_t)(b * NKV + kvh) * KPAD * HD, VP + (size_t)(b * NKV + kvh) * KPAD * HD,
                           MRG + (size_t)(b * SEQ + qb * 256) * DM + h * HD, F.ldsg, qb * 256, args.in[IN_QG], (const f32x2*)(F.ws + WS_ROPE));
        }
    }
    SEAM(3);
    if (IN(4)) { combine_rows(F, args); }
    SEAM(4);
    if (IN(5)) for (int rep = 0; rep < NREP(5); ++rep) {
        if (rep) xcd_barrier(bar);
        pg8::Gemm g{(const bf16_t*)(F.ws + WS_MRG), (const bf16_t*)(F.ws + WS_WT2), MR, DM, DM}; pg8::StaticOrder S; S.init(MR, DM, F.G, (int)blockIdx.x);
        pg8::EpiResid E{args.in[IN_X], F.out, (bf16_t*)(F.ws + WS_XN), (float*)(F.ws + WS_SSQ2), DM};
        pg8::gemm_phase<pg8::EpiResid>(F.lds, g, S, E);
    }
    SEAM(5);
    if (IN(6)) for (int rep = 0; rep < NREP(6); ++rep) {
        if (rep) xcd_barrier(bar);
        convert_uv(F, args);
        pg8::Gemm g{(const bf16_t*)(F.ws + WS_XN), (const bf16_t*)(F.ws + WS_WT3), MR, 2048, DM}; pg8::StaticOrder S; S.init(MR, 2048, F.G, (int)blockIdx.x);
        pg8::EpiBf16 E{(bf16_t*)(F.ws + WS_QP), 2048};
        pg8::gemm_phase<pg8::EpiBf16>(F.lds, g, S, E);
    }
    SEAM(6);
    if (IN(7)) { for (int rep = 0; rep < NREP(7); ++rep) { if (rep) xcd_barrier(bar); for (int u = F.vcu; u < MR / 32; u += F.G) topk_unit(F, args, u); } }
    SEAM(7);
    if (IN(8)) {
        const int x = (int)blockIdx.x & 7, y = (int)blockIdx.x >> 3, ny = F.G >> 3;
        float g2s[8];
#pragma unroll
        for (int i = 0; i < 8; ++i) g2s[i] = args.in[IN_G2][512 * x + 8 * F.lane + i];
        const int tstep = ny * NWAVES;
        if (NREP(8) == 2) { peer_u_loop<true>(F, x, y * NWAVES + F.wave, tstep, g2s); xcd_barrier(bar); }
        peer_u_loop<false>(F, x, y * NWAVES + F.wave, tstep, g2s);
    }
    SEAM(8);
    if (IN(9)) { for (int rep = 0; rep < NREP(9); ++rep) { if (rep) xcd_barrier(bar); peer_w_pass(F); } }
    SEAM(9);
    if (IN(10)) {
        const int x = (int)blockIdx.x & 7, y = (int)blockIdx.x >> 3, ny = F.G >> 3; const int tstep = ny * NWAVES;
        if (NREP(10) == 2) { peer_v_loop<true>(F, x, y * NWAVES + F.wave, tstep); xcd_barrier(bar); }
        peer_v_loop<false>(F, x, y * NWAVES + F.wave, tstep);
    }
#undef IN
#undef SEAM
}

template <int P> static void launch_phase(int grid, hipStream_t stream, Args a) {
    static bool attr = false;
    if (!attr) { if (hipFuncSetAttribute((const void*)mega<P>, hipFuncAttributeMaxDynamicSharedMemorySize, LDS_BYTES) != hipSuccess) fprintf(stderr, "hipFuncSetAttribute failed (phase %d)\n", P); attr = true; }
    a.ph_lo = P; a.ph_hi = P + 1;
    hipLaunchKernelGGL(mega<P>, dim3(grid), dim3(NWAVES * 64), LDS_BYTES, stream, a);
}
extern "C" void kernel_launch(void* const* d_in, const int* in_sizes, int n_in, void* d_out, int out_size, void* d_ws, size_t ws_size, hipStream_t stream) {
    static int grid = 0;
    if (grid == 0) {
        if (n_in != 21 || out_size != MR * DM || ws_size < WS_END) { fprintf(stderr, "kernel_launch: unexpected shapes n_in %d out %d ws %zu\n", n_in, out_size, ws_size); grid = -1; return; }
        int dev = 0, cus = 0;
        (void)hipGetDevice(&dev); (void)hipDeviceGetAttribute(&cus, hipDeviceAttributeMultiprocessorCount, dev);
        grid = (cus / 8) * 8;
        if (grid < 8) { fprintf(stderr, "kernel_launch: device with %d CUs not supported\n", cus); grid = -1; return; }
#if N_LAUNCH_MODE == 1
        int per_cu = 0;
        if (hipFuncSetAttribute((const void*)mega<-1>, hipFuncAttributeMaxDynamicSharedMemorySize, LDS_BYTES) != hipSuccess) { fprintf(stderr, "kernel_launch: hipFuncSetAttribute failed\n"); grid = -1; return; }
        if (hipOccupancyMaxActiveBlocksPerMultiprocessor(&per_cu, (const void*)mega<-1>, NWAVES * 64, LDS_BYTES) != hipSuccess || per_cu < 1) { fprintf(stderr, "kernel_launch: occupancy query %d\n", per_cu); grid = -1; return; }
        (void)hipGetLastError();
#endif
    }
    if (grid < 0) return;
    Args a{};
    for (int i = 0; i < 21; ++i) a.in[i] = (const float*)d_in[i];
    a.out = (float*)d_out; a.ws = (unsigned char*)d_ws;
#if N_LAUNCH_MODE == 0
    launch_phase<0>(grid, stream, a); launch_phase<1>(grid, stream, a); launch_phase<2>(grid, stream, a); launch_phase<3>(grid, stream, a); launch_phase<4>(grid, stream, a);
    launch_phase<5>(grid, stream, a); launch_phase<6>(grid, stream, a); launch_phase<7>(grid, stream, a); launch_phase<8>(grid, stream, a); launch_phase<9>(grid, stream, a); launch_phase<10>(grid, stream, a);
#else
    if (hipMemsetAsync((char*)d_ws + WS_CTL, 0, 65536, stream) != hipSuccess) { fprintf(stderr, "kernel_launch: memset failed\n"); return; }
    a.ph_lo = 0; a.ph_hi = NPHASE;
    void* kargs[] = {&a};
    hipError_t e = hipLaunchCooperativeKernel((const void*)mega<-1>, dim3(grid), dim3(NWAVES * 64), kargs, LDS_BYTES, stream);
    if (e != hipSuccess) fprintf(stderr, "cooperative launch failed: %s (grid %d)\n", hipGetErrorString(e), grid);
#endif
    const hipError_t le = hipPeekAtLastError();
    if (le != hipSuccess) fprintf(stderr, "kernel_launch: launch failed: %s\n", hipGetErrorName(le));
}
```

```cpp
#include <hip/hip_runtime.h>
#include <hip/hip_cooperative_groups.h>
#include <cstdio>
#include <cstdint>
namespace cg = cooperative_groups;

#ifndef N_LAUNCH_MODE
#define N_LAUNCH_MODE 1
#endif

#define GAS __attribute__((address_space(1)))
#define LAS __attribute__((address_space(3)))
typedef unsigned short bf16_t;
typedef short bf16x8 __attribute__((ext_vector_type(8)));
typedef short s16x4 __attribute__((ext_vector_type(4)));
typedef float f32x2 __attribute__((ext_vector_type(2)));
typedef float f32x4 __attribute__((ext_vector_type(4)));
typedef float f32x16 __attribute__((ext_vector_type(16)));
typedef unsigned u32x2 __attribute__((ext_vector_type(2)));
typedef unsigned u32x4 __attribute__((ext_vector_type(4)));
typedef __bf16 bf16x2 __attribute__((ext_vector_type(2)));

constexpr int DM = 4096, NB = 4, SEQ = 4096, NMETA = 16, LTOT = SEQ + NMETA;
constexpr int MR = NB * SEQ;
constexpr int INC = 7168, OFF_K = 2048, OFF_V = 2560, OFF_X = 3072, OFF_Y = 5120;
constexpr int HD = 128, NQ = 16, NKV = 4, DATT = 2048, DRNN = 2048;
constexpr int KPAD = 4224;
constexpr int NT_REAL = 64;
constexpr int PH = 8, NKEYS = 128, PDQ = 256, PTOPK = 16, PE = 128, NEXP = 16384;
constexpr float EPS = 1e-6f;

constexpr size_t MiB = 1u << 20;
constexpr size_t WS_CTL = 0;
constexpr size_t WS_ROPE = 1 * MiB;
constexpr size_t WS_RSTD2 = 1 * MiB + 65536;
constexpr size_t WS_SU = 1 * MiB + 131072;
constexpr size_t WS_SV = 1 * MiB + 196608;
constexpr size_t WS_SKB = 2 * MiB;
constexpr size_t WS_ZM = 2 * MiB + 524288;
constexpr size_t WS_WG = 3 * MiB;
constexpr size_t WS_WT1 = 5 * MiB;
constexpr size_t WS_WT2 = 61 * MiB;
constexpr size_t WS_WT3 = 93 * MiB;
constexpr size_t WS_XN = 109 * MiB;
constexpr size_t WS_KP = 238 * MiB;
constexpr size_t WS_VP = 255 * MiB;
constexpr size_t WS_MRG = 272 * MiB;
constexpr size_t WS_SSQ2 = 400 * MiB;
constexpr size_t WS_IDX = 404 * MiB;
constexpr size_t WS_GATE = 412 * MiB;
constexpr size_t WS_QP = 420 * MiB;
constexpr size_t WS_Z = 484 * MiB;
constexpr size_t WS_HF = 708 * MiB;
constexpr size_t WS_HB = 772 * MiB;
constexpr size_t WS_UB = 484 * MiB;
constexpr size_t WS_VB = 516 * MiB;
constexpr size_t WS_SUT = 336 * MiB;
constexpr size_t WS_GS = 344 * MiB;
constexpr size_t WS_PACT = 272 * MiB;
constexpr size_t WS_WQ = 352 * MiB;
constexpr size_t WS_SWQ = 354 * MiB;
constexpr size_t WS_END = 836 * MiB;

constexpr int LDS_BYTES = 147456; constexpr int LDS_MISC = 147456 - 256;
constexpr int NWAVES = 8;
constexpr int NPHASE = 11;

__device__ __forceinline__ unsigned f2bf(float f) { unsigned u = __builtin_bit_cast(unsigned, f); return (u + 0x7fffu + ((u >> 16) & 1u)) >> 16; }
__device__ __forceinline__ unsigned pk2(float lo, float hi) { return f2bf(lo) | (f2bf(hi) << 16); }
__device__ __forceinline__ float bflo(unsigned w) { return __builtin_bit_cast(float, w << 16); }
__device__ __forceinline__ float bfhi(unsigned w) { return __builtin_bit_cast(float, w & 0xffff0000u); }
__device__ __forceinline__ float bf2f(bf16_t b) { return __builtin_bit_cast(float, ((unsigned)b) << 16); }
__device__ __forceinline__ unsigned cvt_pk_bf16(float lo, float hi) { unsigned r; asm volatile("v_cvt_pk_bf16_f32 %0, %1, %2" : "=v"(r) : "v"(lo), "v"(hi)); return r; }
__device__ __forceinline__ float wave_sum(float v) {
#pragma unroll
    for (int o = 1; o < 64; o <<= 1) v += __shfl_xor(v, o);
    return v;
}
__device__ __forceinline__ float gelu_tanh(float x) {
    const float y = 0.7978845608028654f * (x + 0.044715f * x * x * x);
    const float e = __expf(2.f * y);
    const float th = 1.f - 2.f * __builtin_amdgcn_rcpf(1.f + e);
    return 0.5f * x * (1.f + th);
}
__device__ __forceinline__ float sigmoidf_(float x) { return 1.f / (1.f + __expf(-x)); }
__device__ __forceinline__ float dot2bf(unsigned w, unsigned x, float acc) { return __builtin_amdgcn_fdot2_f32_bf16(__builtin_bit_cast(bf16x2, w), __builtin_bit_cast(bf16x2, x), acc, false); }
__device__ __forceinline__ float ub0(unsigned x) { float r; asm("v_cvt_f32_ubyte0 %0, %1" : "=v"(r) : "v"(x)); return r; }
__device__ __forceinline__ float ub1(unsigned x) { float r; asm("v_cvt_f32_ubyte1 %0, %1" : "=v"(r) : "v"(x)); return r; }
__device__ __forceinline__ float ub2(unsigned x) { float r; asm("v_cvt_f32_ubyte2 %0, %1" : "=v"(r) : "v"(x)); return r; }
__device__ __forceinline__ float ub3(unsigned x) { float r; asm("v_cvt_f32_ubyte3 %0, %1" : "=v"(r) : "v"(x)); return r; }
__device__ __forceinline__ float wave_max(float v) {
#pragma unroll
    for (int o = 1; o < 64; o <<= 1) v = fmaxf(v, __shfl_xor(v, o));
    return v;
}
__device__ __forceinline__ unsigned pack_i8x4(float a, float b, float c, float d, int bias) {
    const int ia = (int)__builtin_rintf(a) + bias, ib = (int)__builtin_rintf(b) + bias, ic = (int)__builtin_rintf(c) + bias, id = (int)__builtin_rintf(d) + bias;
    return (unsigned)(ia & 0xff) | ((unsigned)(ib & 0xff) << 8) | ((unsigned)(ic & 0xff) << 16) | ((unsigned)id << 24);
}
#define LDS_WAIT() asm volatile("s_waitcnt lgkmcnt(0)" ::: "memory")

namespace pg8 {
constexpr int BM = 256, BK = 64, HALF = 128, HTB = HALF * BK * 2, STAGE_BYTES = 8 * HTB, NXCD = 8, WGM = 8;
__host__ __device__ __forceinline__ int lds_byte(int r, int c) { const int st = (r >> 4) * 2 + (c >> 5), rr = r & 15, cc = c & 31, ob = rr * 64 + cc * 2; return st * 1024 + (ob ^ (((ob >> 9) & 1) << 5)); }
__host__ __device__ __forceinline__ void stage_rc(int b, int& R, int& C) { const int st = b / 1024, sb = b % 1024, swz = sb ^ (((sb >> 9) & 1) << 5); R = (st >> 1) * 16 + swz / 64; C = (st & 1) * 32 + (swz % 64) / 2; }
__host__ __device__ __forceinline__ int perm32(int rho) { const int n = rho >> 4, i = rho & 15; return 8 * (i >> 2) + 4 * n + (i & 3); }
struct Unit { int pm, pn; };
struct Gemm { const bf16_t* A; const bf16_t* Bt; int M, N, K; };
struct StaticOrder {
    int nM, nN, nwg, G, c;
    __host__ __device__ void init(int M, int N, int G_, int c_) { nM = M / BM; nN = N / BM; nwg = nM * nN; G = G_; c = c_; }
    __host__ __device__ bool next(int i, Unit& u) const {
        const long L = (long)i * G + c; if (L >= nwg) return false;
        int wgid = (int)L; { const int q = nwg / NXCD, r = nwg % NXCD, xcd = wgid % NXCD, off = wgid / NXCD; wgid = (xcd < r ? xcd * (q + 1) : r * (q + 1) + (xcd - r) * q) + off; }
        const int nig = WGM * nN, gid = wgid / nig, fm = gid * WGM, gsz = (nM - fm) < WGM ? (nM - fm) : WGM;
        u.pm = fm + ((wgid % nig) % gsz); u.pn = (wgid % nig) / gsz; return true;
    }
};
struct EpiBf16 {
    bf16_t* O; int ldc;
    __device__ __forceinline__ void operator()(const f32x4 (&acc)[2][2][4][2], const Unit& u, int wr, int wc, int fr, int fq) const {
        const int row0 = u.pm * BM + wr * 64 + fr; const int col0 = u.pn * BM + wc * 32 + 8 * fq;
#pragma unroll
        for (int ai = 0; ai < 2; ++ai)
#pragma unroll
            for (int m = 0; m < 4; ++m) { bf16_t* rowp = O + (size_t)(row0 + ai * HALF + m * 16) * ldc + col0;
#pragma unroll
                for (int bj = 0; bj < 2; ++bj) { const f32x4 v0 = acc[ai][bj][m][0], v1 = acc[ai][bj][m][1];
                    u32x4 w; w.x = cvt_pk_bf16(v0[0], v0[1]); w.y = cvt_pk_bf16(v0[2], v0[3]); w.z = cvt_pk_bf16(v1[0], v1[1]); w.w = cvt_pk_bf16(v1[2], v1[3]);
                    *(u32x4*)(rowp + bj * HALF) = w; } }
    }
};
struct EpiResid {
    const float* X; float* OUT; bf16_t* HB; float* SSQ; int ldc;
    __device__ __forceinline__ void operator()(const f32x4 (&acc)[2][2][4][2], const Unit& u, int wr, int wc, int fr, int fq) const {
        const int row0 = u.pm * BM + wr * 64 + fr; const int col0 = u.pn * BM + wc * 32 + 8 * fq;
#pragma unroll
        for (int ai = 0; ai < 2; ++ai)
#pragma unroll
            for (int m = 0; m < 4; ++m) { const int row = row0 + ai * HALF + m * 16; const size_t off = (size_t)row * ldc + col0; float ss = 0.f;
#pragma unroll
                for (int bj = 0; bj < 2; ++bj) {
                    const f32x4 x0 = *(const f32x4*)(X + off + bj * HALF), x1 = *(const f32x4*)(X + off + bj * HALF + 4);
                    const f32x4 v0 = acc[ai][bj][m][0] + x0, v1 = acc[ai][bj][m][1] + x1;
                    u32x4 w; w.x = cvt_pk_bf16(v0[0], v0[1]); w.y = cvt_pk_bf16(v0[2], v0[3]); w.z = cvt_pk_bf16(v1[0], v1[1]); w.w = cvt_pk_bf16(v1[2], v1[3]);
                    *(u32x4*)(HB + off + bj * HALF) = w;
                    ss += (v0[0] * v0[0] + v0[1] * v0[1]) + (v0[2] * v0[2] + v0[3] * v0[3]) + (v1[0] * v1[0] + v1[1] * v1[1]) + (v1[2] * v1[2] + v1[3] * v1[3]); }
                ss += __shfl_xor(ss, 16); ss += __shfl_xor(ss, 32);
                if (fq == 0) SSQ[(size_t)row * 64 + u.pn * 4 + wc] = ss; }
    }
};

template <class Epi>
__device__ __forceinline__ void gemm_phase(LAS unsigned char* lds, const Gemm g, const StaticOrder& S, const Epi& E) {
    const int tid = threadIdx.x, wid = __builtin_amdgcn_readfirstlane(tid >> 6), lane = tid & 63, wr = wid >> 2, wc = wid & 3, fr = lane & 15, fq = lane >> 4;
    const int K = g.K, nt = K / BK;
    unsigned voffA[2], voffB[2];
#pragma unroll
    for (int i = 0; i < 2; ++i) { int R, C; stage_rc(tid * 16 + i * 8192, R, C); const int Rb = (R & ~31) + perm32(R & 31);
        voffA[i] = (unsigned)(R * K + C) * 2u; voffB[i] = (unsigned)(Rb * K + C) * 2u; }
    const size_t kstep = (size_t)(BK * 2);
    const size_t hstep = (size_t)HALF * K * 2;
    const size_t tstep = 2 * hstep;
    const unsigned ldsw = (unsigned)wid * 1024u;
    const int aoff = lds_byte(wr * 64 + fr, fq * 8), boff = lds_byte(wc * 32 + fr, fq * 8);
#define PG8_SA(b, h) (((b) * 2 + (h)) * HTB)
#define PG8_SB(b, h) ((4 + (b) * 2 + (h)) * HTB)
#define PG8_STAGE(bufoff, gbase, voff) do { _Pragma("unroll") for (int _i = 0; _i < 2; ++_i) \
        __builtin_amdgcn_global_load_lds((const unsigned*)((const char*)(gbase) + (voff)[_i]), (LAS unsigned*)(lds + (bufoff) + ldsw + _i * 8192), 16, 0, 0); } while (0)
#define PG8_LDA(dst, b, h) do { _Pragma("unroll") for (int m = 0; m < 4; ++m) _Pragma("unroll") for (int k = 0; k < 2; ++k) dst[m][k] = *(const LAS bf16x8*)(lds + PG8_SA(b, h) + aoff + m * 2048 + k * 1024); } while (0)
#define PG8_LDB(dst, b, h) do { _Pragma("unroll") for (int n = 0; n < 2; ++n) _Pragma("unroll") for (int k = 0; k < 2; ++k) dst[n][k] = *(const LAS bf16x8*)(lds + PG8_SB(b, h) + boff + n * 2048 + k * 1024); } while (0)
#define PG8_MMA(ai, bj, At, Bt) do { __builtin_amdgcn_s_setprio(1); _Pragma("unroll") for (int m = 0; m < 4; ++m) _Pragma("unroll") for (int n = 0; n < 2; ++n) _Pragma("unroll") for (int k = 0; k < 2; ++k) \
        acc[ai][bj][m][n] = __builtin_amdgcn_mfma_f32_16x16x32_bf16(Bt[n][k], At[m][k], acc[ai][bj][m][n], 0, 0, 0); __builtin_amdgcn_s_setprio(0); } while (0)
#define PG8_WAIT_V(n) asm volatile("s_waitcnt vmcnt(" #n ")" ::: "memory")
#define PG8_WAIT_L(n) asm volatile("s_waitcnt lgkmcnt(" #n ")" ::: "memory")
#define PG8_BAR __builtin_amdgcn_s_barrier()
#define PG8_SCHED __builtin_amdgcn_sched_barrier(0)
    Unit cur, nxt; int ui = 0;
    if (!S.next(0, cur)) return;
    f32x4 acc[2][2][4][2];
#pragma unroll
    for (int a = 0; a < 2; ++a)
#pragma unroll
        for (int b = 0; b < 2; ++b)
#pragma unroll
            for (int m = 0; m < 4; ++m)
#pragma unroll
                for (int n = 0; n < 2; ++n) acc[a][b][m][n] = (f32x4){0.f, 0.f, 0.f, 0.f};
    bf16x8 At[4][2], B0[2][2], B1[2][2];
    const char* cA = (const char*)g.A + (size_t)cur.pm * tstep; const char* cB = (const char*)g.Bt + (size_t)cur.pn * tstep;
    PG8_STAGE(PG8_SB(0, 0), cB, voffB); PG8_STAGE(PG8_SB(0, 1), cB + hstep, voffB); PG8_STAGE(PG8_SA(0, 0), cA, voffA); PG8_STAGE(PG8_SA(0, 1), cA + hstep, voffA);
    if (wr == 1) PG8_BAR;
    PG8_WAIT_V(2); PG8_BAR;
    PG8_STAGE(PG8_SB(1, 0), cB + kstep, voffB); PG8_STAGE(PG8_SA(1, 0), cA + kstep, voffA); PG8_STAGE(PG8_SB(1, 1), cB + hstep + kstep, voffB);
    PG8_WAIT_V(6); PG8_BAR;
    for (;;) {
        const bool has_next = S.next(ui + 1, nxt);
        const char* nA = has_next ? (const char*)g.A + (size_t)nxt.pm * tstep : cA; const char* nB = has_next ? (const char*)g.Bt + (size_t)nxt.pn * tstep : cB;
        for (int t = 0; t < nt; t += 2) {
            const bool last = (t == nt - 2);
            const char* a1 = cA + (size_t)(t + 1) * kstep;
            const char* a2 = last ? nA : cA + (size_t)(t + 2) * kstep; const char* b2 = last ? nB : cB + (size_t)(t + 2) * kstep;
            const char* a3 = a2 + kstep; const char* b3 = b2 + kstep;
            PG8_LDB(B0, 0, 0); PG8_LDB(B1, 0, 1); PG8_SCHED; PG8_LDA(At, 0, 0); PG8_STAGE(PG8_SA(1, 1), a1 + hstep, voffA);
            PG8_WAIT_V(8); PG8_WAIT_L(0); PG8_BAR; PG8_MMA(0, 0, At, B0); PG8_MMA(0, 1, At, B1); PG8_BAR; PG8_SCHED;
            PG8_LDA(At, 0, 1); PG8_STAGE(PG8_SB(0, 0), b2, voffB); PG8_STAGE(PG8_SB(0, 1), b2 + hstep, voffB); PG8_STAGE(PG8_SA(0, 0), a2, voffA);
            PG8_WAIT_V(8); PG8_WAIT_L(0); PG8_BAR; PG8_MMA(1, 0, At, B0); PG8_MMA(1, 1, At, B1); PG8_BAR; PG8_SCHED;
            PG8_LDB(B0, 1, 0); PG8_LDB(B1, 1, 1); PG8_SCHED; PG8_LDA(At, 1, 0); PG8_STAGE(PG8_SA(0, 1), a2 + hstep, voffA);
            PG8_WAIT_V(8); PG8_WAIT_L(0); PG8_BAR; PG8_MMA(0, 0, At, B0); PG8_MMA(0, 1, At, B1); PG8_BAR; PG8_SCHED;
            PG8_LDA(At, 1, 1); PG8_STAGE(PG8_SB(1, 0), b3, voffB); PG8_STAGE(PG8_SB(1, 1), b3 + hstep, voffB); PG8_STAGE(PG8_SA(1, 0), a3, voffA);
            PG8_WAIT_V(8); PG8_WAIT_L(0); PG8_BAR; PG8_MMA(1, 0, At, B0); PG8_MMA(1, 1, At, B1); PG8_BAR; PG8_SCHED;
        }
        if (wr == 0) PG8_BAR;
        E(acc, cur, wr, wc, fr, fq);
        if (!has_next) break;
#pragma unroll
        for (int a = 0; a < 2; ++a)
#pragma unroll
            for (int b = 0; b < 2; ++b)
#pragma unroll
                for (int m = 0; m < 4; ++m)
#pragma unroll
                    for (int n = 0; n < 2; ++n) acc[a][b][m][n] = (f32x4){0.f, 0.f, 0.f, 0.f};
        cur = nxt; cA = nA; cB = nB; ++ui;
        if (wr == 1) PG8_BAR;
    }
    PG8_WAIT_V(0);
    PG8_BAR;
#undef PG8_SA
#undef PG8_SB
#undef PG8_STAGE
#undef PG8_LDA
#undef PG8_LDB
#undef PG8_MMA
#undef PG8_WAIT_V
#undef PG8_WAIT_L
#undef PG8_BAR
#undef PG8_SCHED
}
}

namespace att {
constexpr int D = 128, NW = 8, QBLK = 32, KVBLK = 64;
constexpr float SCALE = 0.088388347648318440f;
constexpr float THR = 8.f;
constexpr int LDQ = INC, LDK = HD, LDO = DM;
constexpr size_t SHM_V = KVBLK * D * 2, SHM_K = KVBLK * D * 2, SHM_ATTN = 2 * SHM_V + 2 * SHM_K + NW * 64 * 4;
#define KSWZ(row, colB) ((row) * 256 + ((colB) ^ (((row) & 7) << 4)))
#define SBAR() __builtin_amdgcn_sched_barrier(0)
__device__ __forceinline__ int crow(int r, int hi) { return (r & 3) + 8 * (r >> 2) + 4 * hi; }
__device__ __forceinline__ unsigned cvtpk(float lo, float hi) { unsigned r; asm volatile("v_cvt_pk_bf16_f32 %0, %1, %2" : "=v"(r) : "v"(lo), "v"(hi)); return r; }
template <int NV> __device__ __forceinline__ void partialSM(f32x16& p0, f32x16& p1, float& m_reg, float& mn, float& alpha) {
    constexpr float C = SCALE * 1.4426950408889634f;
    float pmax = p0[0];
#pragma unroll
    for (int r = 1; r < 16; ++r) pmax = fmaxf(pmax, p0[r]);
#pragma unroll
    for (int r = 0; r < 16; ++r) pmax = fmaxf(pmax, p1[r]);
    { auto rr = __builtin_amdgcn_permlane32_swap(__float_as_uint(pmax), __float_as_uint(pmax), false, false);
      pmax = fmaxf(__uint_as_float(rr[0]), __uint_as_float(rr[1])); }
    if (__builtin_expect(__all(pmax - m_reg <= THR / SCALE), 1)) { mn = m_reg; alpha = 1.f; }
    else { mn = fmaxf(m_reg, pmax); alpha = __builtin_amdgcn_exp2f((m_reg - mn) * C); m_reg = mn; }
    float mnC = -mn * C;
#pragma unroll
    for (int r = 0; r < 16; ++r) p0[r] = fmaf(p0[r], C, mnC);
#pragma unroll
    for (int r = 0; r < 16; ++r) p1[r] = fmaf(p1[r], C, mnC);
#pragma unroll
    for (int r = 0; r < 16; ++r) p0[r] = __builtin_amdgcn_exp2f(p0[r]);
}
__device__ __forceinline__ void finishSM(f32x16& p0, f32x16& p1, float alpha, float& l_reg, bf16x8& pa0, bf16x8& pa1, bf16x8& pa2, bf16x8& pa3) {
#pragma unroll
    for (int r = 0; r < 16; ++r) p1[r] = __builtin_amdgcn_exp2f(p1[r]);
    float ps = 0;
#pragma unroll
    for (int r = 0; r < 16; ++r) ps += p0[r];
#pragma unroll
    for (int r = 0; r < 16; ++r) ps += p1[r];
    { auto rr = __builtin_amdgcn_permlane32_swap(__float_as_uint(ps), __float_as_uint(ps), false, false);
      ps = __uint_as_float(rr[0]) + __uint_as_float(rr[1]); }
    l_reg = l_reg * alpha + ps;
#define PK4(P, BASE, OUT) do { unsigned a0 = cvtpk(P[BASE + 0], P[BASE + 1]), a1 = cvtpk(P[BASE + 2], P[BASE + 3]);   \
    unsigned b0 = cvtpk(P[BASE + 4], P[BASE + 5]), b1 = cvtpk(P[BASE + 6], P[BASE + 7]);                              \
    auto r0 = __builtin_amdgcn_permlane32_swap(a0, b0, false, false); auto r1 = __builtin_amdgcn_permlane32_swap(a1, b1, false, false); \
    u32x4 w = {r0[0], r1[0], r0[1], r1[1]}; OUT = *reinterpret_cast<bf16x8*>(&w); } while (0)
    PK4(p0, 0, pa0); PK4(p0, 8, pa1); PK4(p1, 0, pa2); PK4(p1, 8, pa3);
#undef PK4
}
__device__ __forceinline__ void qkt(f32x16& p0, f32x16& p1, const bf16_t* Ks, const bf16x8* qr, int r32, int hi) {
    p0 = f32x16{}; p1 = f32x16{};
#pragma unroll
    for (int d0 = 0; d0 < 8; ++d0) { int cb = (d0 * 16 + hi * 8) * 2;
        bf16x8 b0 = *reinterpret_cast<const bf16x8*>((const char*)Ks + KSWZ(r32, cb));
        bf16x8 b1 = *reinterpret_cast<const bf16x8*>((const char*)Ks + KSWZ(32 + r32, cb));
        p0 = __builtin_amdgcn_mfma_f32_32x32x16_bf16(b0, qr[d0], p0, 0, 0, 0);
        p1 = __builtin_amdgcn_mfma_f32_32x32x16_bf16(b1, qr[d0], p1, 0, 0, 0); }
}
__device__ __forceinline__ int v_st(int k, int c) { const int kk = (k & ~0xC) | ((k & 4) << 1) | ((k & 8) >> 1); return ((kk >> 3) * 4 + (c >> 5)) * 512 + ((kk & 7) * 32 + (c & 31)) * 2; }
__device__ __forceinline__ int v_rd_base(int lane) { return ((lane & 3) << 3) | (((lane >> 2) & 3) << 6) | (((lane >> 4) & 1) << 5) | (((lane >> 5) & 1) << 8); }
constexpr int v_rd_off(int d0, int ks, int half) { return d0 * 512 + ks * 4096 + half * 2048; }
template <int OFF> __device__ __forceinline__ s16x4 tr_read(int vb) {
    s16x4 r; asm volatile("ds_read_b64_tr_b16 %0, %1 offset:%2" : "=&v"(r) : "v"(vb), "i"(OFF) : "memory"); return r;
}
template <int D0> __device__ __forceinline__ void pv_one(f32x16& od, int vb, bf16x8 pa0, bf16x8 pa1, bf16x8 pa2, bf16x8 pa3) {
    const s16x4 l0 = tr_read<v_rd_off(D0, 0, 0)>(vb), h0 = tr_read<v_rd_off(D0, 0, 1)>(vb), l1 = tr_read<v_rd_off(D0, 1, 0)>(vb), h1 = tr_read<v_rd_off(D0, 1, 1)>(vb);
    const s16x4 l2 = tr_read<v_rd_off(D0, 2, 0)>(vb), h2 = tr_read<v_rd_off(D0, 2, 1)>(vb), l3 = tr_read<v_rd_off(D0, 3, 0)>(vb), h3 = tr_read<v_rd_off(D0, 3, 1)>(vb);
    asm volatile("s_waitcnt lgkmcnt(0)" ::: "memory"); SBAR();
#define PK(L, H) (bf16x8){L[0], L[1], L[2], L[3], H[0], H[1], H[2], H[3]}
    od = __builtin_amdgcn_mfma_f32_32x32x16_bf16(pa0, PK(l0, h0), od, 0, 0, 0);
    od = __builtin_amdgcn_mfma_f32_32x32x16_bf16(pa1, PK(l1, h1), od, 0, 0, 0);
    od = __builtin_amdgcn_mfma_f32_32x32x16_bf16(pa2, PK(l2, h2), od, 0, 0, 0);
    od = __builtin_amdgcn_mfma_f32_32x32x16_bf16(pa3, PK(l3, h3), od, 0, 0, 0);
#undef PK
}
__device__ __forceinline__ void pv_d0(f32x16* o, int vb, bf16x8 pa0, bf16x8 pa1, bf16x8 pa2, bf16x8 pa3) {
    pv_one<0>(o[0], vb, pa0, pa1, pa2, pa3); pv_one<1>(o[1], vb, pa0, pa1, pa2, pa3); pv_one<2>(o[2], vb, pa0, pa1, pa2, pa3); pv_one<3>(o[3], vb, pa0, pa1, pa2, pa3);
}

__device__ __forceinline__ void attn_unit(const bf16_t* __restrict__ Qb, const bf16_t* __restrict__ Kh, const bf16_t* __restrict__ Vh, bf16_t* __restrict__ Ob, char* lds,
                                          const int s0, const float* __restrict__ gq, const f32x2* __restrict__ RT) {
    const int tid = threadIdx.x, wid = tid >> 6, lane = tid & 63, r32 = lane & 31, hi = lane >> 5;
    bf16_t* V_lds = (bf16_t*)lds; bf16_t* K_lds = (bf16_t*)(lds + 2 * SHM_V);
    float* ws = (float*)(lds + 2 * SHM_V + 2 * SHM_K) + wid * 64; float* li_l = ws; float* al_l = ws + 32;
    float m_reg = -1e30f, l_reg = 0; bf16x8 qr[8];
    const bf16_t* Qw = Qb + (long)(wid * QBLK + r32) * LDQ + hi * 8;
#pragma unroll
    for (int d0 = 0; d0 < 8; ++d0) qr[d0] = *reinterpret_cast<const bf16x8*>(Qw + d0 * 16);
    { float ss = 0.f;
#pragma unroll
      for (int d0 = 0; d0 < 8; ++d0)
#pragma unroll
          for (int j = 0; j < 8; ++j) { const float x = bf2f((bf16_t)qr[d0][j]); ss += x * x; }
      ss += __shfl_xor(ss, 32);
      const float rstd = 1.f / sqrtf(ss * (1.f / HD) + EPS);
      const int sq = s0 + wid * QBLK + r32, prow = sq >> 6, pcol = sq & 63;
#pragma unroll
      for (int pr = 0; pr < 4; ++pr) { const int da = (pr & 1) + 4 * (pr >> 1), db = da + 2; const int pos = (pr < 2) ? prow : pcol;
          const f32x4* cs4 = (const f32x4*)(RT + pos * 32 + (da & 1) * 16 + hi * 8);
          const f32x4* ga4 = (const f32x4*)(gq + da * 16 + hi * 8); const f32x4* gb4 = (const f32x4*)(gq + db * 16 + hi * 8);
          unsigned wa[4], wb[4];
#pragma unroll
          for (int jj = 0; jj < 4; ++jj) { const f32x4 cs = cs4[jj]; const f32x4 ga = ga4[jj >> 1], gb = gb4[jj >> 1];
              const int j = 2 * jj; const float g0a = (jj & 1) ? ga.z : ga.x, g1a = (jj & 1) ? ga.w : ga.y, g0b = (jj & 1) ? gb.z : gb.x, g1b = (jj & 1) ? gb.w : gb.y;
              const float xa0 = bf2f((bf16_t)qr[da][j]) * rstd * g0a, xa1 = bf2f((bf16_t)qr[da][j + 1]) * rstd * g1a;
              const float xb0 = bf2f((bf16_t)qr[db][j]) * rstd * g0b, xb1 = bf2f((bf16_t)qr[db][j + 1]) * rstd * g1b;
              wa[jj] = cvtpk(xa0 * cs.x - xb0 * cs.y, xa1 * cs.z - xb1 * cs.w);
              wb[jj] = cvtpk(xb0 * cs.x + xa0 * cs.y, xb1 * cs.z + xa1 * cs.w); }
          const u32x4 va = {wa[0], wa[1], wa[2], wa[3]}, vb = {wb[0], wb[1], wb[2], wb[3]};
          qr[da] = *reinterpret_cast<const bf16x8*>(&va); qr[db] = *reinterpret_cast<const bf16x8*>(&vb); } }
    f32x16 o[4] = {};
    const int sr = tid >> 4, sc = (tid & 15) * 8, vst0 = v_st(sr, sc), vst1 = v_st(32 + sr, sc);
    const int vb0 = (int)(uintptr_t)V_lds + v_rd_base(lane);
    struct { bf16x8 vs0, vs1, ks0, ks1; } sr_[2];
    const unsigned toff = (unsigned)(sr * LDK + sc) * 2u;
#define SLOAD(i, k0) do { const char* _kb = (const char*)Kh + (size_t)(k0) * (LDK * 2); const char* _vb = (const char*)Vh + (size_t)(k0) * (LDK * 2); \
    sr_[i].vs0 = *reinterpret_cast<const bf16x8*>(_vb + toff); sr_[i].vs1 = *reinterpret_cast<const bf16x8*>(_vb + 32 * LDK * 2 + toff); \
    sr_[i].ks0 = *reinterpret_cast<const bf16x8*>(_kb + toff); sr_[i].ks1 = *reinterpret_cast<const bf16x8*>(_kb + 32 * LDK * 2 + toff); } while (0)
#define SWRITE(b, i) do { *(bf16x8*)((char*)V_lds + (b) * SHM_V + vst0) = sr_[i].vs0;          \
    *(bf16x8*)((char*)V_lds + (b) * SHM_V + vst1) = sr_[i].vs1; int kc = sc * 2;               \
    *(bf16x8*)((char*)K_lds + (b) * SHM_K + KSWZ(sr, kc)) = sr_[i].ks0;                       \
    *(bf16x8*)((char*)K_lds + (b) * SHM_K + KSWZ(32 + sr, kc)) = sr_[i].ks1; } while (0)
#define SWAIT() asm volatile("s_waitcnt vmcnt(4)" ::: "memory")
#define RESC(a) do { if (__any((a) < 1.f)) { if (hi == 0) al_l[r32] = (a); asm volatile("s_waitcnt lgkmcnt(0)" ::: "memory"); \
    _Pragma("unroll") for (int d = 0; d < 4; ++d) _Pragma("unroll") for (int r = 0; r < 16; ++r) o[d][r] *= al_l[crow(r, hi)]; } } while (0)
    f32x16 pA0, pA1, pB0, pB1; float mnA, mnB, alA, alB; bf16x8 pa0, pa1, pa2, pa3; constexpr int NT = KPAD / KVBLK; static_assert(NT == NT_REAL + 2, "tile count");
    constexpr int SE = 0, SO = 1;
    SLOAD(SE, 0); asm volatile("s_waitcnt vmcnt(0)" ::: "memory"); SWRITE(0, SE); __syncthreads();
    qkt(pA0, pA1, K_lds, qr, r32, hi); partialSM<64>(pA0, pA1, m_reg, mnA, alA);
    SLOAD(SO, KVBLK); SLOAD(SE, 2 * KVBLK);
    SWAIT(); SWRITE(1, SO); __syncthreads();
    for (int j = 1; j + 1 < NT; j += 2) {
        SBAR(); qkt(pB0, pB1, (bf16_t*)((char*)K_lds + SHM_K), qr, r32, hi);
        finishSM(pA0, pA1, alA, l_reg, pa0, pa1, pa2, pa3); SBAR();
        SLOAD(SO, (j + 2) * KVBLK); SBAR();
        pv_d0(o, vb0, pa0, pa1, pa2, pa3); partialSM<64>(pB0, pB1, m_reg, mnB, alB);
        __syncthreads(); SWAIT(); SWRITE(0, SE);
        RESC(alB); __syncthreads();
        SBAR(); qkt(pA0, pA1, K_lds, qr, r32, hi);
        finishSM(pB0, pB1, alB, l_reg, pa0, pa1, pa2, pa3); SBAR();
        if (j + 3 < NT) SLOAD(SE, (j + 3) * KVBLK); SBAR();
        pv_d0(o, vb0 + (int)SHM_V, pa0, pa1, pa2, pa3); partialSM<64>(pA0, pA1, m_reg, mnA, alA);
        __syncthreads(); SWAIT(); SWRITE(1, SO);
        RESC(alA); __syncthreads();
    }
    SBAR(); qkt(pB0, pB1, (bf16_t*)((char*)K_lds + SHM_K), qr, r32, hi);
    finishSM(pA0, pA1, alA, l_reg, pa0, pa1, pa2, pa3); SBAR();
    pv_d0(o, vb0, pa0, pa1, pa2, pa3); partialSM<64>(pB0, pB1, m_reg, mnB, alB);
    __syncthreads(); RESC(alB);
    finishSM(pB0, pB1, alB, l_reg, pa0, pa1, pa2, pa3); SBAR();
    pv_d0(o, vb0 + (int)SHM_V, pa0, pa1, pa2, pa3);
    l_reg -= (float)(KPAD - LTOT) * __builtin_amdgcn_exp2f(-m_reg * (SCALE * 1.4426950408889634f));
    if (hi == 0) li_l[r32] = l_reg; asm volatile("s_waitcnt lgkmcnt(0)" ::: "memory");
    float rli[16];
#pragma unroll
    for (int r = 0; r < 16; ++r) rli[r] = __builtin_amdgcn_rcpf(li_l[crow(r, hi)]);
    bf16_t* Ow = Ob + (long)(wid * QBLK) * LDO;
    const int odd = lane & 1;
#pragma unroll
    for (int r = 0; r < 16; r += 2) {
#pragma unroll
        for (int d0 = 0; d0 < 4; ++d0) {
            const float a = o[d0][r] * rli[r], b = o[d0][r + 1] * rli[r + 1];
            const float send = odd ? a : b;
            const float recv = __builtin_bit_cast(float, __builtin_amdgcn_update_dpp(0, __builtin_bit_cast(int, send), 0xB1, 0xF, 0xF, false));
            const float plo = odd ? recv : a, phi = odd ? b : recv;
            const unsigned w = cvtpk(plo, phi);
            const int orow = crow(odd ? r + 1 : r, hi);
            *(unsigned*)(Ow + (long)orow * LDO + d0 * 32 + (r32 & ~1)) = w;
        }
    }
    __syncthreads();
#undef SLOAD
#undef SWRITE
#undef SWAIT
#undef RESC
}
}

#define XB_TMO      128
#define XB_XCNT(j)  (256  + 64 * (j))
#define XB_XSUB(j)  (1280 + 64 * (j))
#define XB_XGEN(j)  (2304 + 64 * (j))
#define XB_TOP      3328
#define XB_TOPGEN   3392
#define XCD_BAR_WORDS 3456
#define XB_SPIN_CAP (1u << 22)
__device__ __forceinline__ unsigned xb_ld(unsigned* p)              { return __hip_atomic_load(p, __ATOMIC_RELAXED, __HIP_MEMORY_SCOPE_AGENT); }
__device__ __forceinline__ unsigned xb_add(unsigned* p, unsigned v) { return __hip_atomic_fetch_add(p, v, __ATOMIC_RELAXED, __HIP_MEMORY_SCOPE_AGENT); }
__device__ __forceinline__ unsigned xb_xcc_id() { return (unsigned)__builtin_amdgcn_s_getreg((3 << 11) | 20) & 0xFu; }
#define XB_SPIN(cond, bar) do { unsigned _sp = 0; while (cond) { __builtin_amdgcn_s_sleep(1); \
    if ((++_sp & 255u) == 0u) { if (xb_ld(&(bar)[XB_TMO])) break; if (_sp > XB_SPIN_CAP) { atomicAdd(&(bar)[XB_TMO], 1u); break; } } } } while (0)
struct XcdBarrier { unsigned* bar; unsigned x; volatile LAS unsigned* st; };
__device__ __forceinline__ XcdBarrier xcd_barrier_post(unsigned* bar, volatile LAS unsigned* st) {
    XcdBarrier b; b.bar = bar; b.x = xb_xcc_id(); b.st = st;
    if (threadIdx.x == 0) (void)xb_add(&bar[XB_XCNT(b.x)], 1u);
    return b;
}
__device__ __forceinline__ void xcd_barrier_complete(unsigned* bar, unsigned x, unsigned& nloc, unsigned& nx) {
    const unsigned G = gridDim.x * gridDim.y * gridDim.z;
    unsigned sum, cnt, mine, sp = 0u;
    for (;;) {
        sum = 0u; cnt = 0u; mine = 0u;
#pragma unroll
        for (unsigned j = 0; j < 16; ++j) { const unsigned c = xb_ld(&bar[XB_XCNT(j)]); sum += c; cnt += (c > 0u) ? 1u : 0u; mine = (j == x) ? c : mine; }
        if (sum == G) break;
        __builtin_amdgcn_s_sleep(1);
        if ((++sp & 255u) == 0u) { if (xb_ld(&bar[XB_TMO])) break; if (sp > XB_SPIN_CAP) { atomicAdd(&bar[XB_TMO], 1u); break; } }
    }
    nloc = mine > 0u ? mine : 1u; nx = cnt > 0u ? cnt : 1u;
}
__device__ __forceinline__ void xcd_barrier(const XcdBarrier& b) {
    asm volatile("s_waitcnt vmcnt(0)" ::: "memory");
    __syncthreads();
    if (threadIdx.x == 0) {
        unsigned* bar = b.bar;
        __builtin_amdgcn_s_waitcnt(0);
        unsigned nloc = b.st[0], nx = b.st[1];
        if (nloc == 0u) { xcd_barrier_complete(bar, b.x, nloc, nx); b.st[0] = nloc; b.st[1] = nx; }
        const unsigned old = xb_add(&bar[XB_XSUB(b.x)], 1u);
        const unsigned gen = old / nloc;
        if (old + 1u == (gen + 1u) * nloc) {
            __builtin_amdgcn_fence(__ATOMIC_RELEASE, "agent");
            asm volatile("s_waitcnt vmcnt(0)" ::: "memory");
            const unsigned og = xb_add(&bar[XB_TOP], 1u);
            const unsigned tg = og / nx;
            if (og + 1u == (tg + 1u) * nx) xb_add(&bar[XB_TOPGEN], 1u);
            else XB_SPIN(xb_ld(&bar[XB_TOPGEN]) == tg, bar);
            __builtin_amdgcn_fence(__ATOMIC_ACQUIRE, "agent");
            xb_add(&bar[XB_XGEN(b.x)], 1u);
            asm volatile("s_waitcnt vmcnt(0)" ::: "memory");
        } else {
            XB_SPIN(xb_ld(&bar[XB_XGEN(b.x)]) == gen, bar);
            __builtin_amdgcn_fence(__ATOMIC_ACQUIRE, "agent");
            asm volatile("s_waitcnt vmcnt(0)" ::: "memory");
        }
    }
    __syncthreads();
}

struct Args { const float* in[21]; float* out; unsigned char* ws; int ph_lo, ph_hi; };
struct Frame {
    LAS unsigned char* lds; char* ldsg;
    int tid, lane, wave, vcu, G;
    float* out; unsigned char* ws;
};
#define IN_X 0
#define IN_META 1
#define IN_G1 2
#define IN_WIN 3
#define IN_QG 4
#define IN_KG 5
#define IN_CW 6
#define IN_CB 7
#define IN_WRG 8
#define IN_BRG 9
#define IN_WIG 10
#define IN_BIG 11
#define IN_LAM 12
#define IN_GA 13
#define IN_GL 14
#define IN_WOUT 15
#define IN_G2 16
#define IN_WQ 17
#define IN_SK 18
#define IN_U 19
#define IN_V 20

struct TItem { const float* W; const float* gk; bf16_t* WT; int N, K, k0, n0; };
__device__ __forceinline__ void p0_item_load(const TItem& T, int lane, f32x4 (&v)[16], float (&g)[16]) {
    const int kq = lane >> 4, nq = lane & 15;
#pragma unroll
    for (int i = 0; i < 16; ++i) { const int kk = 4 * i + kq; v[i] = *(const f32x4*)(T.W + (size_t)(T.k0 + kk) * T.N + T.n0 + 4 * nq); g[i] = T.gk ? T.gk[T.k0 + kk] : 1.f; }
}
__device__ __forceinline__ void p0_item_store(const TItem& T, int lane, const f32x4 (&v)[16], const float (&g)[16], LAS float* scr) {
    const int kq = lane >> 4, nq = lane & 15;
#pragma unroll
    for (int i = 0; i < 16; ++i) { const int kk = 4 * i + kq; LAS float* d = scr + kk * 65 + 4 * nq; d[0] = v[i].x * g[i]; d[1] = v[i].y * g[i]; d[2] = v[i].z * g[i]; d[3] = v[i].w * g[i]; }
    LDS_WAIT(); asm volatile("" ::: "memory");
    const int c = lane & 7;
#pragma unroll
    for (int j = 0; j < 8; ++j) { const int n = (lane >> 3) + 8 * j; const LAS float* sp = scr + (8 * c) * 65 + n;
        u32x4 o; o.x = pk2(sp[0 * 65], sp[1 * 65]); o.y = pk2(sp[2 * 65], sp[3 * 65]); o.z = pk2(sp[4 * 65], sp[5 * 65]); o.w = pk2(sp[6 * 65], sp[7 * 65]);
        *(u32x4*)(T.WT + (size_t)(T.n0 + n) * T.K + T.k0 + 8 * c) = o; }
    LDS_WAIT(); asm volatile("" ::: "memory");
}
__device__ __forceinline__ TItem p0_item_decode(Frame& F, const Args& A, int it) {
    constexpr int I_1 = (DM / 64) * (INC / 64), I_2 = (DM / 64) * (DM / 64), I_3 = (DM / 64) * (2048 / 64);
    TItem T; int r = it;
    if (r < I_1) { T.W = A.in[IN_WIN]; T.gk = A.in[IN_G1]; T.WT = (bf16_t*)(F.ws + WS_WT1); T.N = INC; T.K = DM; }
    else if ((r -= I_1) < I_2) { const int kb = r % (DM / 64); T.W = A.in[IN_WOUT]; T.gk = (kb < 32) ? A.in[IN_GA] : (A.in[IN_GL] - DATT); T.WT = (bf16_t*)(F.ws + WS_WT2); T.N = DM; T.K = DM; }
    else if ((r -= I_2) < I_3) { T.W = A.in[IN_WQ]; T.gk = A.in[IN_G2]; T.WT = (bf16_t*)(F.ws + WS_WT3); T.N = 2048; T.K = DM; }
    else { r -= I_3; const int mat = r >> 2; const int dirn = mat >> 1, gate = mat & 1;
        T.W = (gate ? A.in[IN_WIG] : A.in[IN_WRG]) + (size_t)dirn * 128 * 128; T.gk = nullptr; T.WT = (bf16_t*)(F.ws + WS_WG) + (size_t)mat * 128 * 128; T.N = 128; T.K = 128; r &= 3; }
    const int nkb = T.K / 64; T.k0 = 64 * (r % nkb); T.n0 = 64 * (r / nkb);
    return T;
}
__device__ __forceinline__ void p0_prologue(Frame& F, const Args& A) {
    LAS float* scr = (LAS float*)(F.lds + F.wave * 16640);
    const int gw = F.vcu * NWAVES + F.wave, NGW = F.G * NWAVES, lane = F.lane;
    constexpr int NITEMS = (DM / 64) * (INC / 64) + (DM / 64) * (DM / 64) + (DM / 64) * (2048 / 64) + 64 * 4;
    if (gw < NITEMS) {
        TItem T = p0_item_decode(F, A, gw); f32x4 v[16]; float g[16];
        p0_item_load(T, lane, v, g);
        for (int it = gw; it < NITEMS; it += NGW) {
            TItem Tn = T; f32x4 vn[16]; float gn[16];
            const bool more = it + NGW < NITEMS;
            if (more) { Tn = p0_item_decode(F, A, it + NGW); p0_item_load(Tn, lane, vn, gn); }
            p0_item_store(T, lane, v, g, scr);
            if (more) { T = Tn;
#pragma unroll
                for (int i = 0; i < 16; ++i) { v[i] = vn[i]; g[i] = gn[i]; } }
        }
    }
    bf16_t* XN = (bf16_t*)(F.ws + WS_XN);
    { f32x4 vn[16];
      if (gw < MR + NMETA) { const f32x4* xr = (const f32x4*)((gw < MR) ? A.in[IN_X] + (size_t)gw * DM : A.in[IN_META] + (size_t)(gw - MR) * DM) + lane;
#pragma unroll
          for (int j = 0; j < 16; ++j) vn[j] = xr[64 * j]; }
      for (int m = gw; m < MR + NMETA; m += NGW) {
        f32x4 v[16]; float s = 0.f;
#pragma unroll
        for (int j = 0; j < 16; ++j) { v[j] = vn[j]; s += (v[j].x * v[j].x + v[j].y * v[j].y) + (v[j].z * v[j].z + v[j].w * v[j].w); }
        { const int mn = m + NGW;
          if (mn < MR + NMETA) { const f32x4* xr = (const f32x4*)((mn < MR) ? A.in[IN_X] + (size_t)mn * DM : A.in[IN_META] + (size_t)(mn - MR) * DM) + lane;
#pragma unroll
              for (int j = 0; j < 16; ++j) vn[j] = xr[64 * j]; } }
        const float rstd = 1.f / sqrtf(wave_sum(s) * (1.f / DM) + EPS);
        u32x2* o8 = (u32x2*)(XN + (size_t)m * DM) + lane;
#pragma unroll
        for (int j = 0; j < 16; ++j) { u32x2 w; w.x = pk2(v[j].x * rstd, v[j].y * rstd); w.y = pk2(v[j].z * rstd, v[j].w * rstd); o8[64 * j] = w; }
      } }
    { const float* sk = A.in[IN_SK]; bf16_t* SKB = (bf16_t*)(F.ws + WS_SKB);
      for (int i = gw * 64 + lane; i < PH * 2 * NKEYS * 128 / 4; i += NGW * 64) { const f32x4 v = ((const f32x4*)sk)[i]; u32x2 w; w.x = pk2(v.x, v.y); w.y = pk2(v.z, v.w); ((u32x2*)SKB)[i] = w; }
      f32x2* RT = (f32x2*)(F.ws + WS_ROPE);
      for (int i = gw * 64 + lane; i < 64 * 32; i += NGW * 64) { const int p = i >> 5, j = i & 31;
          const float inv = exp2f(-(float)j * (13.287712379549449f / 32.f)); const float ang = (float)p * inv;
          float rev = ang * 0.15915494309189535f; rev -= floorf(rev);
          f32x2 cs; cs.x = __builtin_amdgcn_cosf(rev); cs.y = __builtin_amdgcn_sinf(rev); RT[i] = cs; } }
}

__device__ __forceinline__ void p1_meta_gemm(Frame& F, const Args& A) {
    const bf16_t* XNm = (const bf16_t*)(F.ws + WS_XN) + (size_t)MR * DM; const bf16_t* WT1 = (const bf16_t*)(F.ws + WS_WT1); bf16_t* ZM = (bf16_t*)(F.ws + WS_ZM);
    LAS float* red = (LAS float*)F.lds;
    const int lane = F.lane, c16 = lane & 15, q = lane >> 4;
    for (int item = F.vcu; item < (OFF_Y - OFF_K) / 16; item += F.G) {
        const int n0 = OFF_K + 16 * item;
        f32x4 acc = {0.f, 0.f, 0.f, 0.f};
        const bf16_t* ap = XNm + (size_t)c16 * DM + F.wave * 512 + 8 * q; const bf16_t* bp = WT1 + (size_t)(n0 + c16) * DM + F.wave * 512 + 8 * q;
#pragma unroll
        for (int ks = 0; ks < 16; ++ks) { const bf16x8 a = *(const bf16x8*)(ap + 32 * ks), b = *(const bf16x8*)(bp + 32 * ks); acc = __builtin_amdgcn_mfma_f32_16x16x32_bf16(a, b, acc, 0, 0, 0); }
#pragma unroll
        for (int r = 0; r < 4; ++r) red[F.wave * 256 + (4 * q + r) * 16 + c16] = acc[r];
        __syncthreads();
        if (F.tid < 256) { float s = 0.f;
#pragma unroll
            for (int w = 0; w < 8; ++w) s += red[w * 256 + F.tid];
            ZM[(size_t)(F.tid >> 4) * INC + n0 + (F.tid & 15)] = (bf16_t)f2bf(s); }
        __syncthreads();
    }
}

template <int dir> __device__ __forceinline__ void scan_unit(Frame& F, const Args& A, int u) {
    const int half = (u >> 1) & 1, n = (u >> 2) & 15, b = u >> 6;
    const int tid = F.tid, lane = F.lane, wave = F.wave;
    const bf16_t* Z = (const bf16_t*)(F.ws + WS_Z); const bf16_t* ZM = (const bf16_t*)(F.ws + WS_ZM);
    bf16_t* HO = (bf16_t*)(F.ws + (dir ? WS_HB : WS_HF));
    LAS unsigned char* XR = F.lds;
    LAS unsigned char* XC = F.lds + 18432;
    LAS float* AS = (LAS float*)(F.lds + 35840);
    LAS float* BS = (LAS float*)(F.lds + 52224);
    LAS float* HS = (LAS float*)(F.lds + 68608);
    LAS float* SM = (LAS float*)(F.lds + 84992);
    LAS float* CR = (LAS float*)(F.lds + 89088);
    const int mt = wave & 3, dh = wave >> 2, r16 = lane & 15, q4 = lane >> 4;
    bf16x8 bw[4][4];
#pragma unroll
    for (int nt = 0; nt < 4; ++nt) { const int gate = nt >> 1, dcol = 64 * half + 32 * dh + 16 * (nt & 1) + r16;
        const bf16_t* wp = (const bf16_t*)(F.ws + WS_WG) + ((size_t)((dir * 16 + n) * 2 + gate) * 128 + dcol) * 128 + 8 * q4;
#pragma unroll
        for (int ks = 0; ks < 4; ++ks) bw[nt][ks] = *(const bf16x8*)(wp + 32 * ks); }
    float br[2], bi[2], sp8[2];
#pragma unroll
    for (int db = 0; db < 2; ++db) { const int che = 128 * n + 64 * half + 32 * dh + 16 * db + r16;
        br[db] = -1.4426950408889634f * A.in[IN_BRG][dir * DRNN + che]; bi[db] = -1.4426950408889634f * A.in[IN_BIG][dir * DRNN + che];
        sp8[db] = -16.f * log1pf(__expf(-A.in[IN_LAM][dir * DRNN + che])); }
    const int cp = tid & 63, tg = tid >> 6;
    float cw[2][4], cb[2];
#pragma unroll
    for (int c = 0; c < 2; ++c) { const int ch = 128 * n + 2 * cp + c;
#pragma unroll
        for (int j = 0; j < 4; ++j) cw[c][j] = A.in[IN_CW][j * DRNN + ch];
        cb[c] = A.in[IN_CB][ch]; }
    const int ntile = dir ? 64 : 65;
    const int lr = tid >> 4, lc = tid & 15;
    u32x4 pf[3];
#define TILE_P0(it) (dir ? (NMETA + 64 * (63 - (it))) : ((it) == 0 ? -48 : NMETA + 64 * ((it) - 1)))
#define XR_PREFETCH(it) do { const int _p0 = TILE_P0(it); _Pragma("unroll") for (int _j = 0; _j < 3; ++_j) { const int _r = lr + 32 * _j; const int _p = _p0 - 2 + _r; u32x4 _v = {0u, 0u, 0u, 0u}; \
        if (_r < 67 && _p >= 0 && _p < LTOT) { const bf16_t* _row = (_p < NMETA) ? (ZM + (size_t)_p * INC) : (Z + (size_t)(b * SEQ + _p - NMETA) * INC); _v = *(const u32x4*)(_row + OFF_X + 128 * n + 8 * lc); } pf[_j] = _v; } } while (0)
    XR_PREFETCH(0);
    if (tid < 128) CR[tid] = 0.f;
    for (int it = 0; it < ntile; ++it) {
        const int p0 = TILE_P0(it);
#pragma unroll
        for (int j = 0; j < 3; ++j) { const int r = lr + 32 * j; if (r < 67) *(LAS u32x4*)(XR + r * 272 + lc * 16) = pf[j]; }
        __syncthreads();
        if (it + 1 < ntile) XR_PREFETCH(it + 1);
        { float x0[11], x1[11];
#pragma unroll
          for (int i = 0; i < 11; ++i) { const unsigned w = *(const LAS unsigned*)(XR + (8 * tg + i) * 272 + cp * 4); x0[i] = bflo(w); x1[i] = bfhi(w); }
#pragma unroll
          for (int i = 0; i < 8; ++i) { const float y0 = cw[0][0] * x0[i] + cw[0][1] * x0[i + 1] + cw[0][2] * x0[i + 2] + cw[0][3] * x0[i + 3] + cb[0];
              const float y1 = cw[1][0] * x1[i] + cw[1][1] * x1[i + 1] + cw[1][2] * x1[i + 2] + cw[1][3] * x1[i + 3] + cb[1];
              *(LAS unsigned*)(XC + (8 * tg + i) * 272 + cp * 4) = pk2(y0, y1); } }
        __syncthreads();
        { bf16x8 af[4];
#pragma unroll
          for (int ks = 0; ks < 4; ++ks) af[ks] = *(const LAS bf16x8*)(XC + (16 * mt + r16) * 272 + (32 * ks + 8 * q4) * 2);
          f32x4 acc[4];
#pragma unroll
          for (int nt = 0; nt < 4; ++nt) { acc[nt] = (f32x4){0.f, 0.f, 0.f, 0.f};
#pragma unroll
              for (int ks = 0; ks < 4; ++ks) acc[nt] = __builtin_amdgcn_mfma_f32_16x16x32_bf16(af[ks], bw[nt][ks], acc[nt], 0, 0, 0); }
#pragma unroll
          for (int db = 0; db < 2; ++db)
#pragma unroll
              for (int rg = 0; rg < 4; ++rg) { const int t = 16 * mt + 4 * q4 + rg, dloc = 32 * dh + 16 * db + r16;
                  const float rr = __builtin_amdgcn_rcpf(1.f + __builtin_amdgcn_exp2f(fmaf(acc[db][rg], -1.4426950408889634f, br[db])));
                  const float ii = __builtin_amdgcn_rcpf(1.f + __builtin_amdgcn_exp2f(fmaf(acc[2 + db][rg], -1.4426950408889634f, bi[db])));
                  const float x2 = sp8[db] * rr; float a = __builtin_amdgcn_exp2f(x2 * 0.7213475204444817f);
                  const float ser = -x2 * (1.f + 0.5f * x2 * (1.f + (1.f / 3.f) * x2 * (1.f + 0.25f * x2 * (1.f + 0.2f * x2))));
                  const float om = (x2 > -0.125f) ? ser : (1.f - a * a);
                  const float xcv = bf2f(*(const LAS bf16_t*)(XC + t * 272 + (64 * half + dloc) * 2));
                  float bb = __builtin_amdgcn_sqrtf(om) * (ii * xcv);
                  if (p0 < 0) { if (p0 + t < 0) { a = 1.f; bb = 0.f; } }
                  AS[t * 64 + dloc] = a; BS[t * 64 + dloc] = bb; } }
        __syncthreads();
        float hl[8], pl[8];
        { float h = 0.f, pr = 1.f;
#pragma unroll
          for (int i = 0; i < 8; ++i) { const int j = 8 * wave + i, t = dir ? 63 - j : j; const float a = AS[t * 64 + lane], bq = BS[t * 64 + lane]; h = a * h + bq; pr *= a; hl[i] = h; pl[i] = pr; }
          SM[(wave * 64 + lane) * 2] = pr; SM[(wave * 64 + lane) * 2 + 1] = h; }
        __syncthreads();
        { float hin = CR[(it & 1) * 64 + lane];
          float sp_[7], sh_[7];
#pragma unroll
          for (int v = 0; v < 7; ++v) { sp_[v] = SM[(v * 64 + lane) * 2]; sh_[v] = SM[(v * 64 + lane) * 2 + 1]; }
#pragma unroll
          for (int v = 0; v < 7; ++v) hin = (v < wave) ? (sp_[v] * hin + sh_[v]) : hin;
#pragma unroll
          for (int i = 0; i < 8; ++i) { const int j = 8 * wave + i, t = dir ? 63 - j : j; const float h = hl[i] + pl[i] * hin; HS[t * 64 + lane] = h; if (i == 7 && wave == 7) CR[((it + 1) & 1) * 64 + lane] = h; } }
        __syncthreads();
        if (p0 >= NMETA) {
            const int c2 = (tid & 31) * 2;
#pragma unroll
            for (int ps = 0; ps < 4; ++ps) { const int t = (tid >> 5) + 16 * ps; const size_t m = (size_t)b * SEQ + (p0 + t - NMETA);
                *(unsigned*)(HO + m * DRNN + 128 * n + 64 * half + c2) = pk2(HS[t * 64 + c2], HS[t * 64 + c2 + 1]); }
        }
    }
    __syncthreads();
#undef TILE_P0
#undef XR_PREFETCH
}

__device__ __forceinline__ void normrope_rows(Frame& F, const Args& A) {
    const int gw = F.vcu * NWAVES + F.wave, NGW = F.G * NWAVES, lane = F.lane;
    bf16_t* Z = (bf16_t*)(F.ws + WS_Z); const bf16_t* ZM = (const bf16_t*)(F.ws + WS_ZM);
    bf16_t* KP = (bf16_t*)(F.ws + WS_KP); bf16_t* VP = (bf16_t*)(F.ws + WS_VP);
    const f32x2* RT = (const f32x2*)(F.ws + WS_ROPE);
    const int g = lane >> 4, i16 = lane & 15, j0 = 2 * i16;
    float gq[8], gk[8];
#pragma unroll
    for (int s = 0; s < 4; ++s) { gq[2 * s] = A.in[IN_QG][32 * s + j0]; gq[2 * s + 1] = A.in[IN_QG][32 * s + j0 + 1]; gk[2 * s] = A.in[IN_KG][32 * s + j0]; gk[2 * s + 1] = A.in[IN_KG][32 * s + j0 + 1]; }
    const int NIT = NB * KPAD;
    for (int it = gw; it < NIT; it += NGW) {
        const int b = it / KPAD, kidx = it - b * KPAD; const bool meta = (kidx >= SEQ) && (kidx < LTOT), pad = kidx >= LTOT;
        const bf16_t* row = meta ? (ZM + (size_t)(kidx - SEQ) * INC) : (Z + (size_t)(b * SEQ + (pad ? 0 : kidx)) * INC);
        if (pad) { const u32x4 z = {0u, 0u, 0u, 0u};
            *(u32x4*)(KP + ((size_t)(b * NKV + g) * KPAD + kidx) * HD + i16 * 8) = z; *(u32x4*)(VP + ((size_t)(b * NKV + g) * KPAD + kidx) * HD + i16 * 8) = z; continue; }
        f32x2 cr0 = {1.f, 0.f}, cr1 = {1.f, 0.f}, cc0 = {1.f, 0.f}, cc1 = {1.f, 0.f};
        if (!meta) { const int prow = kidx >> 6, pcol = kidx & 63; cr0 = RT[prow * 32 + j0]; cr1 = RT[prow * 32 + j0 + 1]; cc0 = RT[pcol * 32 + j0]; cc1 = RT[pcol * 32 + j0 + 1]; }
        { const bf16_t* base = row + OFF_K + g * HD;
          unsigned e[4];
#pragma unroll
          for (int sgm = 0; sgm < 4; ++sgm) e[sgm] = *(const unsigned*)(base + 32 * sgm + j0);
          float x[8]; float ss = 0.f;
#pragma unroll
          for (int sgm = 0; sgm < 4; ++sgm) { x[2 * sgm] = bflo(e[sgm]); x[2 * sgm + 1] = bfhi(e[sgm]); ss += x[2 * sgm] * x[2 * sgm] + x[2 * sgm + 1] * x[2 * sgm + 1]; }
          ss += __shfl_xor(ss, 1); ss += __shfl_xor(ss, 2); ss += __shfl_xor(ss, 4); ss += __shfl_xor(ss, 8);
          const float rstd = 1.f / sqrtf(ss * (1.f / HD) + EPS);
#pragma unroll
          for (int k = 0; k < 8; ++k) x[k] = x[k] * rstd * gk[k];
          float y[8];
          y[0] = x[0] * cr0.x - x[2] * cr0.y; y[2] = x[2] * cr0.x + x[0] * cr0.y;
          y[1] = x[1] * cr1.x - x[3] * cr1.y; y[3] = x[3] * cr1.x + x[1] * cr1.y;
          y[4] = x[4] * cc0.x - x[6] * cc0.y; y[6] = x[6] * cc0.x + x[4] * cc0.y;
          y[5] = x[5] * cc1.x - x[7] * cc1.y; y[7] = x[7] * cc1.x + x[5] * cc1.y;
          bf16_t* dst = KP + ((size_t)(b * NKV + g) * KPAD + kidx) * HD;
#pragma unroll
          for (int sgm = 0; sgm < 4; ++sgm) *(unsigned*)(dst + 32 * sgm + j0) = pk2(y[2 * sgm], y[2 * sgm + 1]); }
        { const u32x4 vv = *(const u32x4*)(row + OFF_V + lane * 8);
          *(u32x4*)(VP + ((size_t)(b * NKV + g) * KPAD + kidx) * HD + i16 * 8) = vv; }
    }
}

__device__ __forceinline__ void combine_rows(Frame& F, const Args& A) {
    const int gw = F.vcu * NWAVES + F.wave, NGW = F.G * NWAVES, lane = F.lane;
    bf16_t* MRG = (bf16_t*)(F.ws + WS_MRG); const bf16_t* HFp = (const bf16_t*)(F.ws + WS_HF); const bf16_t* HBp = (const bf16_t*)(F.ws + WS_HB); const bf16_t* Z = (const bf16_t*)(F.ws + WS_Z);
    for (int m = gw; m < MR; m += NGW) {
        u32x4* ap = (u32x4*)(MRG + (size_t)m * DM) + lane;
        u32x4 av[4]; float sa = 0.f;
#pragma unroll
        for (int j = 0; j < 4; ++j) { av[j] = ap[64 * j];
#pragma unroll
            for (int k = 0; k < 4; ++k) { const float lo = bflo(av[j][k]), hi = bfhi(av[j][k]); sa += lo * lo + hi * hi; } }
        const u32x4* fp = (const u32x4*)(HFp + (size_t)m * DRNN) + lane; const u32x4* bp = (const u32x4*)(HBp + (size_t)m * DRNN) + lane; const u32x4* yp = (const u32x4*)(Z + (size_t)m * INC + OFF_Y) + lane;
        float lv[32]; float sl = 0.f;
#pragma unroll
        for (int j = 0; j < 4; ++j) { const u32x4 f = fp[64 * j], bq = bp[64 * j], y = yp[64 * j];
#pragma unroll
            for (int k = 0; k < 4; ++k) { const float l0 = (bflo(f[k]) + bflo(bq[k])) * gelu_tanh(bflo(y[k])), l1 = (bfhi(f[k]) + bfhi(bq[k])) * gelu_tanh(bfhi(y[k]));
                lv[8 * j + 2 * k] = l0; lv[8 * j + 2 * k + 1] = l1; sl += l0 * l0 + l1 * l1; } }
        const float ra = 1.f / sqrtf(wave_sum(sa) * (1.f / DATT) + EPS), rl = 1.f / sqrtf(wave_sum(sl) * (1.f / DRNN) + EPS);
#pragma unroll
        for (int j = 0; j < 4; ++j) { u32x4 w;
#pragma unroll
            for (int k = 0; k < 4; ++k) w[k] = pk2(bflo(av[j][k]) * ra, bfhi(av[j][k]) * ra);
            ap[64 * j] = w; }
        u32x4* lp = (u32x4*)(MRG + (size_t)m * DM + DATT) + lane;
#pragma unroll
        for (int j = 0; j < 4; ++j) { u32x4 w;
#pragma unroll
            for (int k = 0; k < 4; ++k) w[k] = pk2(lv[8 * j + 2 * k] * rl, lv[8 * j + 2 * k + 1] * rl);
            lp[64 * j] = w; }
    }
}

constexpr int PIECE = 256;
__device__ __forceinline__ unsigned lane_xor1_u(unsigned v) { return (unsigned)__builtin_amdgcn_update_dpp(0, (int)v, 0xB1, 0xF, 0xF, false); }
__device__ __forceinline__ void convert_uv(Frame& F, const Args& A) {
    const int gw = F.vcu * NWAVES + F.wave, NGW = F.G * NWAVES, lane = F.lane;
    f32x4 vn[16];
    if (gw < 2 * NEXP) { const float* src = (gw < NEXP ? A.in[IN_U] + (size_t)gw * DM : A.in[IN_V] + (size_t)(gw - NEXP) * DM) + 4 * lane;
#pragma unroll
        for (int i = 0; i < 16; ++i) vn[i] = *(const f32x4*)(src + 256 * i); }
    for (int r = gw; r < 2 * NEXP; r += NGW) {
        const bool isu = r < NEXP; const int row = isu ? r : r - NEXP;
        f32x4 v[16]; float m = 0.f, ss = 0.f;
#pragma unroll
        for (int i = 0; i < 16; ++i) { const f32x4 x = vn[i]; v[i] = x;
            m = fmaxf(m, fmaxf(fmaxf(fabsf(x.x), fabsf(x.y)), fmaxf(fabsf(x.z), fabsf(x.w)))); ss += (x.x * x.x + x.y * x.y) + (x.z * x.z + x.w * x.w); }
        { const int rn = r + NGW;
          if (rn < 2 * NEXP) { const float* src = (rn < NEXP ? A.in[IN_U] + (size_t)rn * DM : A.in[IN_V] + (size_t)(rn - NEXP) * DM) + 4 * lane;
#pragma unroll
              for (int i = 0; i < 16; ++i) vn[i] = *(const f32x4*)(src + 256 * i); } }
        m = wave_max(m); ss = wave_sum(ss);
        const float rms = sqrtf(ss * (1.f / DM));
        const float step = isu ? fmaxf(fmaxf(0.49f * rms, m * (1.f / 12.f)), 1e-30f) : fmaxf(fmaxf(0.3352f * rms, m * (1.f / 15.f)), 1e-30f), inv = 1.f / step;
        unsigned char* tab = F.ws + (isu ? WS_UB : WS_VB);
        const bool odd = lane & 1;
#pragma unroll
        for (int i = 0; i < 16; ++i) {
            const float xs[4] = {v[i].x * inv, v[i].y * inv, v[i].z * inv, v[i].w * inv};
            unsigned w = 0;
            if (isu) {
#pragma unroll
                for (int k = 0; k < 4; ++k) { const float a = fabsf(xs[k]);
                    const unsigned c = (unsigned)(a > 0.25f) + (unsigned)(a > 0.75f) + (unsigned)(a > 1.25f) + (unsigned)(a > 1.75f) + (unsigned)(a > 2.5f) + (unsigned)(a > 3.5f) + (unsigned)(a > 5.f);
                    w |= (c | (xs[k] < 0.f ? 8u : 0u)) << (4 * k); }
                w = odd ? (w << 16) : w;
            } else {
#pragma unroll
                for (int k = 0; k < 4; ++k) { const unsigned n = (unsigned)min(max((int)floorf(xs[k]) + 8, 0), 15); w |= n << (8 * k); }
                w = odd ? ((w << 4) ^ 0x80808080u) : w;
            }
            w |= lane_xor1_u(w);
            if (!odd) *(unsigned*)(tab + ((size_t)(i >> 1) * NEXP + row) * PIECE + 128 * (i & 1) + 2 * lane) = w;
        }
        if (lane == 0) ((float*)(F.ws + (isu ? WS_SU : WS_SV)))[row] = step;
    }
}

__device__ __forceinline__ int lt_bits2(f32x2 v, f32x2 mid2) { const u32x2 u = __builtin_bit_cast(u32x2, v - mid2); return (int)((u.x >> 31) + (u.y >> 31)); }
__device__ __forceinline__ int lt_bit(float v, float mid) { return (int)(__float_as_uint(v - mid) >> 31); }
constexpr int CSTR = 17;
#define SKSWZ(row, colB) ((row) * 256 + ((colB) ^ (((row) & 7) << 4)))
__device__ __forceinline__ void topk_unit(Frame& F, const Args& A, int unit) {
    const int h = unit & 7, t0 = (unit >> 3) * 256 + F.wave * 32, lane = F.lane, j = lane & 31, hq = lane >> 5;
    const bf16_t* QP = (const bf16_t*)(F.ws + WS_QP); const bf16_t* SKB = (const bf16_t*)(F.ws + WS_SKB);
    LAS unsigned char* SKL = F.lds;
    LAS u32x2* CAND = (LAS u32x2*)(F.lds + 65536 + F.wave * (32 * 2 * CSTR * 8));
    __syncthreads();
    { const int row = F.tid >> 4, ch = F.tid & 15;
#pragma unroll
      for (int i = 0; i < 8; ++i) { const int rr = row + 32 * i;
          const u32x4 v = *(const u32x4*)(SKB + ((size_t)h * 256 + rr) * 128 + ch * 8);
          *(LAS u32x4*)(SKL + (rr >> 7) * 32768 + SKSWZ(rr & 127, ch * 16)) = v; } }
    __syncthreads();
    float rstd2;
    { const f32x4* sp = (const f32x4*)((const float*)(F.ws + WS_SSQ2) + (size_t)(t0 + j) * 64 + 32 * hq); float s = 0.f;
#pragma unroll
      for (int k = 0; k < 8; ++k) { const f32x4 v = sp[k]; s += (v.x + v.y) + (v.z + v.w); }
      s += __shfl_xor(s, 32);
      rstd2 = 1.f / sqrtf(s * (1.f / DM) + EPS);
      if (h == 0 && hq == 0) ((float*)(F.ws + WS_RSTD2))[t0 + j] = rstd2; }
#pragma nounroll
    for (int p = 0; p < 2; ++p) {
        f32x16 acc[4];
#pragma unroll
        for (int kt = 0; kt < 4; ++kt) acc[kt] = f32x16{};
        const bf16_t* qp = QP + (size_t)(t0 + j) * 2048 + h * 256 + p * 128 + 8 * hq;
        bf16x8 bq[8];
#pragma unroll
        for (int ks = 0; ks < 8; ++ks) bq[ks] = *(const bf16x8*)(qp + 16 * ks);
#pragma unroll
        for (int ks = 0; ks < 8; ++ks) {
#pragma unroll
            for (int kt = 0; kt < 4; ++kt) { const bf16x8 ak = *(const LAS bf16x8*)(SKL + p * 32768 + SKSWZ(32 * kt + j, (16 * ks + 8 * hq) * 2)); acc[kt] = __builtin_amdgcn_mfma_f32_32x32x16_bf16(ak, bq[ks], acc[kt], 0, 0, 0); } }
        float vmx = acc[0][0], vmn = acc[0][0];
#pragma unroll
        for (int kt = 0; kt < 4; ++kt)
#pragma unroll
            for (int r = 0; r < 16; ++r) { vmx = fmaxf(vmx, acc[kt][r]); vmn = fminf(vmn, acc[kt][r]); }
        vmx = fmaxf(vmx, __shfl_xor(vmx, 32)); vmn = fminf(vmn, __shfl_xor(vmn, 32));
        float lo = vmn, hi = vmx + 1.0f, T = vmn; int done = 0;
#pragma nounroll
        for (int iter = 0; iter < 64; ++iter) {
            if (!__any(done == 0)) break;
            const float mid = 0.5f * (lo + hi);
            int c4[4] = {0, 0, 0, 0}; const f32x2 mid2 = {mid, mid};
#pragma unroll
            for (int kt = 0; kt < 4; ++kt)
#pragma unroll
                for (int r = 0; r < 16; r += 2) c4[kt] += lt_bits2(f32x2{acc[kt][r], acc[kt][r + 1]}, mid2);
            int c = (c4[0] + c4[1]) + (c4[2] + c4[3]);
            c += __shfl_xor(c, 32); c = NKEYS - c;
            if (done == 0) {
                if (c == PTOPK) { T = mid; done = 1; }
                else if (mid <= lo || mid >= hi) { T = lo; done = 1; }
                else if (c > PTOPK) lo = mid; else hi = mid;
            }
        }
        if (done == 0) T = lo;
        int cm = 0;
#pragma unroll
        for (int kt = 0; kt < 4; ++kt)
#pragma unroll
            for (int r = 0; r < 16; ++r) cm += lt_bit(acc[kt][r], T);
        cm = 64 - cm;
        const int co = __shfl_xor(cm, 32);
        int slot = hq ? co : 0;
        f32x16 rowidx;
        { bf16x8 ac = {0, 0, 0, 0, 0, 0, 0, 0}, bc = {0, 0, 0, 0, 0, 0, 0, 0};
          if (hq == 0) { ac[0] = (short)f2bf((float)j); bc[0] = (short)0x3F80; }
          rowidx = __builtin_amdgcn_mfma_f32_32x32x16_bf16(ac, bc, f32x16{}, 0, 0, 0); }
        LAS u32x2* cb = CAND + (j * 2 + p) * CSTR;
#pragma unroll
        for (int kt = 0; kt < 4; ++kt)
#pragma unroll
            for (int r = 0; r < 16; ++r) { const float v = acc[kt][r];
                const int take = (1 - lt_bit(v, T)) & (int)((unsigned)(slot - PTOPK) >> 31);
                u32x2 w; w.x = __float_as_uint(v); w.y = (unsigned)(32 * kt + (int)rowidx[r]);
                cb[take ? slot : PTOPK] = w; slot += take; }
    }
    LDS_WAIT();
    float sv[16]; int si[16];
    { LAS u32x2* cb = CAND + (j * 2 + hq) * CSTR;
#pragma unroll
      for (int k = 0; k < 16; ++k) { const u32x2 w = cb[k]; sv[k] = __uint_as_float(w.x); si[k] = (int)w.y; } }
#pragma unroll
    for (int k = 2; k <= 16; k <<= 1)
#pragma unroll
        for (int jj = k >> 1; jj > 0; jj >>= 1)
#pragma unroll
            for (int i = 0; i < 16; ++i) { const int l = i ^ jj;
                if (l > i) { const bool desc = ((i & k) == 0); const bool sw = desc ? (sv[i] < sv[l]) : (sv[i] > sv[l]);
                    const float tv = sw ? sv[l] : sv[i], tw = sw ? sv[i] : sv[l]; const int ti = sw ? si[l] : si[i], tj = sw ? si[i] : si[l];
                    sv[i] = tv; sv[l] = tw; si[i] = ti; si[l] = tj; } }
    float s1[16], s2[16]; int i1[16], i2[16];
#pragma unroll
    for (int k = 0; k < 16; ++k) { const float ov = __shfl_xor(sv[k], 32); const int oi = __shfl_xor(si[k], 32);
        s1[k] = hq ? ov : sv[k]; s2[k] = hq ? sv[k] : ov; i1[k] = hq ? oi : si[k]; i2[k] = hq ? si[k] : oi; }
    float cs[50];
    { int q = 0;
#pragma unroll
      for (int a = 0; a < 16; ++a)
#pragma unroll
          for (int b2 = 0; b2 < 16; ++b2) if ((a + 1) * (b2 + 1) <= 16) { cs[q] = s1[a] + s2[b2]; ++q; } }
    float lo = fminf(s1[15] + s2[0], s1[0] + s2[15]), hi = s1[0] + s2[0] + 1.0f, T = lo; int done = 0;
#pragma nounroll
    for (int iter = 0; iter < 64; ++iter) {
        if (!__any(done == 0)) break;
        const float mid = 0.5f * (lo + hi);
        int c4[5] = {0, 0, 0, 0, 0};
#pragma unroll
        for (int q = 0; q < 50; ++q) c4[q % 5] += lt_bit(cs[q], mid);
        const int c = 50 - ((c4[0] + c4[1]) + (c4[2] + c4[3]) + c4[4]);
        if (done == 0) {
            if (c == PTOPK) { T = mid; done = 1; }
            else if (mid <= lo || mid >= hi) { T = lo; done = 1; }
            else if (c > PTOPK) lo = mid; else hi = mid;
        }
    }
    if (done == 0) T = lo;
    LAS u32x2* wb = CAND + (j * 2) * CSTR;
    if (hq == 0) { int slot = 0; int q = 0;
#pragma unroll
        for (int a = 0; a < 16; ++a)
#pragma unroll
            for (int b2 = 0; b2 < 16; ++b2) if ((a + 1) * (b2 + 1) <= 16) {
                const int take = (1 - lt_bit(cs[q], T)) & (int)((unsigned)(slot - PTOPK) >> 31);
                u32x2 w; w.x = __float_as_uint(cs[q]); w.y = (unsigned)(i1[a] * NKEYS + i2[b2]);
                wb[take ? slot : PTOPK] = w; slot += take; ++q; } }
    LDS_WAIT();
    float wv[16]; int wi[16]; float mx = -1e30f;
#pragma unroll
    for (int k = 0; k < 16; ++k) { const u32x2 w = wb[k]; wv[k] = __uint_as_float(w.x); wi[k] = (int)w.y; mx = fmaxf(mx, wv[k]); }
    float se = 0.f;
#pragma unroll
    for (int k = 0; k < 16; ++k) { wv[k] = __expf((wv[k] - mx) * rstd2); se += wv[k]; }
    const float inv = 1.f / se;
    int* IDX = (int*)(F.ws + WS_IDX) + (size_t)(t0 + j) * PE + h * PTOPK + 8 * hq; float* GT = (float*)(F.ws + WS_GATE) + (size_t)(t0 + j) * PE + h * PTOPK + 8 * hq;
    float* SUT = (float*)(F.ws + WS_SUT) + (size_t)(t0 + j) * PE + h * PTOPK + 8 * hq; float* GS = (float*)(F.ws + WS_GS) + (size_t)(t0 + j) * PE + h * PTOPK + 8 * hq;
#pragma unroll
    for (int k = 0; k < 8; ++k) { const int id = hq ? wi[8 + k] : wi[k]; const float gte = (hq ? wv[8 + k] : wv[k]) * inv;
        IDX[k] = id; GT[k] = gte; SUT[k] = ((const float*)(F.ws + WS_SU))[id]; GS[k] = gte * ((const float*)(F.ws + WS_SV))[id]; }
    LDS_WAIT();
}

__device__ __forceinline__ int row_sum16(int v) {
    v += __builtin_amdgcn_update_dpp(0, v, 0xB1, 0xF, 0xF, false);
    v += __builtin_amdgcn_update_dpp(0, v, 0x4E, 0xF, 0xF, false);
    v += __builtin_amdgcn_update_dpp(0, v, 0x141, 0xF, 0xF, false);
    v += __builtin_amdgcn_update_dpp(0, v, 0x128, 0xF, 0xF, false);
    return v;
}
typedef int i32x8 __attribute__((ext_vector_type(8)));
struct PeerUMeta { u32x4 hv; int id0, id1; float rstd2; };
__device__ __forceinline__ void peer_u_meta(Frame& F, int t, int x, PeerUMeta& M) {
    const int lane = F.lane;
    const bf16_t* H1B = (const bf16_t*)(F.ws + WS_XN);
    M.hv = *(const u32x4*)(H1B + (size_t)t * DM + 512 * x + 8 * lane);
    const int* IDX = (const int*)(F.ws + WS_IDX) + (size_t)t * PE;
    M.id0 = IDX[lane]; M.id1 = IDX[64 + lane]; M.rstd2 = ((const float*)(F.ws + WS_RSTD2))[t];
}
__device__ __forceinline__ int wave_sum_i(int v) { v = row_sum16(v); v += __shfl_xor(v, 16); v += __shfl_xor(v, 32); return v; }
__device__ __forceinline__ int row_max16i(int v) {
    v = max(v, __builtin_amdgcn_update_dpp(0, v, 0xB1, 0xF, 0xF, false)); v = max(v, __builtin_amdgcn_update_dpp(0, v, 0x4E, 0xF, 0xF, false));
    v = max(v, __builtin_amdgcn_update_dpp(0, v, 0x141, 0xF, 0xF, false)); v = max(v, __builtin_amdgcn_update_dpp(0, v, 0x128, 0xF, 0xF, false));
    return v;
}
__device__ __forceinline__ float quad_swap1(float v) { return __builtin_bit_cast(float, __builtin_amdgcn_update_dpp(0, __builtin_bit_cast(int, v), 0xB1, 0xF, 0xF, false)); }
#ifndef PROBE_MODE
#define PROBE_MODE 0
#endif
__device__ __forceinline__ float quad_swap2(float v) { return __builtin_bit_cast(float, __builtin_amdgcn_update_dpp(0, __builtin_bit_cast(int, v), 0x4E, 0xF, 0xF, false)); }
__device__ __forceinline__ float row_ror4(float v) { return __builtin_bit_cast(float, __builtin_amdgcn_update_dpp(0, __builtin_bit_cast(int, v), 0x124, 0xF, 0xF, false)); }
__device__ __forceinline__ void peer_u_issue(const unsigned char* UBs, int idv, int lane, u32x4 (&w)[16]) {
    const int ei = lane & 15, gk = lane >> 4, r4 = ei >> 2, quarter = ei & 3;
#pragma unroll
    for (int b = 0; b < 16; ++b) { const int row = __builtin_amdgcn_ds_bpermute((16 * r4 + b) * 4, idv);
        w[b] = *(const u32x4*)(UBs + (((unsigned)row << 8) + 64u * (unsigned)gk + 16u * (unsigned)quarter)); }
}
__device__ __forceinline__ float sel4(float a, float b, float c, float d, unsigned m0, unsigned m1, unsigned m2, unsigned m3) {
    return __builtin_bit_cast(float, (__builtin_bit_cast(unsigned, a) & m0) | (__builtin_bit_cast(unsigned, b) & m1) | (__builtin_bit_cast(unsigned, c) & m2) | (__builtin_bit_cast(unsigned, d) & m3)); }
__device__ __forceinline__ void peer_u_consume(const u32x4 (&w)[16], const i32x8& B, int lane, unsigned m0, unsigned m1, unsigned m2, unsigned m3, float& keep) {
    const int ei = lane & 15; const bool q1 = (lane >> 1) & 1, q2 = (lane >> 2) & 1;
#pragma unroll
    for (int b0 = 0; b0 < 16; b0 += 4) {
        f32x4 D[4];
#pragma unroll
        for (int k = 0; k < 4; ++k) { const f32x4 z = {0.f, 0.f, 0.f, 0.f};
            const i32x8 a = {(int)w[b0 + k].x, (int)w[b0 + k].y, (int)w[b0 + k].z, (int)w[b0 + k].w, 0, 0, 0, 0};
            D[k] = __builtin_amdgcn_mfma_scale_f32_16x16x128_f8f6f4(a, B, z, 4, 0, 0, 0x7f7f7f7f, 0, 0x7f7f7f7f); }
        __builtin_amdgcn_sched_barrier(0);
        float v[4];
#pragma unroll
        for (int k = 0; k < 4; ++k) { const float lo = q1 ? D[k].y : D[k].x, hi = q1 ? D[k].w : D[k].z; v[k] = q2 ? hi : lo; }
#pragma unroll
        for (int k = 0; k < 4; ++k) v[k] += quad_swap1(v[k]);
#pragma unroll
        for (int k = 0; k < 4; ++k) v[k] += quad_swap2(v[k]);
#pragma unroll
        for (int k = 0; k < 4; ++k) v[k] += row_ror4(v[k]);
#pragma unroll
        for (int k = 0; k < 4; ++k) keep = (ei == b0 + k) ? v[k] : keep;
    }
}
__device__ __forceinline__ float peer_u_xquant(Frame& F, const PeerUMeta& M, const float (&g2s)[8], i32x8& B, int xboff = 0) {
    const int lane = F.lane, ei = lane & 15, g = lane >> 4, qn = ei & 3;
    LAS unsigned char* XB = F.lds + F.wave * 2048 + xboff;
    float xf[8];
    { const float rs = M.rstd2; const u32x4 hv = M.hv;
      xf[0] = bflo(hv.x) * rs * g2s[0]; xf[1] = bfhi(hv.x) * rs * g2s[1]; xf[2] = bflo(hv.y) * rs * g2s[2]; xf[3] = bfhi(hv.y) * rs * g2s[3];
      xf[4] = bflo(hv.z) * rs * g2s[4]; xf[5] = bfhi(hv.z) * rs * g2s[5]; xf[6] = bflo(hv.w) * rs * g2s[6]; xf[7] = bfhi(hv.w) * rs * g2s[7]; }
    float m = 0.f;
#pragma unroll
    for (int i = 0; i < 8; ++i) m = fmaxf(m, fabsf(xf[i]));
    int mi = row_max16i(__builtin_bit_cast(int, m)); mi = max(mi, __shfl_xor(mi, 16)); mi = max(mi, __shfl_xor(mi, 32));
    m = fmaxf(__builtin_bit_cast(float, mi), 1e-30f); const float sx = m * (1.f / 224.f), inv = 224.f * __builtin_amdgcn_rcpf(m);
    { u32x2 hi;
#pragma unroll
      for (int d = 0; d < 2; ++d) { int h = __builtin_amdgcn_cvt_pk_fp8_f32(xf[4 * d] * inv, xf[4 * d + 1] * inv, 0, false); h = __builtin_amdgcn_cvt_pk_fp8_f32(xf[4 * d + 2] * inv, xf[4 * d + 3] * inv, h, true); hi[d] = (unsigned)h; }
      *(LAS u32x2*)(XB + 8 * lane) = hi; }
    LDS_WAIT();
    { LAS const unsigned char* p = XB + 128 * (g >> 1) + 32 * qn + 16 * (g & 1);
      const u32x4 b0 = *(LAS const u32x4*)p, b1 = *(LAS const u32x4*)(p + 256);
      B = i32x8{(int)b0.x, (int)b0.y, (int)b0.z, (int)b0.w, (int)b1.x, (int)b1.y, (int)b1.z, (int)b1.w}; }
    LDS_WAIT();
    return sx;
}
__device__ __forceinline__ void peer_u_meta_async(Frame& F, int t, int x, PeerUMeta& M) {
    const int lane = F.lane;
    const bf16_t* hp = (const bf16_t*)(F.ws + WS_XN) + (size_t)t * DM + 512 * x + 8 * lane;
    const int* ip = (const int*)(F.ws + WS_IDX) + (size_t)t * PE + lane; const float* rp = (const float*)(F.ws + WS_RSTD2) + t;
    asm volatile("global_load_dwordx4 %0, %1, off" : "=v"(M.hv) : "v"(hp) : "memory");
    asm volatile("global_load_dword %0, %1, off" : "=v"(M.id0) : "v"(ip) : "memory");
    asm volatile("global_load_dword %0, %1, off offset:256" : "=v"(M.id1) : "v"(ip) : "memory");
    asm volatile("global_load_dword %0, %1, off" : "=v"(M.rstd2) : "v"(rp) : "memory");
}
struct UStream { u32x4 w[8]; i32x8 B, Bn; PeerUMeta M, Mn; float keep0, keep1, sx, sxn; };
template <int G> __device__ __forceinline__ void us_issue(const unsigned char* UBs, int id0, int id1, int lane, u32x4 (&w)[8]) {
    const int ei = lane & 15, gk = lane >> 4, r4 = ei >> 2, quarter = ei & 3; const int idv = (G < 4) ? id0 : id1;
#pragma unroll
    for (int k = 0; k < 4; ++k) { const int row = __builtin_amdgcn_ds_bpermute((16 * r4 + 4 * (G & 3) + k) * 4, idv);
        w[4 * (G & 1) + k] = *(const u32x4*)(UBs + (((unsigned)row << 8) + 64u * (unsigned)gk + 16u * (unsigned)quarter)); }
}
template <int G> __device__ __forceinline__ void us_consume(UStream& S, int lane) {
    const int ei = lane & 15; const bool q1 = lane & 1, q2 = (lane >> 1) & 1;
    f32x4 D[4];
#pragma unroll
    for (int k = 0; k < 4; ++k) { const f32x4 z = {0.f, 0.f, 0.f, 0.f}; const u32x4 wv = S.w[4 * (G & 1) + k];
        const i32x8 a = {(int)wv.x, (int)wv.y, (int)wv.z, (int)wv.w, 0, 0, 0, 0};
        D[k] = __builtin_amdgcn_mfma_scale_f32_16x16x128_f8f6f4(a, S.B, z, 4, 0, 0, 0x7f7f7f7f, 0, 0x7f7f7f7f); }
    float v[4];
#pragma unroll
    for (int k = 0; k < 4; ++k) { const float lo = q1 ? D[k].y : D[k].x, hi = q1 ? D[k].w : D[k].z; v[k] = q2 ? hi : lo; }
#pragma unroll
    for (int k = 0; k < 4; ++k) v[k] += quad_swap1(v[k]);
#pragma unroll
    for (int k = 0; k < 4; ++k) v[k] += quad_swap2(v[k]);
#pragma unroll
    for (int k = 0; k < 4; ++k) { if (G < 4) S.keep0 = (ei == 4 * (G & 3) + k) ? v[k] : S.keep0; else S.keep1 = (ei == 4 * (G & 3) + k) ? v[k] : S.keep1; }
}
template <bool DRY> __device__ __forceinline__ void peer_u_loop(Frame& F, int x, int tb, int tstep, const float (&g2s)[8]) {
    const int lane = F.lane;
    const unsigned char* UBs = F.ws + WS_UB + (size_t)x * NEXP * PIECE;
    UStream SA, SB;
    peer_u_meta(F, tb, x, SA.M); peer_u_meta(F, (tb + tstep < MR) ? tb + tstep : tb, x, SB.M); SA.Mn = SA.M; SB.Mn = SB.M;
    us_issue<0>(UBs, SA.M.id0, SA.M.id1, lane, SA.w); us_issue<0>(UBs, SB.M.id0, SB.M.id1, lane, SB.w);
    us_issue<1>(UBs, SA.M.id0, SA.M.id1, lane, SA.w); us_issue<1>(UBs, SB.M.id0, SB.M.id1, lane, SB.w);
    SA.sx = peer_u_xquant(F, SA.M, g2s, SA.B, 0); SB.sx = peer_u_xquant(F, SB.M, g2s, SB.B, 1024);
    SA.Bn = SA.B; SB.Bn = SB.B; SA.sxn = SA.sx; SB.sxn = SB.sx;
#pragma nounroll
    for (int t = tb; t < MR; t += 2 * tstep) {
        const bool more = t + 2 * tstep < MR;
        if (more) { peer_u_meta_async(F, t + 2 * tstep, x, SA.Mn); peer_u_meta_async(F, (t + 3 * tstep < MR) ? t + 3 * tstep : t + 2 * tstep, x, SB.Mn); }
        SA.keep0 = SA.keep1 = SB.keep0 = SB.keep1 = 0.f;
#define US_STEP(G) do { us_consume<G>(SA, lane); us_consume<G>(SB, lane); \
        if ((G) + 2 < 8) { us_issue<((G) + 2) & 7>(UBs, SA.M.id0, SA.M.id1, lane, SA.w); us_issue<((G) + 2) & 7>(UBs, SB.M.id0, SB.M.id1, lane, SB.w); } \
        else { us_issue<((G) + 2) & 7>(UBs, SA.Mn.id0, SA.Mn.id1, lane, SA.w); us_issue<((G) + 2) & 7>(UBs, SB.Mn.id0, SB.Mn.id1, lane, SB.w); } \
        __builtin_amdgcn_sched_barrier(0); } while (0)
        US_STEP(0); US_STEP(1); US_STEP(2); US_STEP(3);
        SA.sxn = peer_u_xquant(F, SA.Mn, g2s, SA.Bn, 0); SB.sxn = peer_u_xquant(F, SB.Mn, g2s, SB.Bn, 1024);
        __builtin_amdgcn_sched_barrier(0);
        US_STEP(4); US_STEP(5); US_STEP(6); US_STEP(7);
#undef US_STEP
        if constexpr (!DRY) { float* pa = (float*)(F.ws + WS_PACT) + ((size_t)t * 8 + x) * PE; float* pb = (float*)(F.ws + WS_PACT) + ((size_t)(t + tstep) * 8 + x) * PE;
            pa[lane] = SA.keep0 * SA.sx; pa[64 + lane] = SA.keep1 * SA.sx; if (t + tstep < MR) { pb[lane] = SB.keep0 * SB.sx; pb[64 + lane] = SB.keep1 * SB.sx; } }
        else asm volatile("" :: "v"(SA.keep0), "v"(SA.keep1), "v"(SB.keep0), "v"(SB.keep1));
        asm volatile("" : "+v"(SA.Mn.hv), "+v"(SA.Mn.id0), "+v"(SA.Mn.id1), "+v"(SA.Mn.rstd2), "+v"(SB.Mn.hv), "+v"(SB.Mn.id0), "+v"(SB.Mn.id1), "+v"(SB.Mn.rstd2));
        SA.M = SA.Mn; SB.M = SB.Mn; SA.B = SA.Bn; SB.B = SB.Bn; SA.sx = SA.sxn; SB.sx = SB.sxn;
    }
}
typedef int i32x4 __attribute__((ext_vector_type(4)));
struct PeerVRest { unsigned wdw; float sw; int qw; u32x4 hv; };
struct PeerVIds { int id0, id1; };
__device__ __forceinline__ void peer_v_ids(Frame& F, int t, PeerVIds& I) { const int* IDX = (const int*)(F.ws + WS_IDX) + (size_t)t * PE; I.id0 = IDX[F.lane]; I.id1 = IDX[64 + F.lane]; }
__device__ __forceinline__ void peer_v_rest(Frame& F, int t, int x, PeerVRest& R) {
    const int lane = F.lane, r = lane >> 4, sp = lane & 15;
    R.wdw = ((const unsigned*)(F.ws + WS_WQ))[(size_t)t * 32 + (lane & 31)];
    const u32x2 sq = ((const u32x2*)(F.ws + WS_SWQ))[t]; R.sw = __builtin_bit_cast(float, sq.x); R.qw = (int)sq.y;
    R.hv = *(const u32x4*)((const bf16_t*)(F.ws + WS_XN) + (size_t)t * DM + 512 * x + 32 * sp + 8 * r);
}
__device__ __forceinline__ void peer_v_ids_async(Frame& F, int t, PeerVIds& I) {
    const int* ip = (const int*)(F.ws + WS_IDX) + (size_t)t * PE + F.lane;
    asm volatile("global_load_dword %0, %1, off" : "=v"(I.id0) : "v"(ip) : "memory");
    asm volatile("global_load_dword %0, %1, off offset:256" : "=v"(I.id1) : "v"(ip) : "memory");
}
__device__ __forceinline__ void peer_v_rest_async(Frame& F, int t, int x, PeerVRest& R) {
    const int lane = F.lane, r = lane >> 4, sp = lane & 15;
    const unsigned* wp = (const unsigned*)(F.ws + WS_WQ) + (size_t)t * 32 + (lane & 31);
    const unsigned* qp = (const unsigned*)(F.ws + WS_SWQ) + (size_t)t * 2;
    const bf16_t* hp = (const bf16_t*)(F.ws + WS_XN) + (size_t)t * DM + 512 * x + 32 * sp + 8 * r;
    asm volatile("global_load_dword %0, %1, off" : "=v"(R.wdw) : "v"(wp) : "memory");
    asm volatile("global_load_dword %0, %1, off" : "=v"(R.sw) : "v"(qp) : "memory");
    asm volatile("global_load_dword %0, %1, off offset:4" : "=v"(R.qw) : "v"(qp) : "memory");
    asm volatile("global_load_dwordx4 %0, %1, off" : "=v"(R.hv) : "v"(hp) : "memory");
}
__device__ __forceinline__ void peer_v_pin(PeerVRest& R) { asm volatile("" : "+v"(R.wdw), "+v"(R.sw), "+v"(R.qw), "+v"(R.hv)); }
__device__ __forceinline__ void peer_v_prologue(Frame& F, const PeerVRest& R, float& sw, int& qw) {
    LAS unsigned* QW8 = (LAS unsigned*)(F.lds + F.wave * 256);
    if (F.lane < 32) QW8[F.lane] = R.wdw;
    sw = R.sw; qw = R.qw;
    LDS_WAIT();
}
__device__ __forceinline__ void peer_w_pass(Frame& F) {
    const int gw = F.vcu * NWAVES + F.wave, NGW = F.G * NWAVES, lane = F.lane;
    for (int t = gw; t < MR; t += NGW) {
        const float* SUT = (const float*)(F.ws + WS_SUT) + (size_t)t * PE; const float* GS = (const float*)(F.ws + WS_GS) + (size_t)t * PE;
        const float su0 = SUT[lane], su1 = SUT[64 + lane], gs0 = GS[lane], gs1 = GS[64 + lane];
        const float* pa = (const float*)(F.ws + WS_PACT) + (size_t)t * 8 * PE;
        float a0 = 0.f, a1 = 0.f;
#pragma unroll
        for (int xx = 0; xx < 8; ++xx) { a0 += pa[xx * PE + lane]; a1 += pa[xx * PE + 64 + lane]; }
        const float w0 = gs0 * gelu_tanh(a0 * su0), w1 = gs1 * gelu_tanh(a1 * su1);
        int wmi = row_max16i(__builtin_bit_cast(int, fmaxf(fabsf(w0), fabsf(w1)))); wmi = max(wmi, __shfl_xor(wmi, 16)); wmi = max(wmi, __shfl_xor(wmi, 32));
        const float wm = fmaxf(__builtin_bit_cast(float, wmi), 1e-30f); const float sw = wm * (1.f / 127.f), winv = 127.f * __builtin_amdgcn_rcpf(wm);
        const int q0 = max(min((int)__builtin_rintf(w0 * winv), 127), -127), q1 = max(min((int)__builtin_rintf(w1 * winv), 127), -127);
        const int qw = wave_sum_i(q0 + q1);
        unsigned char* WQ = F.ws + WS_WQ + (size_t)t * 128;
        WQ[((lane >> 4) * 4 + (lane & 3)) * 4 + ((lane >> 2) & 3)] = (unsigned char)(q0 & 0xff);
        WQ[(((64 + lane) >> 4) * 4 + (lane & 3)) * 4 + ((lane >> 2) & 3)] = (unsigned char)(q1 & 0xff);
        if (lane == 0) { u32x2 sq; sq.x = __builtin_bit_cast(unsigned, sw); sq.y = (unsigned)qw; ((u32x2*)(F.ws + WS_SWQ))[t] = sq; }
    }
}
template <bool DRY> __device__ __forceinline__ void peer_v_issue4(const unsigned char* VBs, int idv, int lane, int gg, u32x4 (&w)[16]) {
    const int r = lane >> 4, sp = lane & 15;
#pragma unroll
    for (int k = 0; k < 4; ++k) { const int q = 4 * gg + k; const int row = __builtin_amdgcn_ds_bpermute((4 * q + r) * 4, idv);
#if PROBE_MODE == 1
        if constexpr (DRY) { const unsigned ur = (unsigned)row + r; w[q] = u32x4{ur, ur * 3u, ur * 5u, ur * 7u}; } else
#endif
        w[q] = *(const u32x4*)(VBs + (((unsigned)row << 8) + 16u * (unsigned)sp)); }
}
template <bool DRY> __device__ __forceinline__ void peer_v_round(Frame& F, const unsigned char* VBs, u32x4 (&w)[16], int h, int idv_next, int lane, const unsigned (&sel)[4], i32x4 (&Dl)[4], i32x4 (&Dh)[4]) {
    const int r = lane >> 4;
    LAS const unsigned char* QW8 = F.lds + F.wave * 256;
#pragma unroll
    for (int gg = 0; gg < 4; ++gg) {
        i32x4 blo[4], bhi[4];
#pragma unroll
        for (int j = 0; j < 4; ++j) {
            blo[j] = i32x4{(int)(w[4 * gg][j] & 0x0F0F0F0Fu), (int)(w[4 * gg + 1][j] & 0x0F0F0F0Fu), (int)(w[4 * gg + 2][j] & 0x0F0F0F0Fu), (int)(w[4 * gg + 3][j] & 0x0F0F0F0Fu)};
            bhi[j] = i32x4{(int)(w[4 * gg][j] & 0xF0F0F0F0u), (int)(w[4 * gg + 1][j] & 0xF0F0F0F0u), (int)(w[4 * gg + 2][j] & 0xF0F0F0F0u), (int)(w[4 * gg + 3][j] & 0xF0F0F0F0u)}; }
        __builtin_amdgcn_sched_barrier(0);
        peer_v_issue4<DRY>(VBs, idv_next, lane, gg, w);
        __builtin_amdgcn_sched_barrier(0);
#if PROBE_MODE == 2
        if constexpr (DRY) { _Pragma("unroll") for (int j = 0; j < 4; ++j) { Dl[j].x ^= blo[j].x ^ blo[j].y ^ blo[j].z ^ blo[j].w; Dh[j].x ^= bhi[j].x ^ bhi[j].y ^ bhi[j].z ^ bhi[j].w; } continue; }
#endif
        const unsigned wpk = *(const LAS unsigned*)(QW8 + ((4 * h + gg) * 4 + r) * 4);
        const i32x4 a = {(int)__builtin_amdgcn_perm(wpk, wpk, sel[0]), (int)__builtin_amdgcn_perm(wpk, wpk, sel[1]), (int)__builtin_amdgcn_perm(wpk, wpk, sel[2]), (int)__builtin_amdgcn_perm(wpk, wpk, sel[3])};
#pragma unroll
        for (int j = 0; j < 4; ++j) { Dl[j] = __builtin_amdgcn_mfma_i32_16x16x64_i8(a, blo[j], Dl[j], 0, 0, 0); Dh[j] = __builtin_amdgcn_mfma_i32_16x16x64_i8(a, bhi[j], Dh[j], 0, 0, 0); }
        __builtin_amdgcn_sched_barrier(0);
    }
}
__device__ __forceinline__ int sel4i(int a, int b, int c, int d, unsigned m0, unsigned m1, unsigned m2, unsigned m3) { return (int)(((unsigned)a & m0) | ((unsigned)b & m1) | ((unsigned)c & m2) | ((unsigned)d & m3)); }
template <bool DRY> __device__ __forceinline__ void peer_v_loop(Frame& F, int x, int tb, int tstep) {
    const int lane = F.lane, r = lane >> 4, sp = lane & 15;
    const unsigned char* VBs = F.ws + WS_VB + (size_t)x * NEXP * PIECE;
    unsigned sel[4];
#pragma unroll
    for (int e = 0; e < 4; ++e) sel[e] = (0x0C0C0C0Cu & ~(0xFFu << (8 * (lane & 3)))) | ((unsigned)e << (8 * (lane & 3)));
    unsigned m0 = r == 0 ? ~0u : 0u, m1 = r == 1 ? ~0u : 0u, m2 = r == 2 ? ~0u : 0u, m3 = r == 3 ? ~0u : 0u;
    asm volatile("" : "+v"(m0), "+v"(m1), "+v"(m2), "+v"(m3));
    PeerVIds I, In, I2; PeerVRest R, Rn;
    peer_v_ids(F, tb, I); peer_v_ids(F, tb + tstep, In); I2 = In;
    peer_v_rest(F, tb, x, R); Rn = R;
    u32x4 w[16];
#pragma unroll
    for (int gg = 0; gg < 4; ++gg) peer_v_issue4<DRY>(VBs, I.id0, lane, gg, w);
    float sw; int qw; u32x4 hv = R.hv;
    peer_v_prologue(F, R, sw, qw);
#pragma nounroll
    for (int t = tb; t < MR; t += tstep) {
        const bool more = t + tstep < MR;
        if (more) peer_v_rest_async(F, t + tstep, x, Rn);
        if (t + 2 * tstep < MR) peer_v_ids_async(F, t + 2 * tstep, I2);
        i32x4 Dl[4], Dh[4];
#pragma unroll
        for (int j = 0; j < 4; ++j) { Dl[j] = i32x4{0, 0, 0, 0}; Dh[j] = i32x4{0, 0, 0, 0}; }
        peer_v_round<DRY>(F, VBs, w, 0, I.id1, lane, sel, Dl, Dh);
        peer_v_round<DRY>(F, VBs, w, 1, In.id0, lane, sel, Dl, Dh);
        if constexpr (!DRY) {
            int a8[8]; const bool r1 = r & 1, r2 = (r >> 1) & 1;
#define SEL4R(A0, A1, A2, A3) (r2 ? (r1 ? (A3) : (A2)) : (r1 ? (A1) : (A0)))
            a8[0] = SEL4R(Dl[0].x, Dl[1].x, Dl[2].x, Dl[3].x); a8[1] = SEL4R(Dl[0].y, Dl[1].y, Dl[2].y, Dl[3].y);
            a8[2] = SEL4R(Dl[0].z, Dl[1].z, Dl[2].z, Dl[3].z); a8[3] = SEL4R(Dl[0].w, Dl[1].w, Dl[2].w, Dl[3].w);
            a8[4] = SEL4R(Dh[0].x, Dh[1].x, Dh[2].x, Dh[3].x); a8[5] = SEL4R(Dh[0].y, Dh[1].y, Dh[2].y, Dh[3].y);
            a8[6] = SEL4R(Dh[0].z, Dh[1].z, Dh[2].z, Dh[3].z); a8[7] = SEL4R(Dh[0].w, Dh[1].w, Dh[2].w, Dh[3].w);
#undef SEL4R
            const float c75 = 7.5f * (float)qw, c05 = 0.5f * (float)qw;
            f32x4 o0, o1;
            o0.x = bflo(hv.x) + sw * ((float)a8[0] - c75); o0.y = bfhi(hv.x) + sw * ((float)a8[1] - c75); o0.z = bflo(hv.y) + sw * ((float)a8[2] - c75); o0.w = bfhi(hv.y) + sw * ((float)a8[3] - c75);
            o1.x = bflo(hv.z) + sw * ((float)(a8[4] >> 4) + c05); o1.y = bfhi(hv.z) + sw * ((float)(a8[5] >> 4) + c05); o1.z = bflo(hv.w) + sw * ((float)(a8[6] >> 4) + c05); o1.w = bfhi(hv.w) + sw * ((float)(a8[7] >> 4) + c05);
            float* op = F.out + (size_t)t * DM + 512 * x + 32 * sp + 8 * r;
            __builtin_nontemporal_store(o0, (f32x4*)op); __builtin_nontemporal_store(o1, (f32x4*)(op + 4));
        } else { _Pragma("unroll") for (int j = 0; j < 4; ++j) asm volatile("" :: "v"(Dl[j]), "v"(Dh[j])); }
        if (more) { peer_v_pin(Rn); hv = Rn.hv; peer_v_prologue(F, Rn, sw, qw); }
        asm volatile("" : "+v"(I2.id0), "+v"(I2.id1));
        I = In; In = I2;
    }
}

template <int ONLY> __global__ void __launch_bounds__(NWAVES * 64, 2) mega(Args args) {
    extern __shared__ __attribute__((aligned(16))) unsigned char lds[];
    Frame F;
    F.lds = (LAS unsigned char*)lds; F.ldsg = (char*)lds;
    F.tid = threadIdx.x; F.lane = F.tid & 63; F.wave = __builtin_amdgcn_readfirstlane(F.tid >> 6);
    F.G = gridDim.x; { const int bx = blockIdx.x; F.vcu = (F.G % 8 == 0) ? (bx % 8) * (F.G / 8) + bx / 8 : bx; }
    F.out = args.out; F.ws = args.ws;
    const int lo = args.ph_lo, hi = args.ph_hi;
#define IN(k) ((ONLY < 0 || ONLY == (k)) && lo <= (k) && (k) < hi)
    XcdBarrier bar; bar.bar = nullptr; bar.x = 0; bar.st = nullptr;
    if constexpr (ONLY < 0) {
        volatile LAS unsigned* MISC = (volatile LAS unsigned*)(F.lds + LDS_MISC);
        if (F.tid < 64) MISC[F.tid] = 0u;
        __syncthreads();
        bar = xcd_barrier_post((unsigned*)(F.ws + WS_CTL) + 4096, MISC + 8);
    }
#ifndef PROBE_REPEAT
#define PROBE_REPEAT 0
#endif
#define NREP(k) (((PROBE_REPEAT >> (k)) & 1) ? 2 : 1)
#define SEAM(k) do { if constexpr (ONLY < 0) { if (IN(k) && IN((k) + 1)) xcd_barrier(bar); } } while (0)

    if (IN(0)) { for (int rep = 0; rep < NREP(0); ++rep) { p0_prologue(F, args); if (rep + 1 < NREP(0)) xcd_barrier(bar); } }
    SEAM(0);
    if (IN(1)) for (int rep = 0; rep < NREP(1); ++rep) {
        if (rep) xcd_barrier(bar);
        p1_meta_gemm(F, args);
        pg8::Gemm g{(const bf16_t*)(F.ws + WS_XN), (const bf16_t*)(F.ws + WS_WT1), MR, INC, DM}; pg8::StaticOrder S; S.init(MR, INC, F.G, (int)blockIdx.x);
        pg8::EpiBf16 E{(bf16_t*)(F.ws + WS_Z), INC};
        pg8::gemm_phase<pg8::EpiBf16>(F.lds, g, S, E);
    }
    SEAM(1);
    if (IN(2)) {
        for (int rep = 0; rep < NREP(2); ++rep) { if (rep) xcd_barrier(bar); for (int u = F.vcu; u < 256; u += F.G) { if (u & 1) scan_unit<1>(F, args, u); else scan_unit<0>(F, args, u); } }
        normrope_rows(F, args);
    }
    SEAM(2);
    if (IN(3)) for (int rep = 0; rep < NREP(3); ++rep) {
        if (rep) xcd_barrier(bar);
        const bf16_t* Z = (const bf16_t*)(F.ws + WS_Z); const bf16_t* KP = (const bf16_t*)(F.ws + WS_KP); const bf16_t* VP = (const bf16_t*)(F.ws + WS_VP); bf16_t* MRG = (bf16_t*)(F.ws + WS_MRG);
        for (int u = F.vcu; u < NB * NQ * (SEQ / 256); u += F.G) {
            const int grp = u >> 6, within = u & 63, b = grp >> 2, kvh = grp & 3, hq = within >> 4, qb = within & 15, h = kvh * 4 + hq;
            att::attn_unit(Z + (size_t)(b * SEQ + qb * 256) * INC + h * HD, KP + (size_t)(b * NKV + kvh) * KPAD * HD, VP + (size_t)(b * NKV + kvh) * KPAD * HD,
                           MRG + (size_t)(b * SEQ + qb * 256) * DM + h * HD, F.ldsg, qb * 256, args.in[IN_QG], (const f32x2*)(F.ws + WS_ROPE));
        }
    }
    SEAM(3);
    if (IN(4)) { combine_rows(F, args); }
    SEAM(4);
    if (IN(5)) for (int rep = 0; rep < NREP(5); ++rep) {
        if (rep) xcd_barrier(bar);
        pg8::Gemm g{(const bf16_t*)(F.ws + WS_MRG), (const bf16_t*)(F.ws + WS_WT2), MR, DM, DM}; pg8::StaticOrder S; S.init(MR, DM, F.G, (int)blockIdx.x);
        pg8::EpiResid E{args.in[IN_X], F.out, (bf16_t*)(F.ws + WS_XN), (float*)(F.ws + WS_SSQ2), DM};
        pg8::gemm_phase<pg8::EpiResid>(F.lds, g, S, E);
    }
    SEAM(5);
    if (IN(6)) for (int rep = 0; rep < NREP(6); ++rep) {
        if (rep) xcd_barrier(bar);
        convert_uv(F, args);
        pg8::Gemm g{(const bf16_t*)(F.ws + WS_XN), (const bf16_t*)(F.ws + WS_WT3), MR, 2048, DM}; pg8::StaticOrder S; S.init(MR, 2048, F.G, (int)blockIdx.x);
        pg8::EpiBf16 E{(bf16_t*)(F.ws + WS_QP), 2048};
        pg8::gemm_phase<pg8::EpiBf16>(F.lds, g, S, E);
    }
    SEAM(6);
    if (IN(7)) { for (int rep = 0; rep < NREP(7); ++rep) { if (rep) xcd_barrier(bar); for (int u = F.vcu; u < MR / 32; u += F.G) topk_unit(F, args, u); } }
    SEAM(7);
    if (IN(8)) {
        const int x = (int)blockIdx.x & 7, y = (int)blockIdx.x >> 3, ny = F.G >> 3;
        float g2s[8];
#pragma unroll
        for (int i = 0; i < 8; ++i) g2s[i] = args.in[IN_G2][512 * x + 8 * F.lane + i];
        const int tstep = ny * NWAVES;
        if (NREP(8) == 2) { peer_u_loop<true>(F, x, y * NWAVES + F.wave, tstep, g2s); xcd_barrier(bar); }
        peer_u_loop<false>(F, x, y * NWAVES + F.wave, tstep, g2s);
    }
    SEAM(8);
    if (IN(9)) { for (int rep = 0; rep < NREP(9); ++rep) { if (rep) xcd_barrier(bar); peer_w_pass(F); } }
    SEAM(9);
    if (IN(10)) {
        const int x = (int)blockIdx.x & 7, y = (int)blockIdx.x >> 3, ny = F.G >> 3; const int tstep = ny * NWAVES;
        if (NREP(10) == 2) { peer_v_loop<true>(F, x, y * NWAVES + F.wave, tstep); xcd_barrier(bar); }
        peer_v_loop<false>(F, x, y * NWAVES + F.wave, tstep);
    }
#undef IN
#undef SEAM
}

template <int P> static void launch_phase(int grid, hipStream_t stream, Args a) {
    static bool attr = false;
    if (!attr) { if (hipFuncSetAttribute((const void*)mega<P>, hipFuncAttributeMaxDynamicSharedMemorySize, LDS_BYTES) != hipSuccess) fprintf(stderr, "hipFuncSetAttribute failed (phase %d)\n", P); attr = true; }
    a.ph_lo = P; a.ph_hi = P + 1;
    hipLaunchKernelGGL(mega<P>, dim3(grid), dim3(NWAVES * 64), LDS_BYTES, stream, a);
}
extern "C" void kernel_launch(void* const* d_in, const int* in_sizes, int n_in, void* d_out, int out_size, void* d_ws, size_t ws_size, hipStream_t stream) {
    static int grid = 0;
    if (grid == 0) {
        if (n_in != 21 || out_size != MR * DM || ws_size < WS_END) { fprintf(stderr, "kernel_launch: unexpected shapes n_in %d out %d ws %zu\n", n_in, out_size, ws_size); grid = -1; return; }
        int dev = 0, cus = 0;
        (void)hipGetDevice(&dev); (void)hipDeviceGetAttribute(&cus, hipDeviceAttributeMultiprocessorCount, dev);
        grid = (cus / 8) * 8;
        if (grid < 8) { fprintf(stderr, "kernel_launch: device with %d CUs not supported\n", cus); grid = -1; return; }
#if N_LAUNCH_MODE == 1
        int per_cu = 0;
        if (hipFuncSetAttribute((const void*)mega<-1>, hipFuncAttributeMaxDynamicSharedMemorySize, LDS_BYTES) != hipSuccess) { fprintf(stderr, "kernel_launch: hipFuncSetAttribute failed\n"); grid = -1; return; }
        if (hipOccupancyMaxActiveBlocksPerMultiprocessor(&per_cu, (const void*)mega<-1>, NWAVES * 64, LDS_BYTES) != hipSuccess || per_cu < 1) { fprintf(stderr, "kernel_launch: occupancy query %d\n", per_cu); grid = -1; return; }
        (void)hipGetLastError();
#endif
    }
    if (grid < 0) return;
    Args a{};
    for (int i = 0; i < 21; ++i) a.in[i] = (const float*)d_in[i];
    a.out = (float*)d_out; a.ws = (unsigned char*)d_ws;
#if N_LAUNCH_MODE == 0
    launch_phase<0>(grid, stream, a); launch_phase<1>(grid, stream, a); launch_phase<2>(grid, stream, a); launch_phase<3>(grid, stream, a); launch_phase<4>(grid, stream, a);
    launch_phase<5>(grid, stream, a); launch_phase<6>(grid, stream, a); launch_phase<7>(grid, stream, a); launch_phase<8>(grid, stream, a); launch_phase<9>(grid, stream, a); launch_phase<10>(grid, stream, a);
#else
    if (hipMemsetAsync((char*)d_ws + WS_CTL, 0, 65536, stream) != hipSuccess) { fprintf(stderr, "kernel_launch: memset failed\n"); return; }
    a.ph_lo = 0; a.ph_hi = NPHASE;
    void* kargs[] = {&a};
    hipError_t e = hipLaunchCooperativeKernel((const void*)mega<-1>, dim3(grid), dim3(NWAVES * 64), kargs, LDS_BYTES, stream);
    if (e != hipSuccess) fprintf(stderr, "cooperative launch failed: %s (grid %d)\n", hipGetErrorString(e), grid);
#endif
    const hipError_t le = hipPeekAtLastError();
    if (le != hipSuccess) fprintf(stderr, "kernel_launch: launch failed: %s\n", hipGetErrorName(le));
}
```
